# Optimizing an MI355X kernel written in HIP

```python
import jax, jax.numpy as jnp
from jax import lax
import numpy as np

D_MODEL = 1024
BATCH = 8
SEQ = 2048
DEPTH = 2

EPS = 1e-6
NEG_INF = -1e30
FORCE_SCORE = 1e4
N_BRANCH = 3

GMLP_WIDTH = 1024
GMLP_GROUPS = 4
GMLP_GROUP_DIM = GMLP_WIDTH // GMLP_GROUPS
GMLP_CHUNK = 128

NSA_HEADS = 16
NSA_KV_GROUPS = 4
NSA_HEAD_DIM = 64
NSA_HPG = NSA_HEADS // NSA_KV_GROUPS
NSA_Q_WIDTH = NSA_HEADS * NSA_HEAD_DIM
NSA_KV_WIDTH = NSA_KV_GROUPS * NSA_HEAD_DIM
CMP_BLOCK = 32
CMP_STRIDE = 16
CMP_HIDDEN = 256
SEL_BLOCK = 64
SEL_TOP_N = 16
WINDOW = 512
NSA_Q_CHUNK = 64

RNN_WIDTH = 1024
RNN_HEADS = 16
RNN_HEAD_DIM = RNN_WIDTH // RNN_HEADS
CONV_WIDTH = 4
LRU_C = 8.0

D_FF = -(-8 * D_MODEL // (3 * 256)) * 256

IN_SPLITS = (GMLP_WIDTH, GMLP_WIDTH, NSA_Q_WIDTH, 6 * NSA_KV_WIDTH, N_BRANCH * NSA_HEADS, RNN_WIDTH, RNN_WIDTH, N_BRANCH * D_MODEL)
D_IN = sum(IN_SPLITS)

kernel_name = "hybrid_gmlp_nsa_rglru_block"


def rms_norm(x, g):
    xf = x.astype(jnp.float32)
    y = xf * lax.rsqrt(jnp.mean(xf * xf, axis=-1, keepdims=True) + EPS)
    return (y * g.astype(jnp.float32)).astype(x.dtype)


def layer_norm(x, g, b):
    xf = x.astype(jnp.float32)
    mu = jnp.mean(xf, axis=-1, keepdims=True)
    var = jnp.mean(jnp.square(xf - mu), axis=-1, keepdims=True)
    y = (xf - mu) * lax.rsqrt(var + EPS) * g.astype(jnp.float32) + b.astype(jnp.float32)
    return y.astype(x.dtype)


def gmlp_mixer(u, v, ln_g, ln_b, w_s, b_s):
    B, S, _ = u.shape
    n_chunks = S // GMLP_CHUNK
    vn = layer_norm(v, ln_g, ln_b).reshape(B, n_chunks, GMLP_CHUNK, GMLP_GROUPS, GMLP_GROUP_DIM)
    causal = jnp.tril(jnp.ones((GMLP_CHUNK, GMLP_CHUNK), w_s.dtype))
    w = w_s * causal
    mixed = jnp.einsum('gts,bnsgd->bntgd', w, vn) + b_s.T[None, None, :, :, None]
    return u * mixed.reshape(B, S, GMLP_WIDTH)


def nsa_mixer(q, k_cmp, v_cmp, k_slc, v_slc, k_win, v_win, branch_gates,
              pe_k, pe_v, wk1, wk2, wv1, wv2):
    B, S, _ = q.shape
    G, HP, DH = NSA_KV_GROUPS, NSA_HPG, NSA_HEAD_DIM
    scale = DH ** -0.5
    qh = q.reshape(B, S, G, HP, DH).transpose(0, 2, 3, 1, 4)

    def kv_heads(t):
        return t.reshape(B, S, G, DH).transpose(0, 2, 1, 3)

    k_cmp, v_cmp, k_slc, v_slc, k_win, v_win = map(kv_heads, (k_cmp, v_cmp, k_slc, v_slc, k_win, v_win))
    pos = jnp.arange(S)

    n_cmp = (S - CMP_BLOCK) // CMP_STRIDE + 1
    blk_idx = jnp.arange(n_cmp)[:, None] * CMP_STRIDE + jnp.arange(CMP_BLOCK)[None, :]

    def compress(t, pe, w1, w2):
        blocks = t[:, :, blk_idx] + pe
        flat = blocks.reshape(B, G, n_cmp, CMP_BLOCK * DH)
        return jax.nn.gelu(flat @ w1) @ w2

    kc = compress(k_cmp, pe_k, wk1, wk2)
    vc = compress(v_cmp, pe_v, wv1, wv2)
    cmp_end = jnp.arange(n_cmp) * CMP_STRIDE + CMP_BLOCK - 1
    valid_c = cmp_end[None, :] <= pos[:, None]
    s_c = jnp.einsum('bghsd,bgnd->bghsn', qh, kc).astype(jnp.float32) * scale
    s_c = jnp.where(valid_c, s_c, NEG_INF)
    p_c = jax.nn.softmax(s_c, axis=-1) * jnp.any(valid_c, axis=-1)[:, None].astype(jnp.float32)
    o_cmp = jnp.einsum('bghsn,bgnd->bghsd', p_c.astype(vc.dtype), vc)

    n_sel = S // SEL_BLOCK
    c_start = np.arange(n_cmp) * CMP_STRIDE
    s_start = np.arange(n_sel) * SEL_BLOCK
    overlap = np.clip(np.minimum(c_start[:, None] + CMP_BLOCK, s_start[None, :] + SEL_BLOCK)
                      - np.maximum(c_start[:, None], s_start[None, :]), 0, None) / CMP_BLOCK
    overlap = jnp.asarray(overlap, jnp.float32)
    imp = jnp.einsum('bghsn,nj->bgsj', p_c, overlap)
    cur = (pos // SEL_BLOCK)[:, None]
    j = jnp.arange(n_sel)[None, :]
    forced = (j == 0) | (j == cur) | (j == cur - 1)
    imp = jnp.where(forced, FORCE_SCORE, jnp.where(j > cur, NEG_INF, imp))
    top_n = min(SEL_TOP_N, n_sel)
    _, sel_idx = lax.top_k(imp, top_n)

    k_sb = k_slc.reshape(B, G, n_sel, SEL_BLOCK, DH)
    v_sb = v_slc.reshape(B, G, n_sel, SEL_BLOCK, DH)
    pad = jnp.zeros((B, G, WINDOW, DH), k_win.dtype)
    k_wp = jnp.concatenate([pad, k_win], axis=2)
    v_wp = jnp.concatenate([pad, v_win], axis=2)
    gather = jax.vmap(jax.vmap(lambda blocks, ix: blocks[ix]))

    C = NSA_Q_CHUNK
    n_chunks = S // C
    q_ch = jnp.moveaxis(qh.reshape(B, G, HP, n_chunks, C, DH), 3, 0)
    idx_ch = jnp.moveaxis(sel_idx.reshape(B, G, n_chunks, C, top_n), 2, 0)

    def chunk_fn(args):
        c, qc, ic = args
        t = c * C + jnp.arange(C)
        kg = gather(k_sb, ic)
        vg = gather(v_sb, ic)
        kpos = ic[..., None] * SEL_BLOCK + jnp.arange(SEL_BLOCK)
        s = jnp.einsum('bghcd,bgckld->bghckl', qc, kg).astype(jnp.float32) * scale
        s = jnp.where((kpos <= t[:, None, None])[:, :, None], s, NEG_INF)
        p = jax.nn.softmax(s.reshape(B, G, HP, C, top_n * SEL_BLOCK), axis=-1).reshape(s.shape)
        o_s = jnp.einsum('bghckl,bgckld->bghcd', p.astype(vg.dtype), vg)
        kw = lax.dynamic_slice_in_dim(k_wp, c * C, WINDOW + C, axis=2)
        vw = lax.dynamic_slice_in_dim(v_wp, c * C, WINDOW + C, axis=2)
        wpos = c * C - WINDOW + jnp.arange(WINDOW + C)
        wmask = (wpos[None, :] >= 0) & (wpos[None, :] <= t[:, None]) & (wpos[None, :] > t[:, None] - WINDOW)
        sw = jnp.einsum('bghcd,bgkd->bghck', qc, kw).astype(jnp.float32) * scale
        sw = jnp.where(wmask, sw, NEG_INF)
        o_w = jnp.einsum('bghck,bgkd->bghcd', jax.nn.softmax(sw, axis=-1).astype(vw.dtype), vw)
        return o_s, o_w

    o_slc, o_win = lax.map(chunk_fn, (jnp.arange(n_chunks), q_ch, idx_ch))
    o_slc = jnp.moveaxis(o_slc, 0, 3).reshape(B, G, HP, S, DH)
    o_win = jnp.moveaxis(o_win, 0, 3).reshape(B, G, HP, S, DH)

    g = jax.nn.sigmoid(branch_gates).reshape(B, S, G, HP, N_BRANCH).transpose(0, 2, 3, 1, 4)
    o = g[..., 0:1] * o_cmp + g[..., 1:2] * o_slc + g[..., 2:3] * o_win
    return o.transpose(0, 3, 1, 2, 4).reshape(B, S, NSA_Q_WIDTH)


def rglru_mixer(xr, gate, conv_w, conv_b, w_a, b_a, w_x, b_x, lam):
    B, S, _ = xr.shape
    xc = lax.conv_general_dilated(xr, conv_w[:, None, :], window_strides=(1,),
                                  padding=[(CONV_WIDTH - 1, 0)],
                                  dimension_numbers=('NWC', 'WIO', 'NWC'),
                                  feature_group_count=RNN_WIDTH) + conv_b
    xh = xc.reshape(B, S, RNN_HEADS, RNN_HEAD_DIM)
    r = jax.nn.sigmoid(jnp.einsum('bshi,hio->bsho', xh, w_a).reshape(B, S, RNN_WIDTH) + b_a)
    i = jax.nn.sigmoid(jnp.einsum('bshi,hio->bsho', xh, w_x).reshape(B, S, RNN_WIDTH) + b_x)
    log_a = -LRU_C * r.astype(jnp.float32) * jax.nn.softplus(-lam.astype(jnp.float32))
    a = jnp.exp(log_a)
    b_in = jnp.sqrt(-jnp.expm1(2.0 * log_a)) * (i * xc).astype(jnp.float32)

    def combine(left, right):
        a1, b1 = left
        a2, b2 = right
        return a2 * a1, a2 * b1 + b2

    _, h = lax.associative_scan(combine, (a, b_in), axis=1)
    return h.astype(xr.dtype) * jax.nn.gelu(gate)


def hybrid_layer(x, g_pre_mix, g_post_mix, g_pre_ffn, g_post_ffn, w_in,
                 gmlp_ln_g, gmlp_ln_b, gmlp_ws, gmlp_bs,
                 nsa_pe_k, nsa_pe_v, nsa_wk1, nsa_wk2, nsa_wv1, nsa_wv2,
                 rnn_conv_w, rnn_conv_b, rnn_wa, rnn_ba, rnn_wx, rnn_bx, rnn_lam,
                 w_br_a, w_br_b, w_br_c, w_o, w_ffn_in, w_ffn_out):
    B, S, _ = x.shape
    h = rms_norm(x, g_pre_mix)
    z = h @ w_in
    split_points = [int(p) for p in np.cumsum(IN_SPLITS)[:-1]]
    u, v, q, kv, nsa_g, xr, rg, mg = jnp.split(z, split_points, axis=-1)
    k_cmp, v_cmp, k_slc, v_slc, k_win, v_win = jnp.split(kv, 6, axis=-1)

    y_a = gmlp_mixer(jax.nn.gelu(u), jax.nn.gelu(v), gmlp_ln_g, gmlp_ln_b, gmlp_ws, gmlp_bs)
    y_b = nsa_mixer(q, k_cmp, v_cmp, k_slc, v_slc, k_win, v_win, nsa_g,
                    nsa_pe_k, nsa_pe_v, nsa_wk1, nsa_wk2, nsa_wv1, nsa_wv2)
    y_c = rglru_mixer(xr, rg, rnn_conv_w, rnn_conv_b, rnn_wa, rnn_ba, rnn_wx, rnn_bx, rnn_lam)

    gates = jax.nn.sigmoid(mg).reshape(B, S, N_BRANCH, D_MODEL)
    merged = (gates[:, :, 0] * (y_a @ w_br_a)
              + gates[:, :, 1] * (y_b @ w_br_b)
              + gates[:, :, 2] * (y_c @ w_br_c))
    x = x + rms_norm(merged @ w_o, g_post_mix)

    hf = rms_norm(x, g_pre_ffn)
    f_gate, f_up = jnp.split(hf @ w_ffn_in, 2, axis=-1)
    f = (jax.nn.silu(f_gate) * f_up) @ w_ffn_out
    return x + rms_norm(f, g_post_ffn)


def setup_inputs(seed: int = 0) -> dict:
    key = jax.random.key(seed)
    keys = iter(jax.random.split(key, 48))
    L = DEPTH

    def nrm(shape, scale):
        return jax.random.normal(next(keys), shape, jnp.float32) * scale

    def gain(n):
        return 1.0 + nrm((L, n), 0.05)

    u_lam = jax.random.uniform(next(keys), (L, RNN_WIDTH), jnp.float32, minval=0.9, maxval=0.999)
    a0 = u_lam ** (1.0 / LRU_C)
    rnn_lam = jnp.log(a0) - jnp.log1p(-a0)

    return {
        "x": nrm((BATCH, SEQ, D_MODEL), 1.0),
        "g_pre_mix": gain(D_MODEL),
        "g_post_mix": gain(D_MODEL),
        "g_pre_ffn": gain(D_MODEL),
        "g_post_ffn": gain(D_MODEL),
        "w_in": nrm((L, D_MODEL, D_IN), D_MODEL ** -0.5),
        "gmlp_ln_g": gain(GMLP_WIDTH),
        "gmlp_ln_b": nrm((L, GMLP_WIDTH), 0.05),
        "gmlp_ws": nrm((L, GMLP_GROUPS, GMLP_CHUNK, GMLP_CHUNK), GMLP_CHUNK ** -0.5),
        "gmlp_bs": 1.0 + nrm((L, GMLP_GROUPS, GMLP_CHUNK), 0.1),
        "nsa_pe_k": nrm((L, CMP_BLOCK, NSA_HEAD_DIM), 0.1),
        "nsa_pe_v": nrm((L, CMP_BLOCK, NSA_HEAD_DIM), 0.1),
        "nsa_wk1": nrm((L, CMP_BLOCK * NSA_HEAD_DIM, CMP_HIDDEN), (CMP_BLOCK * NSA_HEAD_DIM) ** -0.5),
        "nsa_wk2": nrm((L, CMP_HIDDEN, NSA_HEAD_DIM), CMP_HIDDEN ** -0.5),
        "nsa_wv1": nrm((L, CMP_BLOCK * NSA_HEAD_DIM, CMP_HIDDEN), (CMP_BLOCK * NSA_HEAD_DIM) ** -0.5),
        "nsa_wv2": nrm((L, CMP_HIDDEN, NSA_HEAD_DIM), CMP_HIDDEN ** -0.5),
        "rnn_conv_w": nrm((L, CONV_WIDTH, RNN_WIDTH), CONV_WIDTH ** -0.5),
        "rnn_conv_b": nrm((L, RNN_WIDTH), 0.05),
        "rnn_wa": nrm((L, RNN_HEADS, RNN_HEAD_DIM, RNN_HEAD_DIM), RNN_HEAD_DIM ** -0.5),
        "rnn_ba": nrm((L, RNN_WIDTH), 0.1),
        "rnn_wx": nrm((L, RNN_HEADS, RNN_HEAD_DIM, RNN_HEAD_DIM), RNN_HEAD_DIM ** -0.5),
        "rnn_bx": nrm((L, RNN_WIDTH), 0.1),
        "rnn_lam": rnn_lam,
        "w_br_a": nrm((L, GMLP_WIDTH, D_MODEL), GMLP_WIDTH ** -0.5),
        "w_br_b": nrm((L, NSA_Q_WIDTH, D_MODEL), NSA_Q_WIDTH ** -0.5),
        "w_br_c": nrm((L, RNN_WIDTH, D_MODEL), RNN_WIDTH ** -0.5),
        "w_o": nrm((L, D_MODEL, D_MODEL), D_MODEL ** -0.5),
        "w_ffn_in": nrm((L, D_MODEL, 2 * D_FF), D_MODEL ** -0.5),
        "w_ffn_out": nrm((L, D_FF, D_MODEL), D_FF ** -0.5),
    }


def reference(x, g_pre_mix, g_post_mix, g_pre_ffn, g_post_ffn, w_in,
              gmlp_ln_g, gmlp_ln_b, gmlp_ws, gmlp_bs,
              nsa_pe_k, nsa_pe_v, nsa_wk1, nsa_wk2, nsa_wv1, nsa_wv2,
              rnn_conv_w, rnn_conv_b, rnn_wa, rnn_ba, rnn_wx, rnn_bx, rnn_lam,
              w_br_a, w_br_b, w_br_c, w_o, w_ffn_in, w_ffn_out):
    for l in range(DEPTH):
        x = hybrid_layer(x, g_pre_mix[l], g_post_mix[l], g_pre_ffn[l], g_post_ffn[l], w_in[l],
                         gmlp_ln_g[l], gmlp_ln_b[l], gmlp_ws[l], gmlp_bs[l],
                         nsa_pe_k[l], nsa_pe_v[l], nsa_wk1[l], nsa_wk2[l], nsa_wv1[l], nsa_wv2[l],
                         rnn_conv_w[l], rnn_conv_b[l], rnn_wa[l], rnn_ba[l], rnn_wx[l], rnn_bx[l], rnn_lam[l],
                         w_br_a[l], w_br_b[l], w_br_c[l], w_o[l], w_ffn_in[l], w_ffn_out[l])
    return x
```

```cpp
#include <hip/hip_runtime.h>
#include <hip/hip_cooperative_groups.h>
#include <cstdio>
namespace cg = cooperative_groups;

#ifndef MK_MULTI
#define MK_MULTI 0
#endif

typedef unsigned short u16;
using bf16x8 = __attribute__((ext_vector_type(8))) short;
using f32x16 = __attribute__((ext_vector_type(16))) float;
#define DI __device__ __forceinline__
#define MFMA32(a, b, c) __builtin_amdgcn_mfma_f32_32x32x16_bf16((a), (b), (c), 0, 0, 0)

constexpr int T_ = 16384;
constexpr int NTHR = 256;

constexpr size_t SZ32 = 33554432;
constexpr size_t OFF_HB = 0;
constexpr size_t OFF_U = 1 * SZ32;
constexpr size_t OFF_GV = 2 * SZ32;
constexpr size_t OFF_Q = 3 * SZ32;
constexpr size_t OFF_XR = 4 * SZ32;
constexpr size_t OFF_RG = 5 * SZ32;
constexpr size_t OFF_KV = 6 * SZ32;
constexpr size_t KV_ELEMS = 4194304;
constexpr size_t OFF_NG = OFF_KV + 50331648;
constexpr size_t OFF_SM = OFF_NG + 3145728;
constexpr size_t SM_KC = 0, SM_VCT = 524288, SM_CKV = 1048576, SM_WSB = 1050624, SM_HID = 1310720;
constexpr size_t OFF_W1 = OFF_SM + 6291456;
constexpr size_t W1_WIN = 0, W1_WMG = 13893632, W1_WBR = 20185088, W1_WK1 = 26476544, W1_WV1 = 27525120, W1_WK2 = 28573696, W1_WV2 = 28606464;
constexpr size_t WS_NEED = OFF_W1 + 28639232;
constexpr size_t OFF_TBUF = OFF_XR;
constexpr size_t OFF_W2 = OFF_KV;
constexpr size_t W2_WO = 0, W2_WFI = 2097152, W2_WFO = 13631488;
constexpr size_t OFF_ACT = OFF_U;
constexpr size_t OFF_MERGED = OFF_GV;

struct Params { const float* in[29]; float* out; char* ws; };

DI int otid() { int t = (int)__builtin_amdgcn_workitem_id_x(); asm volatile("" : "+v"(t)); return t; }
DI u16 f2bf(float x) { unsigned u = __float_as_uint(x); u += 0x7fffu + ((u >> 16) & 1u); return (u16)(u >> 16); }
DI float bf2f(u16 b) { return __uint_as_float(((unsigned)b) << 16); }
DI unsigned pack2(float a, float b) { return (unsigned)f2bf(a) | ((unsigned)f2bf(b) << 16); }
DI float bflo(unsigned w) { return __uint_as_float(w << 16); }
DI float bfhi(unsigned w) { return __uint_as_float(w & 0xffff0000u); }
DI float rcpf(float x) { return __builtin_amdgcn_rcpf(x); }
DI float sigmoidf_(float x) { return rcpf(1.f + __expf(-x)); }
DI float geluf_(float x) { float y = 1.5957691216f * (x + 0.044715f * x * x * x); return x * rcpf(1.f + __expf(-y)); }
DI float wave_sum(float v) {
#pragma unroll
  for (int o = 32; o >= 1; o >>= 1) v += __shfl_xor(v, o);
  return v;
}
DI f32x16 zero16() { f32x16 v;
#pragma unroll
  for (int i = 0; i < 16; ++i) v[i] = 0.f;
  return v; }
DI void store4bf(u16* p, float a, float b, float c, float d) { uint2 v; v.x = pack2(a, b); v.y = pack2(c, d); *(uint2*)p = v; }

template <int NI> DI void gemm_mainloop(f32x16 (&acc)[NI][2], const u16* __restrict__ A, long lda, const u16* __restrict__ Bt, long ldb, int K, char* smem) {
  const int tid = otid(), lane = tid & 63, wid = tid >> 6;
  const int wm = wid >> 1, wn = wid & 1;
  const int r32 = lane & 31, h = lane >> 5;
  const int lr = tid >> 3, lc = tid & 7;
  const u16* ga = A + (long)lr * lda + lc * 8;
  const u16* gb = Bt + (long)lr * ldb + lc * 8;
  const int soff = lr * 128 + ((lc ^ (lr & 7)) << 4);
  uint4 ra[4], rb[2 * NI];
  const int nk = K >> 6;
#pragma unroll
  for (int i = 0; i < 4; ++i) ra[i] = *(const uint4*)(ga + (long)(32 * i) * lda);
#pragma unroll
  for (int i = 0; i < 2 * NI; ++i) rb[i] = *(const uint4*)(gb + (long)(32 * i) * ldb);
#pragma unroll
  for (int i = 0; i < 4; ++i) *(uint4*)(smem + soff + i * 4096) = ra[i];
#pragma unroll
  for (int i = 0; i < 2 * NI; ++i) *(uint4*)(smem + 16384 + soff + i * 4096) = rb[i];
  __syncthreads();
  const int sw = r32 & 7;
  for (int kt = 0; kt < nk; ++kt) {
    const bool more = (kt + 1 < nk);
    if (more) {
      ga += 64; gb += 64;
#pragma unroll
      for (int i = 0; i < 4; ++i) ra[i] = *(const uint4*)(ga + (long)(32 * i) * lda);
#pragma unroll
      for (int i = 0; i < 2 * NI; ++i) rb[i] = *(const uint4*)(gb + (long)(32 * i) * ldb);
    }
    const char* sa = smem + (kt & 1) * 32768;
    const char* sb = sa + 16384;
#pragma unroll
    for (int ks = 0; ks < 4; ++ks) {
      bf16x8 fa[NI], fb[2];
      const int coff = ((ks * 2 + h) ^ sw) << 4;
#pragma unroll
      for (int ni = 0; ni < NI; ++ni) fa[ni] = *(const bf16x8*)(sb + (wn * (32 * NI) + ni * 32 + r32) * 128 + coff);
#pragma unroll
      for (int mi = 0; mi < 2; ++mi) fb[mi] = *(const bf16x8*)(sa + (wm * 64 + mi * 32 + r32) * 128 + coff);
#pragma unroll
      for (int ni = 0; ni < NI; ++ni)
#pragma unroll
        for (int mi = 0; mi < 2; ++mi) acc[ni][mi] = MFMA32(fa[ni], fb[mi], acc[ni][mi]);
    }
    if (more) {
      char* d = smem + ((kt + 1) & 1) * 32768;
#pragma unroll
      for (int i = 0; i < 4; ++i) *(uint4*)(d + soff + i * 4096) = ra[i];
#pragma unroll
      for (int i = 0; i < 2 * NI; ++i) *(uint4*)(d + 16384 + soff + i * 4096) = rb[i];
    }
    __syncthreads();
  }
}

template <int NI, class F> DI void epi_foreach(const f32x16 (&acc)[NI][2], int m0, int n0, F f) {
  const int lane = otid() & 63, wid = otid() >> 6, wm = wid >> 1, wn = wid & 1, r32 = lane & 31, h = lane >> 5;
#pragma unroll
  for (int ni = 0; ni < NI; ++ni)
#pragma unroll
    for (int mi = 0; mi < 2; ++mi) {
      const int m = m0 + wm * 64 + mi * 32 + r32;
#pragma unroll
      for (int g4 = 0; g4 < 4; ++g4) {
        const int n = n0 + wn * (32 * NI) + ni * 32 + 8 * g4 + 4 * h;
        f(m, n, acc[ni][mi][4 * g4 + 0], acc[ni][mi][4 * g4 + 1], acc[ni][mi][4 * g4 + 2], acc[ni][mi][4 * g4 + 3]);
      }
    }
}

DI int srccol(int mode, int param, int n) {
  if (mode == 0) return n + param;
  if (mode == 1) { if (n < 4608) return n; if (n < 6656) return n + 48; if (n < 6704) return n - 2048; return -1; }
  const int blk = n >> 6, w = n & 63;
  return (w < 32) ? (blk * 32 + w) : (2816 + blk * 32 + (w - 32));
}
DI void conv_tile(const float* __restrict__ src, int lds_, u16* __restrict__ dst, int K, int mode, int param, int tile, char* smem) {
  const int tid = otid();
  const int ntk = K >> 6;
  const int k0 = (tile % ntk) * 64, n0 = (tile / ntk) * 64;
  float* tl = (float*)smem;
  {
    const int c = tid & 63, i0 = tid >> 6;
    const int sc = srccol(mode, param, n0 + c);
#pragma unroll
    for (int j = 0; j < 16; ++j) { const int k = i0 + 4 * j; tl[k * 65 + c] = (sc >= 0) ? src[(long)(k0 + k) * lds_ + sc] : 0.f; }
  }
  __syncthreads();
#pragma unroll
  for (int jj = 0; jj < 2; ++jj) {
    const int nl = (tid >> 3) + 32 * jj, kc = tid & 7;
    float v[8];
#pragma unroll
    for (int e = 0; e < 8; ++e) v[e] = tl[(kc * 8 + e) * 65 + nl];
    uint4 o; o.x = pack2(v[0], v[1]); o.y = pack2(v[2], v[3]); o.z = pack2(v[4], v[5]); o.w = pack2(v[6], v[7]);
    *(uint4*)(dst + (long)(n0 + nl) * K + k0 + kc * 8) = o;
  }
  __syncthreads();
}

constexpr int CONV1_TILES = 1696 + 768 + 768 + 256 + 8;
constexpr int CONV1_ITEMS = CONV1_TILES + 8 + 32;
DI void conv1_item(const Params& p, int l, int t, char* smem) {
  char* w1 = p.ws + OFF_W1;
  const int tid = otid();
  if (t < CONV1_TILES) {
    const float* win = p.in[5] + (long)l * 1024 * 9776;
    if (t < 1696) { conv_tile(win, 9776, (u16*)(w1 + W1_WIN), 1024, 1, 0, t, smem); return; }
    t -= 1696;
    if (t < 768) { conv_tile(win, 9776, (u16*)(w1 + W1_WMG), 1024, 0, 6704, t, smem); return; }
    t -= 768;
    if (t < 768) { const int k = t >> 8; conv_tile(p.in[23 + k] + (long)l * 1048576, 1024, (u16*)(w1 + W1_WBR) + (long)k * 1048576, 1024, 0, 0, t & 255, smem); return; }
    t -= 768;
    if (t < 256) { const int kv = t >> 7; conv_tile(p.in[kv ? 14 : 12] + (long)l * 524288, 256, (u16*)(w1 + (kv ? W1_WV1 : W1_WK1)), 2048, 0, 0, t & 127, smem); return; }
    t -= 256;
    { const int kv = t >> 2; conv_tile(p.in[kv ? 15 : 13] + (long)l * 16384, 64, (u16*)(w1 + (kv ? W1_WV2 : W1_WK2)), 256, 0, 0, t & 3, smem); return; }
  }
  t -= CONV1_TILES;
  if (t < 8) {
    const int kv = t >> 2, jg = t & 3;
    const float* pe = p.in[10 + kv] + (long)l * 2048;
    const float* w = p.in[kv ? 14 : 12] + (long)l * 524288;
    const int j = jg * 64 + (tid & 63), ksl = tid >> 6;
    float s = 0.f;
    for (int kk = ksl * 512; kk < ksl * 512 + 512; ++kk) s += pe[kk] * w[(long)kk * 256 + j];
    float* red = (float*)smem;
    red[tid] = s;
    __syncthreads();
    if (tid < 64) { float r = red[tid] + red[tid + 64] + red[tid + 128] + red[tid + 192]; ((float*)(p.ws + OFF_SM + SM_CKV))[kv * 256 + jg * 64 + tid] = r; }
    __syncthreads();
    return;
  }
  t -= 8;
  {
    const float* wsrc = p.in[8] + (long)l * 65536;
    u16* dst = (u16*)(p.ws + OFF_SM + SM_WSB);
    const int e0 = t * 2048 + tid * 8;
    const int tt = (e0 >> 7) & 127, s0 = e0 & 127;
    float v[8];
#pragma unroll
    for (int e = 0; e < 8; ++e) v[e] = (s0 + e <= tt) ? wsrc[e0 + e] : 0.f;
    uint4 o; o.x = pack2(v[0], v[1]); o.y = pack2(v[2], v[3]); o.z = pack2(v[4], v[5]); o.w = pack2(v[6], v[7]);
    *(uint4*)(dst + e0) = o;
  }
}
constexpr int CONV2_TILES = 256 + 1408 + 704;
DI void conv2_item(const Params& p, int l, int t, char* smem) {
  char* w2 = p.ws + OFF_W2;
  if (t < 256) { conv_tile(p.in[26] + (long)l * 1048576, 1024, (u16*)(w2 + W2_WO), 1024, 0, 0, t, smem); return; }
  t -= 256;
  if (t < 1408) { conv_tile(p.in[27] + (long)l * 1024 * 5632, 5632, (u16*)(w2 + W2_WFI), 1024, 2, 0, t, smem); return; }
  t -= 1408;
  conv_tile(p.in[28] + (long)l * 2816 * 1024, 1024, (u16*)(w2 + W2_WFO), 2816, 0, 0, t, smem);
}

DI void row_item(int item, const float* __restrict__ res_in, const float* __restrict__ delta, const float* __restrict__ g_post,
                 float* __restrict__ res_out, const float* __restrict__ g_next, u16* __restrict__ hnext) {
  const int lane = otid() & 63;
  const long row = (long)item * 4 + (otid() >> 6);
  float x[16];
#pragma unroll
  for (int j = 0; j < 4; ++j) { const float4 v = *(const float4*)(res_in + row * 1024 + j * 256 + lane * 4); x[4 * j] = v.x; x[4 * j + 1] = v.y; x[4 * j + 2] = v.z; x[4 * j + 3] = v.w; }
  if (delta) {
    float d[16]; float ss = 0.f;
#pragma unroll
    for (int j = 0; j < 4; ++j) { const float4 v = *(const float4*)(delta + row * 1024 + j * 256 + lane * 4); d[4 * j] = v.x; d[4 * j + 1] = v.y; d[4 * j + 2] = v.z; d[4 * j + 3] = v.w; }
#pragma unroll
    for (int i = 0; i < 16; ++i) ss += d[i] * d[i];
    ss = wave_sum(ss);
    const float rs = rsqrtf(ss * (1.f / 1024.f) + 1e-6f);
#pragma unroll
    for (int j = 0; j < 4; ++j) {
      const float4 g = *(const float4*)(g_post + j * 256 + lane * 4);
      x[4 * j] += d[4 * j] * rs * g.x; x[4 * j + 1] += d[4 * j + 1] * rs * g.y; x[4 * j + 2] += d[4 * j + 2] * rs * g.z; x[4 * j + 3] += d[4 * j + 3] * rs * g.w;
      float4 o; o.x = x[4 * j]; o.y = x[4 * j + 1]; o.z = x[4 * j + 2]; o.w = x[4 * j + 3];
      *(float4*)(res_out + row * 1024 + j * 256 + lane * 4) = o;
    }
  }
  if (hnext) {
    float ss = 0.f;
#pragma unroll
    for (int i = 0; i < 16; ++i) ss += x[i] * x[i];
    ss = wave_sum(ss);
    const float rs = rsqrtf(ss * (1.f / 1024.f) + 1e-6f);
#pragma unroll
    for (int j = 0; j < 4; ++j) {
      const float4 g = *(const float4*)(g_next + j * 256 + lane * 4);
      store4bf(hnext + row * 1024 + j * 256 + lane * 4, x[4 * j] * rs * g.x, x[4 * j + 1] * rs * g.y, x[4 * j + 2] * rs * g.z, x[4 * j + 3] * rs * g.w);
    }
  }
}

DI void phaseB_tile(const Params& p, int item, char* smem) {
  const int nt = item % 53, mt = item / 53;
  const int m0 = mt * 128, n0 = nt * 128;
  char* ws = p.ws;
  f32x16 acc[2][2];
#pragma unroll
  for (int a = 0; a < 2; ++a)
#pragma unroll
    for (int b = 0; b < 2; ++b) acc[a][b] = zero16();
  gemm_mainloop<2>(acc, (const u16*)(ws + OFF_HB) + (long)m0 * 1024, 1024, (const u16*)(ws + OFF_W1 + W1_WIN) + (long)n0 * 1024, 1024, 1024, smem);
  if (n0 < 1024) {
    u16* U = (u16*)(ws + OFF_U);
    epi_foreach<2>(acc, m0, n0, [&](int m, int n, float a, float b, float c, float d) { store4bf(U + (long)m * 1024 + n, geluf_(a), geluf_(b), geluf_(c), geluf_(d)); });
  } else if (n0 < 2048) {
    u16* G = (u16*)(ws + OFF_GV);
    epi_foreach<2>(acc, m0, n0, [&](int m, int n, float a, float b, float c, float d) { store4bf(G + (long)m * 1024 + (n - 1024), geluf_(a), geluf_(b), geluf_(c), geluf_(d)); });
  } else if (n0 < 3072) {
    u16* Q = (u16*)(ws + OFF_Q);
    epi_foreach<2>(acc, m0, n0, [&](int m, int n, float a, float b, float c, float d) { store4bf(Q + (long)m * 1024 + (n - 2048), a, b, c, d); });
  } else if (n0 < 4608) {
    const int i6 = (n0 - 3072) >> 8;
    u16* base = (u16*)(ws + OFF_KV) + (long)i6 * KV_ELEMS;
    if (i6 == 3 || i6 == 5) {
      epi_foreach<2>(acc, m0, n0, [&](int m, int n, float a, float b, float c, float d) {
        const int cc = n - 3072, g = (cc >> 6) & 3, dd = cc & 63, bb = m >> 11, s = m & 2047;
        u16* q = base + ((long)(bb * 4 + g) * 64 + dd) * 2048 + s;
        q[0] = f2bf(a); q[2048] = f2bf(b); q[4096] = f2bf(c); q[6144] = f2bf(d);
      });
    } else {
      epi_foreach<2>(acc, m0, n0, [&](int m, int n, float a, float b, float c, float d) {
        const int cc = n - 3072, g = (cc >> 6) & 3, dd = cc & 63, bb = m >> 11, s = m & 2047;
        store4bf(base + ((long)(bb * 4 + g) * 2048 + s) * 64 + dd, a, b, c, d);
      });
    }
  } else if (n0 < 5632) {
    u16* X = (u16*)(ws + OFF_XR);
    epi_foreach<2>(acc, m0, n0, [&](int m, int n, float a, float b, float c, float d) { store4bf(X + (long)m * 1024 + (n - 4608), a, b, c, d); });
  } else if (n0 < 6656) {
    u16* R = (u16*)(ws + OFF_RG);
    epi_foreach<2>(acc, m0, n0, [&](int m, int n, float a, float b, float c, float d) { store4bf(R + (long)m * 1024 + (n - 5632), geluf_(a), geluf_(b), geluf_(c), geluf_(d)); });
  } else {
    float* NG = (float*)(ws + OFF_NG);
    epi_foreach<2>(acc, m0, n0, [&](int m, int n, float a, float b, float c, float d) {
      const int cc = n - 6656;
      if (cc < 48) { float4 o; o.x = sigmoidf_(a); o.y = sigmoidf_(b); o.z = sigmoidf_(c); o.w = sigmoidf_(d); *(float4*)(NG + (long)m * 48 + cc) = o; }
    });
  }
}

DI void rglru_item(const Params& p, int l, int item, char* smem) {
  const int tid = otid();
  const int qo = item & 3, hd = (item >> 2) & 15, b = item >> 6;
  float* xc = (float*)smem;
  float* Wa = (float*)(smem + 33280);
  float* Wx = (float*)(smem + 37376);
  float* AL = (float*)(smem + 41472);
  float* BL = (float*)(smem + 50176);
  float* segP = (float*)(smem + 58880);
  float* segH = (float*)(smem + 59904);
  float* carry = (float*)(smem + 60928);
  const u16* XR = (const u16*)(p.ws + OFF_XR);
  u16* RG = (u16*)(p.ws + OFF_RG);
  {
    const float* wa = p.in[18] + (long)l * 65536 + (long)hd * 4096;
    const float* wx = p.in[20] + (long)l * 65536 + (long)hd * 4096;
#pragma unroll
    for (int j = 0; j < 4; ++j) { const int e = tid + 256 * j; const int i = e >> 4, o = e & 15; Wa[e] = wa[i * 64 + qo * 16 + o]; Wx[e] = wx[i * 64 + qo * 16 + o]; }
    if (tid < 32) carry[tid] = 0.f;
  }
  const int cc = tid & 63, tg = tid >> 6;
  float cw[4];
#pragma unroll
  for (int j = 0; j < 4; ++j) cw[j] = p.in[16][(long)l * 4096 + j * 1024 + hd * 64 + cc];
  const float cb = p.in[17][(long)l * 1024 + hd * 64 + cc];
  const int gt = tid & 127, og = tid >> 7;
  float ba[8], bx[8], sp[8];
#pragma unroll
  for (int e = 0; e < 8; ++e) {
    const int c = hd * 64 + qo * 16 + og * 8 + e;
    ba[e] = p.in[19][(long)l * 1024 + c]; bx[e] = p.in[21][(long)l * 1024 + c];
    sp[e] = log1pf(expf(-p.in[22][(long)l * 1024 + c]));
  }
  const int so = tid & 15, seg = tid >> 4;
  __syncthreads();
  for (int ch = 0; ch < 16; ++ch) {
    const int s0 = ch * 128;
    {
      const int sb = s0 + tg * 32;
      const u16* xp = XR + ((long)b * 2048 + sb) * 1024 + hd * 64 + cc;
      float x0 = (sb - 3 >= 0) ? bf2f(xp[-3 * 1024]) : 0.f;
      float x1 = (sb - 2 >= 0) ? bf2f(xp[-2 * 1024]) : 0.f;
      float x2 = (sb - 1 >= 0) ? bf2f(xp[-1 * 1024]) : 0.f;
#pragma unroll 8
      for (int tt = 0; tt < 32; ++tt) {
        const float x3 = bf2f(xp[(long)tt * 1024]);
        xc[(tg * 32 + tt) * 65 + cc] = cb + cw[0] * x0 + cw[1] * x1 + cw[2] * x2 + cw[3] * x3;
        x0 = x1; x1 = x2; x2 = x3;
      }
    }
    __syncthreads();
    {
      float ar[8], ai[8];
#pragma unroll
      for (int e = 0; e < 8; ++e) { ar[e] = ba[e]; ai[e] = bx[e]; }
#pragma unroll 4
      for (int i = 0; i < 64; ++i) {
        const float xv = xc[gt * 65 + i];
        const float4 a0 = *(const float4*)(Wa + i * 16 + og * 8), a1 = *(const float4*)(Wa + i * 16 + og * 8 + 4);
        const float4 b0 = *(const float4*)(Wx + i * 16 + og * 8), b1 = *(const float4*)(Wx + i * 16 + og * 8 + 4);
        ar[0] += xv * a0.x; ar[1] += xv * a0.y; ar[2] += xv * a0.z; ar[3] += xv * a0.w;
        ar[4] += xv * a1.x; ar[5] += xv * a1.y; ar[6] += xv * a1.z; ar[7] += xv * a1.w;
        ai[0] += xv * b0.x; ai[1] += xv * b0.y; ai[2] += xv * b0.z; ai[3] += xv * b0.w;
        ai[4] += xv * b1.x; ai[5] += xv * b1.y; ai[6] += xv * b1.z; ai[7] += xv * b1.w;
      }
#pragma unroll
      for (int e = 0; e < 8; ++e) {
        const float r = sigmoidf_(ar[e]), ii = sigmoidf_(ai[e]);
        const float la = -8.f * r * sp[e];
        const float a = expf(la);
        const float bb = sqrtf(-expm1f(2.f * la)) * ii * xc[gt * 65 + qo * 16 + og * 8 + e];
        AL[gt * 17 + og * 8 + e] = a; BL[gt * 17 + og * 8 + e] = bb;
      }
    }
    __syncthreads();
    {
      float a[8], bq[8];
      float P = 1.f, H = 0.f;
#pragma unroll
      for (int j = 0; j < 8; ++j) { a[j] = AL[(seg * 8 + j) * 17 + so]; bq[j] = BL[(seg * 8 + j) * 17 + so]; H = a[j] * H + bq[j]; P *= a[j]; }
      segP[seg * 16 + so] = P; segH[seg * 16 + so] = H;
      __syncthreads();
      float hh = carry[(ch & 1) * 16 + so];
      for (int s2 = 0; s2 < seg; ++s2) hh = segP[s2 * 16 + so] * hh + segH[s2 * 16 + so];
      u16* rp = RG + ((long)b * 2048 + s0 + seg * 8) * 1024 + hd * 64 + qo * 16 + so;
#pragma unroll
      for (int j = 0; j < 8; ++j) { hh = a[j] * hh + bq[j]; const float y = hh * bf2f(rp[(long)j * 1024]); rp[(long)j * 1024] = f2bf(y); }
      if (seg == 15) carry[((ch + 1) & 1) * 16 + so] = hh;
    }
  }
  __syncthreads();
}

DI void compress_item(const Params& p, int item, char* smem) {
  const int tid = otid(), lane = tid & 63, w = tid >> 6, r32 = lane & 31, h = lane >> 5;
  const int kv = item & 1, bg = item >> 1;
  char* ws = p.ws;
  const u16* A = (const u16*)(ws + OFF_KV) + (long)kv * KV_ELEMS + (long)bg * 131072;
  const u16* w1T = (const u16*)(ws + OFF_W1 + (kv ? W1_WV1 : W1_WK1));
  const u16* w2T = (const u16*)(ws + OFF_W1 + (kv ? W1_WV2 : W1_WK2));
  const float* cb = (const float*)(ws + OFF_SM + SM_CKV) + kv * 256;
  u16* hid = (u16*)(ws + OFF_SM + SM_HID) + (long)item * 32768;
  for (int nh = 0; nh < 2; ++nh) {
    f32x16 acc[2][2];
#pragma unroll
    for (int a = 0; a < 2; ++a)
#pragma unroll
      for (int b = 0; b < 2; ++b) acc[a][b] = zero16();
    gemm_mainloop<2>(acc, A, 1024, w1T + (long)nh * 128 * 2048, 2048, 2048, smem);
    epi_foreach<2>(acc, 0, nh * 128, [&](int m, int n, float a, float b, float c, float d) {
      const float4 cv = *(const float4*)(cb + n);
      store4bf(hid + m * 256 + n, geluf_(a + cv.x), geluf_(b + cv.y), geluf_(c + cv.z), geluf_(d + cv.w));
    });
  }
  __syncthreads();
  f32x16 o2[2]; o2[0] = zero16(); o2[1] = zero16();
#pragma unroll 4
  for (int ks = 0; ks < 16; ++ks) {
    const bf16x8 fb = *(const bf16x8*)(hid + (w * 32 + r32) * 256 + ks * 16 + h * 8);
#pragma unroll
    for (int dt = 0; dt < 2; ++dt) {
      const bf16x8 fa = *(const bf16x8*)(w2T + (dt * 32 + r32) * 256 + ks * 16 + h * 8);
      o2[dt] = MFMA32(fa, fb, o2[dt]);
    }
  }
  const int n = w * 32 + r32;
  const bool dead = (n == 127);
  if (kv == 0) {
    u16* KC = (u16*)(ws + OFF_SM + SM_KC) + (long)bg * 8192;
#pragma unroll
    for (int dt = 0; dt < 2; ++dt)
#pragma unroll
      for (int g4 = 0; g4 < 4; ++g4) {
        const int d = dt * 32 + 8 * g4 + 4 * h;
        if (dead) store4bf(KC + n * 64 + d, 0.f, 0.f, 0.f, 0.f);
        else store4bf(KC + n * 64 + d, o2[dt][4 * g4], o2[dt][4 * g4 + 1], o2[dt][4 * g4 + 2], o2[dt][4 * g4 + 3]);
      }
  } else {
    u16* VCT = (u16*)(ws + OFF_SM + SM_VCT) + (long)bg * 8192;
#pragma unroll
    for (int dt = 0; dt < 2; ++dt)
#pragma unroll
      for (int i = 0; i < 16; ++i) {
        const int d = dt * 32 + (i & 3) + 8 * (i >> 2) + 4 * h;
        VCT[d * 128 + n] = dead ? (u16)0 : f2bf(o2[dt][i]);
      }
  }
  __syncthreads();
}

DI void gmlp_item(const Params& p, int l, int item, char* smem) {
  const int tid = otid(), lane = tid & 63, w = tid >> 6, r32 = lane & 31, h = lane >> 5;
  const long t0 = (long)item * 128;
  char* ws = p.ws;
  const u16* GV = (const u16*)(ws + OFF_GV);
  u16* U = (u16*)(ws + OFF_U);
  const u16* WSB = (const u16*)(ws + OFF_SM + SM_WSB);
  const float* lng = p.in[6] + (long)l * 1024;
  const float* lnb = p.in[7] + (long)l * 1024;
  const float* bs = p.in[9] + (long)l * 512;
  char* vnt = smem;
  float* mu = (float*)(smem + 34816);
  float* rs = (float*)(smem + 34816 + 512);
  for (int rr = 0; rr < 32; ++rr) {
    const int row = w * 32 + rr;
    const uint4 a = *(const uint4*)(GV + (t0 + row) * 1024 + lane * 16);
    const uint4 b = *(const uint4*)(GV + (t0 + row) * 1024 + lane * 16 + 8);
    float x[16];
    x[0] = bflo(a.x); x[1] = bfhi(a.x); x[2] = bflo(a.y); x[3] = bfhi(a.y); x[4] = bflo(a.z); x[5] = bfhi(a.z); x[6] = bflo(a.w); x[7] = bfhi(a.w);
    x[8] = bflo(b.x); x[9] = bfhi(b.x); x[10] = bflo(b.y); x[11] = bfhi(b.y); x[12] = bflo(b.z); x[13] = bfhi(b.z); x[14] = bflo(b.w); x[15] = bfhi(b.w);
    float s = 0.f;
#pragma unroll
    for (int i = 0; i < 16; ++i) s += x[i];
    s = wave_sum(s);
    const float m = s * (1.f / 1024.f);
    float q = 0.f;
#pragma unroll
    for (int i = 0; i < 16; ++i) { const float d = x[i] - m; q += d * d; }
    q = wave_sum(q);
    if (lane == 0) { mu[row] = m; rs[row] = rsqrtf(q * (1.f / 1024.f) + 1e-6f); }
  }
  __syncthreads();
  for (int sub = 0; sub < 8; ++sub) {
    const int g = sub >> 1, c0 = g * 256 + (sub & 1) * 128;
#pragma unroll 2
    for (int i = 0; i < 8; ++i) {
      const int idx = tid + 256 * i;
      const int sp = idx & 127, ch = (idx >> 7) * 8;
      const uint4 a = *(const uint4*)(GV + (t0 + sp) * 1024 + c0 + ch);
      const float m = mu[sp], r = rs[sp];
      const float4 g0 = *(const float4*)(lng + c0 + ch), g1 = *(const float4*)(lng + c0 + ch + 4);
      const float4 b0 = *(const float4*)(lnb + c0 + ch), b1 = *(const float4*)(lnb + c0 + ch + 4);
      u16* dp = (u16*)vnt + ch * 136 + sp;
      dp[0 * 136] = f2bf((bflo(a.x) - m) * r * g0.x + b0.x);
      dp[1 * 136] = f2bf((bfhi(a.x) - m) * r * g0.y + b0.y);
      dp[2 * 136] = f2bf((bflo(a.y) - m) * r * g0.z + b0.z);
      dp[3 * 136] = f2bf((bfhi(a.y) - m) * r * g0.w + b0.w);
      dp[4 * 136] = f2bf((bflo(a.z) - m) * r * g1.x + b1.x);
      dp[5 * 136] = f2bf((bfhi(a.z) - m) * r * g1.y + b1.y);
      dp[6 * 136] = f2bf((bflo(a.w) - m) * r * g1.z + b1.z);
      dp[7 * 136] = f2bf((bfhi(a.w) - m) * r * g1.w + b1.w);
    }
    __syncthreads();
    f32x16 acc[4];
#pragma unroll
    for (int mi = 0; mi < 4; ++mi) acc[mi] = zero16();
#pragma unroll
    for (int ks = 0; ks < 8; ++ks) {
      const bf16x8 fa = *(const bf16x8*)(vnt + (w * 32 + r32) * 272 + ks * 32 + h * 16);
#pragma unroll
      for (int mi = 0; mi < 4; ++mi) {
        if (mi >= (ks >> 1)) {
          const bf16x8 fb = *(const bf16x8*)(WSB + (long)g * 16384 + (mi * 32 + r32) * 128 + ks * 16 + h * 8);
          acc[mi] = MFMA32(fa, fb, acc[mi]);
        }
      }
    }
#pragma unroll
    for (int mi = 0; mi < 4; ++mi) {
      const int t = mi * 32 + r32;
      const float bias = bs[g * 128 + t];
#pragma unroll
      for (int g4 = 0; g4 < 4; ++g4) {
        const int d = c0 + w * 32 + 8 * g4 + 4 * h;
        u16* up = U + (t0 + t) * 1024 + d;
        const uint2 uv = *(const uint2*)up;
        store4bf(up, bflo(uv.x) * (acc[mi][4 * g4] + bias), bfhi(uv.x) * (acc[mi][4 * g4 + 1] + bias),
                 bflo(uv.y) * (acc[mi][4 * g4 + 2] + bias), bfhi(uv.y) * (acc[mi][4 * g4 + 3] + bias));
      }
    }
    __syncthreads();
  }
}

DI void load_tile64(char* dst, const u16* __restrict__ src, long stride) {
  const int tid = otid();
#pragma unroll
  for (int i = 0; i < 2; ++i) { const int idx = tid + 256 * i; const int r = idx >> 3, c = idx & 7; *(uint4*)(dst + r * 144 + c * 16) = *(const uint4*)(src + (long)r * stride + c * 8); }
}
DI f32x16 qk_sub(const char* ldsK, int kr0, const bf16x8 (&qf)[4], int r32, int h) {
  f32x16 s = zero16();
#pragma unroll
  for (int ks = 0; ks < 4; ++ks) { const bf16x8 kf = *(const bf16x8*)(ldsK + (kr0 + r32) * 144 + ks * 32 + h * 16); s = MFMA32(kf, qf[ks], s); }
  return s;
}
DI void pv_sub(f32x16 (&o)[2], const char* ldsV, int key0, const f32x16& pt, int r32, int h) {
#pragma unroll
  for (int s2 = 0; s2 < 2; ++s2) {
    union { uint4 u; bf16x8 v; } pb;
    pb.u.x = pack2(pt[8 * s2 + 0], pt[8 * s2 + 1]); pb.u.y = pack2(pt[8 * s2 + 2], pt[8 * s2 + 3]);
    pb.u.z = pack2(pt[8 * s2 + 4], pt[8 * s2 + 5]); pb.u.w = pack2(pt[8 * s2 + 6], pt[8 * s2 + 7]);
#pragma unroll
    for (int dt = 0; dt < 2; ++dt) {
      const char* vp = ldsV + (dt * 32 + r32) * 144 + (key0 + 16 * s2 + 4 * h) * 2;
      union { uint4 u; bf16x8 v; } vf;
      const uint2 lo = *(const uint2*)vp, hi = *(const uint2*)(vp + 16);
      vf.u.x = lo.x; vf.u.y = lo.y; vf.u.z = hi.x; vf.u.w = hi.y;
      o[dt] = MFMA32(vf.v, pb.v, o[dt]);
    }
  }
}
DI void flash_tile(f32x16 (&O)[2], float& m_run, float& l_run, const char* ldsK, const char* ldsV,
                                          const bf16x8 (&qf)[4], int hi, int lo, int r32, int h) {
  f32x16 s[2];
  s[0] = qk_sub(ldsK, 0, qf, r32, h); s[1] = qk_sub(ldsK, 32, qf, r32, h);
  float mt = -1e30f;
#pragma unroll
  for (int sub = 0; sub < 2; ++sub)
#pragma unroll
    for (int i = 0; i < 16; ++i) {
      const int c = sub * 32 + (i & 3) + 8 * (i >> 2);
      const float v = (c <= hi && c > lo) ? s[sub][i] : -1e30f;
      s[sub][i] = v; mt = fmaxf(mt, v);
    }
  mt = fmaxf(mt, __shfl_xor(mt, 32));
  const float m_new = fmaxf(m_run, mt);
  const float alpha = __expf(m_run - m_new);
  float ls = 0.f;
#pragma unroll
  for (int sub = 0; sub < 2; ++sub)
#pragma unroll
    for (int i = 0; i < 16; ++i) { const float pv = (s[sub][i] > -1e29f) ? __expf(s[sub][i] - m_new) : 0.f; s[sub][i] = pv; ls += pv; }
  l_run = l_run * alpha + ls; m_run = m_new;
#pragma unroll
  for (int dt = 0; dt < 2; ++dt)
#pragma unroll
    for (int i = 0; i < 16; ++i) O[dt][i] *= alpha;
  pv_sub(O, ldsV, 0, s[0], r32, h);
  pv_sub(O, ldsV, 32, s[1], r32, h);
}

DI void attn_item(const Params& p, int item, char* smem) {
  const int tid = otid(), lane = tid & 63, w = tid >> 6, r32 = lane & 31, h = lane >> 5;
  const int qi = item >> 5, bg = item & 31;
  const int qt = 63 - qi, b = bg >> 2, g = bg & 3;
  const int t0 = qt * 32, t = t0 + r32, cur = qt >> 1;
  const int hd = g * 4 + w;
  const long tok = (long)b * 2048 + t;
  char* ws = p.ws;
  u16* Q = (u16*)(ws + OFF_Q);
  char* ldsK = smem; char* ldsV = smem + 9216;
  float* impA = (float*)(smem + 18432);
  float* impB = impA + 4 * 32 * 33;
  float* impT = impB + 4 * 32 * 33;
  unsigned* selm = (unsigned*)(impT + 32 * 33);
  bf16x8 qf[4];
#pragma unroll
  for (int ks = 0; ks < 4; ++ks) {
    union { uint4 u; bf16x8 v; } x;
    x.u = *(const uint4*)(Q + tok * 1024 + hd * 64 + ks * 16 + h * 8);
    unsigned* pw = (unsigned*)&x.u;
#pragma unroll
    for (int e = 0; e < 4; ++e) {
      const float lo = bflo(pw[e]) * 0.125f, hi = bfhi(pw[e]) * 0.125f;
      pw[e] = (__float_as_uint(lo) >> 16) | (__float_as_uint(hi) & 0xffff0000u);
    }
    qf[ks] = x.v;
  }
  const float* NG = (const float*)(ws + OFF_NG) + tok * 48 + hd * 3;
  const float g0 = NG[0], g1 = NG[1], g2 = NG[2];
  f32x16 res[2];
  {
    const u16* KC = (const u16*)(ws + OFF_SM + SM_KC) + (long)bg * 8192;
    const u16* VCT = (const u16*)(ws + OFF_SM + SM_VCT) + (long)bg * 8192;
    const int nsub = (qt >> 4) + 1;
    load_tile64(ldsK, KC, 64);
    if (nsub > 2) load_tile64(ldsV, KC + 64 * 64, 64);
    __syncthreads();
    f32x16 sc[4];
    sc[0] = qk_sub(ldsK, 0, qf, r32, h);
    sc[1] = zero16(); sc[2] = zero16(); sc[3] = zero16();
    if (nsub > 1) sc[1] = qk_sub(ldsK, 32, qf, r32, h);
    if (nsub > 2) sc[2] = qk_sub(ldsV, 0, qf, r32, h);
    if (nsub > 3) sc[3] = qk_sub(ldsV, 32, qf, r32, h);
    float mx = -1e30f;
    const int nlim = ((t - 31) >> 4) - 4 * h;
#pragma unroll
    for (int sub = 0; sub < 4; ++sub)
#pragma unroll
      for (int i = 0; i < 16; ++i) {
        const int c = sub * 32 + (i & 3) + 8 * (i >> 2);
        const float v = (c <= nlim) ? sc[sub][i] : -1e30f;
        sc[sub][i] = v; mx = fmaxf(mx, v);
      }
    mx = fmaxf(mx, __shfl_xor(mx, 32));
    float lsum = 0.f;
#pragma unroll
    for (int sub = 0; sub < 4; ++sub)
#pragma unroll
      for (int i = 0; i < 16; ++i) { const float pv = (sc[sub][i] > -1e29f) ? __expf(sc[sub][i] - mx) : 0.f; sc[sub][i] = pv; lsum += pv; }
    lsum += __shfl_xor(lsum, 32);
    const float inv = (t >= 31) ? (1.f / lsum) : 0.f;
#pragma unroll
    for (int sub = 0; sub < 4; ++sub)
#pragma unroll
      for (int i = 0; i < 16; ++i) sc[sub][i] *= inv;
#pragma unroll
    for (int sub = 0; sub < 4; ++sub)
#pragma unroll
      for (int g4 = 0; g4 < 4; ++g4) {
        const int mi = 8 * sub + 2 * g4 + h;
        const float p3 = 0.5f * sc[sub][4 * g4 + 3];
        impA[(w * 32 + r32) * 33 + mi] = sc[sub][4 * g4] + sc[sub][4 * g4 + 1] + sc[sub][4 * g4 + 2] + p3;
        impB[(w * 32 + r32) * 33 + mi + 1] = p3;
      }
    __syncthreads();
    load_tile64(ldsK, VCT, 128);
    if (nsub > 2) load_tile64(ldsV, VCT + 64, 128);
    {
      const int q = tid >> 3, jj = (tid & 7) * 4;
#pragma unroll
      for (int e = 0; e < 4; ++e) {
        const int j = jj + e;
        float tot = 0.f;
#pragma unroll
        for (int ww = 0; ww < 4; ++ww) tot += impA[(ww * 32 + q) * 33 + j];
        if (j > 0) {
#pragma unroll
          for (int ww = 0; ww < 4; ++ww) tot += impB[(ww * 32 + q) * 33 + j];
        }
        impT[q * 33 + j] = tot;
      }
      if (tid < 32) selm[tid] = 0u;
    }
    __syncthreads();
    f32x16 oc[2]; oc[0] = zero16(); oc[1] = zero16();
    pv_sub(oc, ldsK, 0, sc[0], r32, h);
    if (nsub > 1) pv_sub(oc, ldsK, 32, sc[1], r32, h);
    if (nsub > 2) pv_sub(oc, ldsV, 0, sc[2], r32, h);
    if (nsub > 3) pv_sub(oc, ldsV, 32, sc[3], r32, h);
#pragma unroll
    for (int dt = 0; dt < 2; ++dt)
#pragma unroll
      for (int i = 0; i < 16; ++i) res[dt][i] = g0 * oc[dt][i];
    {
      const int q = tid >> 3, jj = (tid & 7) * 4;
      unsigned bits = 0u;
      for (int e = 0; e < 4; ++e) {
        const int j = jj + e;
        bool sel;
        if (j > cur) sel = false;
        else if (j == 0 || j >= cur - 1) sel = true;
        else if (cur - 2 <= 13) sel = true;
        else {
          const float v = impT[q * 33 + j];
          int rank = 0;
          for (int j2 = 1; j2 <= cur - 2; ++j2) { const float v2 = impT[q * 33 + j2]; rank += ((v2 > v) || (v2 == v && j2 < j)) ? 1 : 0; }
          sel = rank < 13;
        }
        if (sel) bits |= (1u << j);
      }
      atomicOr(&selm[q], bits);
    }
    __syncthreads();
  }
  const unsigned mymask = selm[r32];
  unsigned anym = mymask;
#pragma unroll
  for (int o = 16; o >= 1; o >>= 1) anym |= (unsigned)__shfl_xor((int)anym, o);
  {
    const u16* KS = (const u16*)(ws + OFF_KV) + 2 * KV_ELEMS + (long)bg * 131072;
    const u16* VST = (const u16*)(ws + OFF_KV) + 3 * KV_ELEMS + (long)bg * 131072;
    f32x16 O[2]; O[0] = zero16(); O[1] = zero16();
    float m_run = -1e30f, l_run = 0.f;
#pragma unroll 1
    for (int j = 0; j <= cur; ++j) {
      if (!((anym >> j) & 1u)) continue;
      load_tile64(ldsK, KS + (long)j * 4096, 64);
      load_tile64(ldsV, VST + j * 64, 2048);
      __syncthreads();
      const bool bit = (mymask >> j) & 1u;
      const int kb = j * 64;
      flash_tile(O, m_run, l_run, ldsK, ldsV, qf, bit ? (t - kb - 4 * h) : -1, -100000, r32, h);
      __syncthreads();
    }
    const float l = l_run + __shfl_xor(l_run, 32);
    const float sc_ = g1 / l;
#pragma unroll
    for (int dt = 0; dt < 2; ++dt)
#pragma unroll
      for (int i = 0; i < 16; ++i) res[dt][i] += sc_ * O[dt][i];
  }
  {
    const u16* KW = (const u16*)(ws + OFF_KV) + 4 * KV_ELEMS + (long)bg * 131072;
    const u16* VWT = (const u16*)(ws + OFF_KV) + 5 * KV_ELEMS + (long)bg * 131072;
    f32x16 O[2]; O[0] = zero16(); O[1] = zero16();
    float m_run = -1e30f, l_run = 0.f;
    const int jlo = (t0 - 511 > 0) ? ((t0 - 511) >> 6) : 0;
#pragma unroll 1
    for (int j = jlo; j <= cur; ++j) {
      load_tile64(ldsK, KW + (long)j * 4096, 64);
      load_tile64(ldsV, VWT + j * 64, 2048);
      __syncthreads();
      const int kb = j * 64;
      flash_tile(O, m_run, l_run, ldsK, ldsV, qf, t - kb - 4 * h, t - 512 - kb - 4 * h, r32, h);
      __syncthreads();
    }
    const float l = l_run + __shfl_xor(l_run, 32);
    const float sc_ = g2 / l;
#pragma unroll
    for (int dt = 0; dt < 2; ++dt)
#pragma unroll
      for (int i = 0; i < 16; ++i) res[dt][i] += sc_ * O[dt][i];
  }
#pragma unroll
  for (int dt = 0; dt < 2; ++dt)
#pragma unroll
    for (int g4 = 0; g4 < 4; ++g4)
      store4bf(Q + tok * 1024 + hd * 64 + dt * 32 + 8 * g4 + 4 * h, res[dt][4 * g4], res[dt][4 * g4 + 1], res[dt][4 * g4 + 2], res[dt][4 * g4 + 3]);
}

DI void phaseE_tile(const Params& p, int item, char* smem) {
  const int nt = item & 15, mt = item >> 4;
  const int m0 = mt * 128, n0 = nt * 64;
  char* ws = p.ws;
  f32x16 R[1][2];
  R[0][0] = zero16(); R[0][1] = zero16();
#pragma unroll 1
  for (int k = 0; k < 3; ++k) {
    f32x16 acc[1][2];
    acc[0][0] = zero16(); acc[0][1] = zero16();
    gemm_mainloop<1>(acc, (const u16*)(ws + OFF_HB) + (long)m0 * 1024, 1024, (const u16*)(ws + OFF_W1 + W1_WMG) + ((long)k * 1024 + n0) * 1024, 1024, 1024, smem);
    unsigned G[2][8];
#pragma unroll
    for (int b = 0; b < 2; ++b)
#pragma unroll
      for (int q = 0; q < 8; ++q) G[b][q] = pack2(sigmoidf_(acc[0][b][2 * q]), sigmoidf_(acc[0][b][2 * q + 1]));
    acc[0][0] = zero16(); acc[0][1] = zero16();
    const size_t yo = (k == 0) ? OFF_U : ((k == 1) ? OFF_Q : OFF_RG);
    gemm_mainloop<1>(acc, (const u16*)(ws + yo) + (long)m0 * 1024, 1024, (const u16*)(ws + OFF_W1 + W1_WBR) + ((long)k * 1024 + n0) * 1024, 1024, 1024, smem);
#pragma unroll
    for (int b = 0; b < 2; ++b)
#pragma unroll
      for (int q = 0; q < 8; ++q) { R[0][b][2 * q] += bflo(G[b][q]) * acc[0][b][2 * q]; R[0][b][2 * q + 1] += bfhi(G[b][q]) * acc[0][b][2 * q + 1]; }
  }
  u16* M = (u16*)(ws + OFF_MERGED);
  epi_foreach<1>(R, m0, n0, [&](int m, int n, float a, float b, float c, float d) { store4bf(M + (long)m * 1024 + n, a, b, c, d); });
}

DI void gemm_f32out_tile(const u16* A, long lda, const u16* Bt, long ldb, int K, float* C, int item, char* smem) {
  const int nt = item & 7, mt = item >> 3;
  const int m0 = mt * 128, n0 = nt * 128;
  f32x16 acc[2][2];
#pragma unroll
  for (int a = 0; a < 2; ++a)
#pragma unroll
    for (int b = 0; b < 2; ++b) acc[a][b] = zero16();
  gemm_mainloop<2>(acc, A + (long)m0 * lda, lda, Bt + (long)n0 * ldb, ldb, K, smem);
  epi_foreach<2>(acc, m0, n0, [&](int m, int n, float a, float b, float c, float d) { float4 o; o.x = a; o.y = b; o.z = c; o.w = d; *(float4*)(C + (long)m * 1024 + n) = o; });
}

DI void phaseH_tile(const Params& p, int item, char* smem) {
  const int nt = item % 44, mt = item / 44;
  const int m0 = mt * 128, n0 = nt * 128;
  char* ws = p.ws;
  f32x16 acc[2][2];
#pragma unroll
  for (int a = 0; a < 2; ++a)
#pragma unroll
    for (int b = 0; b < 2; ++b) acc[a][b] = zero16();
  gemm_mainloop<2>(acc, (const u16*)(ws + OFF_HB) + (long)m0 * 1024, 1024, (const u16*)(ws + OFF_W2 + W2_WFI) + (long)n0 * 1024, 1024, 1024, smem);
  u16* ACT = (u16*)(ws + OFF_ACT);
  const int lane = otid() & 63, wid = otid() >> 6, wm = wid >> 1, wn = wid & 1, r32 = lane & 31, h = lane >> 5;
#pragma unroll
  for (int mi = 0; mi < 2; ++mi) {
    const int m = m0 + wm * 64 + mi * 32 + r32;
#pragma unroll
    for (int g4 = 0; g4 < 4; ++g4) {
      const int j = ((n0 + wn * 64) >> 6) * 32 + 8 * g4 + 4 * h;
      float o[4];
#pragma unroll
      for (int e = 0; e < 4; ++e) { const float gt = acc[0][mi][4 * g4 + e], up = acc[1][mi][4 * g4 + e]; o[e] = gt * sigmoidf_(gt) * up; }
      store4bf(ACT + (long)m * 2816 + j, o[0], o[1], o[2], o[3]);
    }
  }
}

#ifndef PHMASK
#define PHMASK 0x3ff
#endif
#define PH_ON(i) ((PHMASK >> (i)) & 1)
DI void run_phase(const Params& p, int ph, char* smem) {
  const int G = gridDim.x, bid = blockIdx.x;
  char* ws = p.ws;
  if (ph == 0) {
    if (!PH_ON(9)) return;
    const int n = 4096 + CONV1_ITEMS;
    for (int it = bid; it < n; it += G) {
      if (it < 4096) row_item(it, p.in[0], nullptr, nullptr, nullptr, p.in[1], (u16*)(ws + OFF_HB));
      else conv1_item(p, 0, it - 4096, smem);
    }
    return;
  }
  const int l = (ph - 1) / 9, sp = (ph - 1) % 9;
  switch (sp) {
    case 0: if (!PH_ON(0)) break; for (int it = bid; it < 128 * 53; it += G) phaseB_tile(p, it, smem); break;
    case 1: if (!PH_ON(1)) break;
      for (int it = bid; it < 512 + 64 + 128; it += G) {
        if (it < 512) rglru_item(p, l, it, smem);
        else if (it < 576) compress_item(p, it - 512, smem);
        else gmlp_item(p, l, it - 576, smem);
      }
      break;
    case 2: if (!PH_ON(2)) break; for (int it = bid; it < 2048; it += G) attn_item(p, it, smem); break;
    case 3: if (!PH_ON(3)) break;
      for (int it = bid; it < 2048 + CONV2_TILES; it += G) {
        if (it < 2048) phaseE_tile(p, it, smem);
        else conv2_item(p, l, it - 2048, smem);
      }
      break;
    case 4: if (!PH_ON(4)) break;
      for (int it = bid; it < 1024; it += G)
        gemm_f32out_tile((const u16*)(ws + OFF_MERGED), 1024, (const u16*)(ws + OFF_W2 + W2_WO), 1024, 1024, (float*)(ws + OFF_TBUF), it, smem);
      break;
    case 5: if (!PH_ON(5)) break;
      for (int it = bid; it < 4096; it += G)
        row_item(it, (l == 0) ? p.in[0] : p.out, (const float*)(ws + OFF_TBUF), p.in[2] + l * 1024, p.out, p.in[3] + l * 1024, (u16*)(ws + OFF_HB));
      break;
    case 6: if (!PH_ON(6)) break; for (int it = bid; it < 128 * 44; it += G) phaseH_tile(p, it, smem); break;
    case 7: if (!PH_ON(7)) break;
      for (int it = bid; it < 1024; it += G)
        gemm_f32out_tile((const u16*)(ws + OFF_ACT), 2816, (const u16*)(ws + OFF_W2 + W2_WFO), 2816, 2816, (float*)(ws + OFF_TBUF), it, smem);
      break;
    case 8: if (!PH_ON(8)) break; {
      const bool nxt = (l + 1 < 2);
      const int n = 4096 + (nxt ? CONV1_ITEMS : 0);
      for (int it = bid; it < n; it += G) {
        if (it < 4096) row_item(it, p.out, (const float*)(ws + OFF_TBUF), p.in[4] + l * 1024, p.out, nxt ? (p.in[1] + (l + 1) * 1024) : nullptr, nxt ? (u16*)(ws + OFF_HB) : nullptr);
        else conv1_item(p, l + 1, it - 4096, smem);
      }
      break;
    }
  }
}

constexpr int N_PHASES = 19;

__global__ void __launch_bounds__(NTHR, 2) mega_kernel(Params p, int ph0, int ph1) {
  __shared__ __attribute__((aligned(16))) char smem[65536];
  cg::grid_group grid = cg::this_grid();
  for (int ph = ph0; ph < ph1; ++ph) {
    run_phase(p, ph, smem);
    if (ph + 1 < ph1) grid.sync();
  }
}

extern "C" void kernel_launch(void* const* d_in, const int* in_sizes, int n_in, void* d_out, int out_size, void* d_ws, size_t ws_size,
                              hipStream_t stream) {
  static int grid_blocks = 0;
  if (!grid_blocks) {
    int dev = 0, cus = 0, per_cu = 0;
    hipGetDevice(&dev);
    hipDeviceGetAttribute(&cus, hipDeviceAttributeMultiprocessorCount, dev);
    hipOccupancyMaxActiveBlocksPerMultiprocessor(&per_cu, mega_kernel, NTHR, 0);
    if (per_cu < 1) per_cu = 1;
    if (per_cu > 2) per_cu = 2;
    grid_blocks = cus * per_cu;
    if (ws_size < WS_NEED) fprintf(stderr, "kernel_launch: workspace too small: %zu < %zu\n", ws_size, (size_t)WS_NEED);
  }
  Params p{};
  for (int i = 0; i < 29; ++i) p.in[i] = (const float*)d_in[i];
  p.out = (float*)d_out;
  p.ws = (char*)d_ws;
#if MK_MULTI
  for (int ph = 0; ph < N_PHASES; ++ph) {
    hipLaunchKernelGGL(mega_kernel, dim3(grid_blocks), dim3(NTHR), 0, stream, p, ph, ph + 1);
  }
#else
  int ph0 = 0, ph1 = N_PHASES;
  void* args[] = {&p, &ph0, &ph1};
  hipError_t e = hipLaunchCooperativeKernel((void*)mega_kernel, dim3(grid_blocks), dim3(NTHR), args, 0, stream);
  if (e != hipSuccess) fprintf(stderr, "cooperative launch failed: %s (grid %d)\n", hipGetErrorString(e), grid_blocks);
#endif
}
```

```cpp
#include <hip/hip_runtime.h>
#include <hip/hip_cooperative_groups.h>
#include <cstdio>
namespace cg = cooperative_groups;

#ifndef MK_MULTI
#define MK_MULTI 0
#endif

typedef unsigned short u16;
using bf16x8 = __attribute__((ext_vector_type(8))) short;
using f32x16 = __attribute__((ext_vector_type(16))) float;
using u32x4 = __attribute__((ext_vector_type(4))) unsigned;
using f32x4 = __attribute__((ext_vector_type(4))) float;
#define MFMA16(a, b, c) __builtin_amdgcn_mfma_f32_16x16x32_bf16((a), (b), (c), 0, 0, 0)
#define DI __device__ __forceinline__
#define MFMA32(a, b, c) __builtin_amdgcn_mfma_f32_32x32x16_bf16((a), (b), (c), 0, 0, 0)

constexpr int T_ = 16384;
constexpr int NTHR = 512;
constexpr int LDS_BYTES = 131072;

constexpr size_t SZ32 = 33554432;
constexpr size_t OFF_HB = 0;
constexpr size_t OFF_U = 1 * SZ32;
constexpr size_t OFF_GV = 2 * SZ32;
constexpr size_t OFF_Q = 3 * SZ32;
constexpr size_t OFF_XR = 4 * SZ32;
constexpr size_t OFF_RG = 5 * SZ32;
constexpr size_t OFF_KV = 6 * SZ32;
constexpr size_t KV_ELEMS = 4194304;
constexpr size_t OFF_NG = OFF_KV + 50331648;
constexpr size_t OFF_SM = OFF_NG + 3145728;
constexpr size_t SM_KC = 0, SM_VCT = 524288, SM_CKV = 1048576, SM_WSB = 1050624, SM_HID = 1310720, SM_STATS = 5505024, SM_BAR = 5767168;
constexpr size_t OFF_W1 = OFF_SM + 6291456;
constexpr size_t W1_WIN = 0, W1_WMG = 14155776, W1_WBR = W1_WMG + 6291456, W1_WK1 = W1_WBR + 6291456, W1_WV1 = W1_WK1 + 1048576, W1_WK2 = W1_WV1 + 1048576, W1_WV2 = W1_WK2 + 32768, W1_WNS = W1_WV2 + 32768;
constexpr size_t WS_NEED = OFF_W1 + W1_WNS + 131072;
constexpr size_t OFF_TBUF = OFF_XR;
constexpr size_t OFF_W2 = OFF_KV;
constexpr size_t W2_WO = 0, W2_WFI = 2097152, W2_WFO = 13631488;
constexpr size_t OFF_ACT = OFF_U;
constexpr size_t OFF_MERGED = OFF_GV;

struct Params { const float* in[29]; float* out; char* ws; };

DI int otid() { int t = (int)__builtin_amdgcn_workitem_id_x(); asm volatile("" : "+v"(t)); return t; }
DI int htid() { int t = (int)__builtin_amdgcn_workitem_id_x() & 255; asm volatile("" : "+v"(t)); return t; }

DI float bf2f(u16 b) { return __uint_as_float(((unsigned)b) << 16); }
typedef __bf16 bf2_t __attribute__((ext_vector_type(2)));
typedef float f2_t __attribute__((ext_vector_type(2)));
DI unsigned pack2(float a, float b) { f2_t v; v.x = a; v.y = b; return __builtin_bit_cast(unsigned, __builtin_convertvector(v, bf2_t)); }
DI u16 f2bf(float x) { return (u16)(pack2(x, 0.f) & 0xffffu); }
DI float bflo(unsigned w) { return __uint_as_float(w << 16); }
DI float bfhi(unsigned w) { return __uint_as_float(w & 0xffff0000u); }
DI float rcpf(float x) { return __builtin_amdgcn_rcpf(x); }
DI float sigmoidf_(float x) { return rcpf(1.f + __expf(-x)); }
DI float geluf_(float x) { float y = 1.5957691216f * (x + 0.044715f * x * x * x); return x * rcpf(1.f + __expf(-y)); }
DI float wave_sum(float v) {
#pragma unroll
  for (int o = 32; o >= 1; o >>= 1) v += __shfl_xor(v, o);
  return v;
}
DI float lane_swap1(float v) { const int u = (int)__float_as_uint(v); return __uint_as_float((unsigned)__builtin_amdgcn_update_dpp(u, u, 0xB1, 0xF, 0xF, false)); }
DI f32x16 zero16() { f32x16 v;
#pragma unroll
  for (int i = 0; i < 16; ++i) v[i] = 0.f;
  return v; }
DI void store4bf(u16* p, float a, float b, float c, float d) { uint2 v; v.x = pack2(a, b); v.y = pack2(c, d); *(uint2*)p = v; }

struct TileSrc { const u16* A; long lda; const u16* Bt; long ldb; };
struct Stg { u32x4 a0, a1, a2, a3, b0, b1, b2, b3; };
template <int MI, int WN> DI void gemm512(f32x4 (&acc)[4][2 * MI], const TileSrc cur, int K, char* smem, Stg& st, bool pre, const TileSrc nxt, bool hasnxt) {
  const int tid = otid(), lane = tid & 63, wid = tid >> 6;
  const int wm = wid / WN, wn = wid % WN;
  const int r16 = lane & 15, q = lane >> 4;
  const int lr = tid >> 3, lc = tid & 7;
  const int soff = lr * 128 + ((lc ^ ((lr >> 1) & 7)) << 4);
  const u16* ga = cur.A + (long)lr * cur.lda + lc * 8;
  const u16* gb = cur.Bt + (long)lr * cur.ldb + lc * 8;
  long a64 = 64 * cur.lda, b64 = 64 * cur.ldb;
  const int nk = K >> 6;
#define G512_LOAD() do { st.a0 = *(const u32x4*)(ga); st.a1 = *(const u32x4*)(ga + a64); st.a2 = *(const u32x4*)(ga + 2 * a64); st.a3 = *(const u32x4*)(ga + 3 * a64); \
    st.b0 = *(const u32x4*)(gb); if (WN > 1) st.b1 = *(const u32x4*)(gb + b64); if (WN > 2) { st.b2 = *(const u32x4*)(gb + 2 * b64); st.b3 = *(const u32x4*)(gb + 3 * b64); } } while (0)
#define G512_STORE(d) do { *(u32x4*)((d) + soff) = st.a0; *(u32x4*)((d) + soff + 8192) = st.a1; *(u32x4*)((d) + soff + 16384) = st.a2; *(u32x4*)((d) + soff + 24576) = st.a3; \
    *(u32x4*)((d) + 32768 + soff) = st.b0; if (WN > 1) *(u32x4*)((d) + 32768 + soff + 8192) = st.b1; if (WN > 2) { *(u32x4*)((d) + 32768 + soff + 16384) = st.b2; *(u32x4*)((d) + 32768 + soff + 24576) = st.b3; } } while (0)
  if (!pre) G512_LOAD();
  G512_STORE(smem);
  ga += 64; gb += 64;
  G512_LOAD();
  const int sw = r16 >> 1;
  for (int kt = 0; kt < nk; ++kt) {
    __syncthreads();
    if (kt + 1 < nk) {
      char* d = smem + ((kt + 1) & 1) * 65536;
      G512_STORE(d);
      if (kt + 2 < nk) { ga += 64; gb += 64; G512_LOAD(); }
      else if (hasnxt) {
        ga = nxt.A + (long)lr * nxt.lda + lc * 8; gb = nxt.Bt + (long)lr * nxt.ldb + lc * 8; a64 = 64 * nxt.lda; b64 = 64 * nxt.ldb;
        G512_LOAD();
      }
    }
    const char* sa = smem + (kt & 1) * 65536;
    const char* sb = sa + 32768;
#pragma unroll
    for (int ks = 0; ks < 2; ++ks) {
      bf16x8 fa[4];
      const int coff = ((ks * 4 + q) ^ sw) << 4;
#pragma unroll
      for (int nf = 0; nf < 4; ++nf) fa[nf] = *(const bf16x8*)(sb + (wn * 64 + nf * 16 + r16) * 128 + coff);
      constexpr int MG = (MI >= 2) ? 4 : 2;
      for (int mh = 0; mh < (2 * MI) / MG; ++mh) {
        bf16x8 fb[MG];
#pragma unroll
        for (int mf = 0; mf < MG; ++mf) fb[mf] = *(const bf16x8*)(sa + (wm * (MI * 32) + (mh * MG + mf) * 16 + r16) * 128 + coff);
#pragma unroll
        for (int nf = 0; nf < 4; ++nf)
#pragma unroll
          for (int mf = 0; mf < MG; ++mf) acc[nf][mh * MG + mf] = MFMA16(fa[nf], fb[mf], acc[nf][mh * MG + mf]);
      }
    }
  }
  if (nk & 1) __syncthreads();
#undef G512_LOAD
#undef G512_STORE
}
template <int MI, int WN, class F> DI void epi512(const f32x4 (&acc)[4][2 * MI], int m0, int n0, F f) {
  const int tid = otid(), lane = tid & 63, wid = tid >> 6, wm = wid / WN, wn = wid % WN, r16 = lane & 15, q = lane >> 4;
#pragma unroll
  for (int nf = 0; nf < 4; ++nf) {
#pragma unroll
    for (int mf = 0; mf < 2 * MI; ++mf) {
      const int m = m0 + wm * (MI * 32) + mf * 16 + r16;
      const int n = n0 + wn * 64 + nf * 16 + q * 4;
      f(m, n, acc[nf][mf][0], acc[nf][mf][1], acc[nf][mf][2], acc[nf][mf][3]);
      __builtin_amdgcn_sched_barrier(0);
    }
  }
}
template <int MI, int WN, class TF> DI void epi512_rows16(const f32x4 (&acc)[4][2 * MI], int m0, int n0, u16* dst, long ld, int coladj, TF tf) {
  const int tid = otid(), lane = tid & 63, wid = tid >> 6, wm = wid / WN, wn = wid % WN, r16 = lane & 15, q = lane >> 4;
#pragma unroll
  for (int mf = 0; mf < 2 * MI; ++mf) {
    const int m = m0 + wm * (MI * 32) + mf * 16 + r16;
#pragma unroll
    for (int pp = 0; pp < 2; ++pp) {
      const unsigned ax = pack2(tf(acc[2 * pp][mf][0]), tf(acc[2 * pp][mf][1])), ay = pack2(tf(acc[2 * pp][mf][2]), tf(acc[2 * pp][mf][3]));
      const unsigned bx = pack2(tf(acc[2 * pp + 1][mf][0]), tf(acc[2 * pp + 1][mf][1])), by = pack2(tf(acc[2 * pp + 1][mf][2]), tf(acc[2 * pp + 1][mf][3]));
      auto rx = __builtin_amdgcn_permlane16_swap(ax, bx, false, false);
      auto ry = __builtin_amdgcn_permlane16_swap(ay, by, false, false);
      const int n = n0 + wn * 64 + (2 * pp + (q & 1)) * 16 + (q >> 1) * 8;
      uint4 o; o.x = rx[0]; o.y = ry[0]; o.z = rx[1]; o.w = ry[1];
      *(uint4*)(dst + (long)m * ld + n + coladj) = o;
    }
    __builtin_amdgcn_sched_barrier(0);
  }
}
template <int MI, int WN, class AF> DI void epi512_rows16_at(const f32x4 (&acc)[4][2 * MI], int m0, int n0, AF af) {
  const int tid = otid(), lane = tid & 63, wid = tid >> 6, wm = wid / WN, wn = wid % WN, r16 = lane & 15, q = lane >> 4;
#pragma unroll
  for (int mf = 0; mf < 2 * MI; ++mf) {
    const int m = m0 + wm * (MI * 32) + mf * 16 + r16;
#pragma unroll
    for (int pp = 0; pp < 2; ++pp) {
      auto rx = __builtin_amdgcn_permlane16_swap(pack2(acc[2 * pp][mf][0], acc[2 * pp][mf][1]), pack2(acc[2 * pp + 1][mf][0], acc[2 * pp + 1][mf][1]), false, false);
      auto ry = __builtin_amdgcn_permlane16_swap(pack2(acc[2 * pp][mf][2], acc[2 * pp][mf][3]), pack2(acc[2 * pp + 1][mf][2], acc[2 * pp + 1][mf][3]), false, false);
      const int n = n0 + wn * 64 + (2 * pp + (q & 1)) * 16 + (q >> 1) * 8;
      uint4 o; o.x = rx[0]; o.y = ry[0]; o.z = rx[1]; o.w = ry[1];
      *(uint4*)af(m, n) = o;
    }
    __builtin_amdgcn_sched_barrier(0);
  }
}
template <int MI> DI void zero_acc(f32x4 (&acc)[4][2 * MI]) {
#pragma unroll
  for (int a = 0; a < 4; ++a)
#pragma unroll
    for (int b = 0; b < 2 * MI; ++b) { acc[a][b][0] = 0.f; acc[a][b][1] = 0.f; acc[a][b][2] = 0.f; acc[a][b][3] = 0.f; }
}

template <int NI> DI void gemm_h(f32x16 (&acc)[NI][2], const u16* __restrict__ A, long lda, const u16* __restrict__ Bt, long ldb, int K, char* smem) {
  const int tid = htid(), lane = tid & 63, wid = tid >> 6;
  const int wm = wid >> 1, wn = wid & 1;
  const int r32 = lane & 31, h = lane >> 5;
  const int lr = tid >> 3, lc = tid & 7;
  const u16* ga = A + (long)lr * lda + lc * 8;
  const u16* gb = Bt + (long)lr * ldb + lc * 8;
  const int soff = lr * 128 + ((lc ^ ((lr & 7) ^ ((lr >> 3) & 1))) << 4);
  uint4 ra[4], rb[2 * NI];
  const int nk = K >> 6;
#pragma unroll
  for (int i = 0; i < 4; ++i) ra[i] = *(const uint4*)(ga + (long)(32 * i) * lda);
#pragma unroll
  for (int i = 0; i < 2 * NI; ++i) rb[i] = *(const uint4*)(gb + (long)(32 * i) * ldb);
#pragma unroll
  for (int i = 0; i < 4; ++i) *(uint4*)(smem + soff + i * 4096) = ra[i];
#pragma unroll
  for (int i = 0; i < 2 * NI; ++i) *(uint4*)(smem + 16384 + soff + i * 4096) = rb[i];
  __syncthreads();
  const int sw = (r32 & 7) ^ ((r32 >> 3) & 1);
  for (int kt = 0; kt < nk; ++kt) {
    const bool more = (kt + 1 < nk);
    if (more) {
      ga += 64; gb += 64;
#pragma unroll
      for (int i = 0; i < 4; ++i) ra[i] = *(const uint4*)(ga + (long)(32 * i) * lda);
#pragma unroll
      for (int i = 0; i < 2 * NI; ++i) rb[i] = *(const uint4*)(gb + (long)(32 * i) * ldb);
    }
    const char* sa = smem + (kt & 1) * 32768;
    const char* sb = sa + 16384;
#pragma unroll
    for (int ks = 0; ks < 4; ++ks) {
      bf16x8 fa[NI], fb[2];
      const int coff = ((ks * 2 + h) ^ sw) << 4;
#pragma unroll
      for (int ni = 0; ni < NI; ++ni) fa[ni] = *(const bf16x8*)(sb + (wn * (32 * NI) + ni * 32 + r32) * 128 + coff);
#pragma unroll
      for (int mi = 0; mi < 2; ++mi) fb[mi] = *(const bf16x8*)(sa + (wm * 64 + mi * 32 + r32) * 128 + coff);
#pragma unroll
      for (int ni = 0; ni < NI; ++ni)
#pragma unroll
        for (int mi = 0; mi < 2; ++mi) acc[ni][mi] = MFMA32(fa[ni], fb[mi], acc[ni][mi]);
    }
    if (more) {
      char* d = smem + ((kt + 1) & 1) * 32768;
#pragma unroll
      for (int i = 0; i < 4; ++i) *(uint4*)(d + soff + i * 4096) = ra[i];
#pragma unroll
      for (int i = 0; i < 2 * NI; ++i) *(uint4*)(d + 16384 + soff + i * 4096) = rb[i];
    }
    __syncthreads();
  }
}

template <int NI, class F> DI void epi_h(const f32x16 (&acc)[NI][2], int m0, int n0, F f) {
  const int lane = htid() & 63, wid = htid() >> 6, wm = wid >> 1, wn = wid & 1, r32 = lane & 31, h = lane >> 5;
#pragma unroll
  for (int ni = 0; ni < NI; ++ni)
#pragma unroll
    for (int mi = 0; mi < 2; ++mi) {
      const int m = m0 + wm * 64 + mi * 32 + r32;
#pragma unroll
      for (int g4 = 0; g4 < 4; ++g4) {
        const int n = n0 + wn * (32 * NI) + ni * 32 + 8 * g4 + 4 * h;
        f(m, n, acc[ni][mi][4 * g4 + 0], acc[ni][mi][4 * g4 + 1], acc[ni][mi][4 * g4 + 2], acc[ni][mi][4 * g4 + 3]);
      }
    }
}

DI int srccol(int mode, int param, int n) {
  if (mode == 0) return n + param;
  if (mode == 1) { if (n < 4608) return n; if (n < 6656) return n + 48; if (n < 6704) return n - 2048; return -1; }
  if (mode == 3) return (n < 48) ? (4608 + n) : -1;
  const int blk = n >> 6, w = n & 63;
  return (w < 32) ? (blk * 32 + w) : (2816 + blk * 32 + (w - 32));
}
DI void conv_tile(const float* __restrict__ src, int lds_, u16* __restrict__ dst, int K, int mode, int param, int tile, char* smem) {
  const int tid = htid();
  const int ntk = K >> 6;
  const int k0 = (tile % ntk) * 64, n0 = (tile / ntk) * 64;
  float* tl = (float*)smem;
  {
    const int c = tid & 63, i0 = tid >> 6;
    const int sc = srccol(mode, param, n0 + c);
#pragma unroll
    for (int j = 0; j < 16; ++j) { const int k = i0 + 4 * j; tl[k * 65 + c] = (sc >= 0) ? src[(long)(k0 + k) * lds_ + sc] : 0.f; }
  }
  __syncthreads();
#pragma unroll
  for (int jj = 0; jj < 2; ++jj) {
    const int nl = (tid >> 3) + 32 * jj, kc = tid & 7;
    float v[8];
#pragma unroll
    for (int e = 0; e < 8; ++e) v[e] = tl[(kc * 8 + e) * 65 + nl];
    uint4 o; o.x = pack2(v[0], v[1]); o.y = pack2(v[2], v[3]); o.z = pack2(v[4], v[5]); o.w = pack2(v[6], v[7]);
    *(uint4*)(dst + (long)(n0 + nl) * K + k0 + kc * 8) = o;
  }
  __syncthreads();
}

constexpr int CONV1_TILES = 1728 + 768 + 768 + 256 + 8 + 16;
constexpr int CONV1_ITEMS = CONV1_TILES + 8 + 32;
DI void conv1_item(const Params& p, int l, int t, char* smem) {
  char* w1 = p.ws + OFF_W1;
  const int tid = htid();
  if (t < CONV1_TILES) {
    const float* win = p.in[5] + (long)l * 1024 * 9776;
    if (t < 1728) { conv_tile(win, 9776, (u16*)(w1 + W1_WIN), 1024, 1, 0, t, smem); return; }
    t -= 1728;
    if (t < 768) { conv_tile(win, 9776, (u16*)(w1 + W1_WMG), 1024, 0, 6704, t, smem); return; }
    t -= 768;
    if (t < 768) { const int k = t >> 8; conv_tile(p.in[23 + k] + (long)l * 1048576, 1024, (u16*)(w1 + W1_WBR) + (long)k * 1048576, 1024, 0, 0, t & 255, smem); return; }
    t -= 768;
    if (t < 256) { const int kv = t >> 7; conv_tile(p.in[kv ? 14 : 12] + (long)l * 524288, 256, (u16*)(w1 + (kv ? W1_WV1 : W1_WK1)), 2048, 0, 0, t & 127, smem); return; }
    t -= 256;
    if (t < 8) { const int kv = t >> 2; conv_tile(p.in[kv ? 15 : 13] + (long)l * 16384, 64, (u16*)(w1 + (kv ? W1_WV2 : W1_WK2)), 256, 0, 0, t & 3, smem); return; }
    t -= 8;
    { conv_tile(win, 9776, (u16*)(w1 + W1_WNS), 1024, 3, 0, t, smem); return; }
  }
  t -= CONV1_TILES;
  if (t < 8) {
    const int kv = t >> 2, jg = t & 3;
    const float* pe = p.in[10 + kv] + (long)l * 2048;
    const float* w = p.in[kv ? 14 : 12] + (long)l * 524288;
    const int j = jg * 64 + (tid & 63), ksl = tid >> 6;
    float s = 0.f;
    for (int kk = ksl * 512; kk < ksl * 512 + 512; kk += 16) {
      float wv[16];
#pragma unroll
      for (int u = 0; u < 16; ++u) wv[u] = w[(long)(kk + u) * 256 + j];
#pragma unroll
      for (int u = 0; u < 16; ++u) s += pe[kk + u] * wv[u];
    }
    float* red = (float*)smem;
    red[tid] = s;
    __syncthreads();
    if (tid < 64) { float r = red[tid] + red[tid + 64] + red[tid + 128] + red[tid + 192]; ((float*)(p.ws + OFF_SM + SM_CKV))[kv * 256 + jg * 64 + tid] = r; }
    __syncthreads();
    return;
  }
  t -= 8;
  {
    const float* wsrc = p.in[8] + (long)l * 65536;
    u16* dst = (u16*)(p.ws + OFF_SM + SM_WSB);
    const int e0 = t * 2048 + tid * 8;
    const int tt = (e0 >> 7) & 127, s0 = e0 & 127;
    float v[8];
#pragma unroll
    for (int e = 0; e < 8; ++e) v[e] = (s0 + e <= tt) ? wsrc[e0 + e] : 0.f;
    uint4 o; o.x = pack2(v[0], v[1]); o.y = pack2(v[2], v[3]); o.z = pack2(v[4], v[5]); o.w = pack2(v[6], v[7]);
    *(uint4*)(dst + e0) = o;
  }
}
constexpr int CONV2_TILES = 256 + 1408 + 704;
DI void conv2_item(const Params& p, int l, int t, char* smem) {
  char* w2 = p.ws + OFF_W2;
  if (t < 256) { conv_tile(p.in[26] + (long)l * 1048576, 1024, (u16*)(w2 + W2_WO), 1024, 0, 0, t, smem); return; }
  t -= 256;
  if (t < 1408) { conv_tile(p.in[27] + (long)l * 1024 * 5632, 5632, (u16*)(w2 + W2_WFI), 1024, 2, 0, t, smem); return; }
  t -= 1408;
  conv_tile(p.in[28] + (long)l * 2816 * 1024, 1024, (u16*)(w2 + W2_WFO), 2816, 0, 0, t, smem);
}

DI void row_item(int item, const float* __restrict__ res_in, const u16* __restrict__ delta, const float* __restrict__ g_post,
                 float* __restrict__ res_out, const float* __restrict__ g_next, u16* __restrict__ hnext, unsigned long long* __restrict__ stats) {
  const int lane = otid() & 63;
  const long row = (long)item * 8 + (otid() >> 6);
  float x[16];
#pragma unroll
  for (int j = 0; j < 4; ++j) { const float4 v = *(const float4*)(res_in + row * 1024 + j * 256 + lane * 4); x[4 * j] = v.x; x[4 * j + 1] = v.y; x[4 * j + 2] = v.z; x[4 * j + 3] = v.w; }
  if (delta) {
    float d[16]; float ss = 0.f;
#pragma unroll
    for (int j = 0; j < 4; ++j) { const uint2 v = *(const uint2*)(delta + row * 1024 + j * 256 + lane * 4); d[4 * j] = bflo(v.x); d[4 * j + 1] = bfhi(v.x); d[4 * j + 2] = bflo(v.y); d[4 * j + 3] = bfhi(v.y); }
#pragma unroll
    for (int i = 0; i < 16; ++i) ss += d[i] * d[i];
    ss = wave_sum(ss);
    const float rs = rsqrtf(ss * (1.f / 1024.f) + 1e-6f);
#pragma unroll
    for (int j = 0; j < 4; ++j) {
      const float4 g = *(const float4*)(g_post + j * 256 + lane * 4);
      x[4 * j] += d[4 * j] * rs * g.x; x[4 * j + 1] += d[4 * j + 1] * rs * g.y; x[4 * j + 2] += d[4 * j + 2] * rs * g.z; x[4 * j + 3] += d[4 * j + 3] * rs * g.w;
      float4 o; o.x = x[4 * j]; o.y = x[4 * j + 1]; o.z = x[4 * j + 2]; o.w = x[4 * j + 3];
      *(float4*)(res_out + row * 1024 + j * 256 + lane * 4) = o;
    }
  }
  if (hnext) {
    if (stats && lane < 2) { unsigned long long zz = 0ull; asm volatile("" : "+v"(zz)); stats[row * 2 + lane] = zz; }
    float ss = 0.f;
#pragma unroll
    for (int i = 0; i < 16; ++i) ss += x[i] * x[i];
    ss = wave_sum(ss);
    const float rs = rsqrtf(ss * (1.f / 1024.f) + 1e-6f);
#pragma unroll
    for (int j = 0; j < 4; ++j) {
      const float4 g = *(const float4*)(g_next + j * 256 + lane * 4);
      store4bf(hnext + row * 1024 + j * 256 + lane * 4, x[4 * j] * rs * g.x, x[4 * j + 1] * rs * g.y, x[4 * j + 2] * rs * g.z, x[4 * j + 3] * rs * g.w);
    }
  }
}

DI bool xcd_tile(int round, int NT, int& mt, int& nt) {
  const int bid = blockIdx.x, x = bid & 7, lb = bid >> 3;
  const int ti = round * 32 + lb;
  mt = x * 8 + (ti & 7); nt = ti >> 3;
  return nt < NT;
}
DI TileSrc srcB(const Params& p, int item) {
  const int nt = item % 27, mt = item / 27;
  TileSrc t; t.A = (const u16*)(p.ws + OFF_HB) + (long)mt * 256 * 1024; t.lda = 1024; t.Bt = (const u16*)(p.ws + OFF_W1 + W1_WIN) + (long)nt * 256 * 1024; t.ldb = 1024;
  return t;
}
DI void phaseB_tile(const Params& p, int item, char* smem, Stg& st, bool pre, int nitem, bool hasnxt) {
  const int nt = item % 27, mt = item / 27;
  const int m0 = mt * 256, n0 = nt * 256;
  char* ws = p.ws;
  f32x4 acc[4][8];
  zero_acc<4>(acc);
  gemm512<4, 4>(acc, srcB(p, item), 1024, smem, st, pre, srcB(p, nitem), hasnxt);
  if (n0 < 1024) {
    u16* U = (u16*)(ws + OFF_U);
    epi512_rows16<4, 4>(acc, m0, n0, U, 1024, 0, [](float v) { return geluf_(v); });
  } else if (n0 < 2048) {
    u16* G = (u16*)(ws + OFF_GV);
    unsigned long long* stats = (unsigned long long*)(ws + OFF_SM + SM_STATS);
    const int tid = otid(), lane = tid & 63, wid = tid >> 6, wm = wid >> 2, wn = wid & 3, r16 = lane & 15, q = lane >> 4;
#pragma unroll
    for (int mf = 0; mf < 8; ++mf) {
      const int m = m0 + wm * 128 + mf * 16 + r16;
      float s1 = 0.f, s2 = 0.f;
#pragma unroll
      for (int nf = 0; nf < 4; ++nf) {
        const int d = n0 - 1024 + wn * 64 + nf * 16 + q * 4;
        float gg[4];
#pragma unroll
        for (int e = 0; e < 4; ++e) { gg[e] = geluf_(acc[nf][mf][e]); s1 += gg[e]; s2 += gg[e] * gg[e]; }
        const int odd = lane & 1;
        const float r0 = lane_swap1(odd ? gg[0] : gg[1]), r1 = lane_swap1(odd ? gg[2] : gg[3]);
        unsigned* gp = (unsigned*)(G + ((long)(m >> 7) * 1024 + d + odd) * 128 + ((m & 127) - odd));
        gp[0] = odd ? pack2(r0, gg[1]) : pack2(gg[0], r0);
        gp[128] = odd ? pack2(r1, gg[3]) : pack2(gg[2], r1);
      }
      s1 += __shfl_xor(s1, 16); s2 += __shfl_xor(s2, 16);
      s1 += __shfl_xor(s1, 32); s2 += __shfl_xor(s2, 32);
      if (q == 0) {
        atomicAdd(stats + (long)m * 2, (unsigned long long)(long long)__float2ll_rn(s1 * 16777216.f));
        atomicAdd(stats + (long)m * 2 + 1, (unsigned long long)(long long)__float2ll_rn(s2 * 16777216.f));
      }
      __builtin_amdgcn_sched_barrier(0);
    }
  } else if (n0 < 3072) {
    u16* Q = (u16*)(ws + OFF_Q);
    epi512_rows16<4, 4>(acc, m0, n0, Q, 1024, -2048, [](float v) { return v; });
  } else if (n0 < 4608) {
    const int i6 = (n0 - 3072) >> 8;
    u16* base = (u16*)(ws + OFF_KV) + (long)i6 * KV_ELEMS;
    if (i6 == 3 || i6 == 5) {
      epi512<4, 4>(acc, m0, n0, [&](int m, int n, float a, float b, float c, float d) {
        const int cc = n - 3072, g = (cc >> 6) & 3, dd = cc & 63, bb = m >> 11, s = m & 2047;
        const int odd = (int)__builtin_amdgcn_workitem_id_x() & 1;
        const float r0 = lane_swap1(odd ? a : b), r1 = lane_swap1(odd ? c : d);
        unsigned* q = (unsigned*)(base + ((long)(bb * 4 + g) * 64 + dd + odd) * 2048 + (s - odd));
        q[0] = odd ? pack2(r0, b) : pack2(a, r0);
        q[2048] = odd ? pack2(r1, d) : pack2(c, r1);
      });
    } else {
      epi512_rows16_at<4, 4>(acc, m0, n0, [&](int m, int n) {
        const int cc = n - 3072, g = (cc >> 6) & 3, dd = cc & 63, bb = m >> 11, s = m & 2047;
        return base + ((long)(bb * 4 + g) * 2048 + s) * 64 + dd;
      });
    }
  } else if (n0 < 5632) {
    u16* X = (u16*)(ws + OFF_XR);
    epi512_rows16<4, 4>(acc, m0, n0, X, 1024, -4608, [](float v) { return v; });
  } else if (n0 < 6656) {
    u16* R = (u16*)(ws + OFF_RG);
    epi512_rows16<4, 4>(acc, m0, n0, R, 1024, -5632, [](float v) { return geluf_(v); });
  } else {
    float* NG = (float*)(ws + OFF_NG);
    epi512<4, 4>(acc, m0, n0, [&](int m, int n, float a, float b, float c, float d) {
      const int cc = n - 6656;
      if (cc < 48) { float4 o; o.x = sigmoidf_(a); o.y = sigmoidf_(b); o.z = sigmoidf_(c); o.w = sigmoidf_(d); *(float4*)(NG + (long)m * 48 + cc) = o; }
    });
  }
}

DI void nsa_item(const Params& p, int strip, char* smem) {
  char* ws = p.ws;
  f32x4 acc[4][2];
  zero_acc<1>(acc);
  {
    Stg st;
    TileSrc t; t.A = (const u16*)(ws + OFF_HB) + (long)strip * 256 * 1024; t.lda = 1024; t.Bt = (const u16*)(ws + OFF_W1 + W1_WNS); t.ldb = 1024;
    gemm512<1, 1>(acc, t, 1024, smem, st, false, t, false);
  }
  float* NG = (float*)(ws + OFF_NG);
  const int tid = otid(), lane = tid & 63, wid = tid >> 6, r16 = lane & 15, q = lane >> 4;
#pragma unroll
  for (int mf = 0; mf < 2; ++mf) {
    const int m = strip * 256 + wid * 32 + mf * 16 + r16;
#pragma unroll
    for (int nf = 0; nf < 3; ++nf) {
      const int c = nf * 16 + q * 4;
      float4 o; o.x = sigmoidf_(acc[nf][mf][0]); o.y = sigmoidf_(acc[nf][mf][1]); o.z = sigmoidf_(acc[nf][mf][2]); o.w = sigmoidf_(acc[nf][mf][3]);
      *(float4*)(NG + (long)m * 48 + c) = o;
    }
  }
  __syncthreads();
}
DI void phaseB_half_tile(const Params& p, int mt, int n0, char* smem) {
  const int m0 = mt * 256;
  char* ws = p.ws;
  f32x4 acc[4][4];
  zero_acc<2>(acc);
  {
    Stg st;
    TileSrc t; t.A = (const u16*)(ws + OFF_HB) + (long)m0 * 1024; t.lda = 1024; t.Bt = (const u16*)(ws + OFF_W1 + W1_WIN) + (long)n0 * 1024; t.ldb = 1024;
    gemm512<2, 2>(acc, t, 1024, smem, st, false, t, false);
  }
  u16* R = (u16*)(ws + OFF_RG);
  epi512_rows16<2, 2>(acc, m0, n0, R, 1024, -5632, [](float v) { return geluf_(v); });
}

DI void rglru_item(const Params& p, int l, int item, char* smem) {
  const int tid = htid(), lane = tid & 63, w = tid >> 6, r32 = lane & 31, h = lane >> 5;
  const int chalf = item & 1, hd = (item >> 1) & 15, b = item >> 5;
  char* xcb = smem;
  char* WT = smem + 18432;
  float* AL = (float*)(smem + 27648);
  float* BL = (float*)(smem + 44544);
  float* segP = (float*)(smem + 61440);
  float* segH = (float*)(smem + 62464);
  float* carry = (float*)(smem + 63488);
  const u16* XR = (const u16*)(p.ws + OFF_XR);
  u16* RG = (u16*)(p.ws + OFF_RG);
  {
    const float* wa = p.in[18] + (long)l * 65536 + (long)hd * 4096;
    const float* wx = p.in[20] + (long)l * 65536 + (long)hd * 4096;
#pragma unroll 4
    for (int e = 0; e < 16; ++e) {
      const int idx = tid + 256 * e;
      const int gate = idx >> 11, i = (idx >> 5) & 63, o = idx & 31;
      const float v = (gate ? wx : wa)[i * 64 + chalf * 32 + o];
      ((u16*)WT)[((o >> 4) * 32 + gate * 16 + (o & 15)) * 72 + i] = f2bf(v);
    }
    if (tid < 64) carry[tid] = 0.f;
  }
  const int cc = tid & 63, tg = tid >> 6;
  float cw[4];
#pragma unroll
  for (int jj = 0; jj < 4; ++jj) cw[jj] = p.in[16][(long)l * 4096 + jj * 1024 + hd * 64 + cc];
  const float cb = p.in[17][(long)l * 1024 + hd * 64 + cc];
  const int wr = w & 1, mth = w >> 1;
  float ba[8], bx[8], sp[8];
#pragma unroll
  for (int e = 0; e < 8; ++e) {
    const int rho = (e & 3) + 8 * (e >> 2) + 4 * h;
    const int c = hd * 64 + chalf * 32 + wr * 16 + rho;
    ba[e] = p.in[19][(long)l * 1024 + c]; bx[e] = p.in[21][(long)l * 1024 + c];
    sp[e] = -8.f * log1pf(expf(-p.in[22][(long)l * 1024 + c]));
  }
  const int scl = tid & 31, seg = tid >> 5;
  float xn[35];
  {
    const u16* xp = XR + ((long)b * 2048 + tg * 32) * 1024 + hd * 64 + cc;
#pragma unroll
    for (int jj = 0; jj < 35; ++jj) { const int s = tg * 32 + jj - 3; xn[jj] = (s >= 0) ? bf2f(xp[(long)(jj - 3) * 1024]) : 0.f; }
  }
  __syncthreads();
#pragma unroll 1
  for (int ch = 0; ch < 16; ++ch) {
    const int s0 = ch * 128;
    u16* rp = RG + ((long)b * 2048 + s0 + seg * 16) * 1024 + hd * 64 + chalf * 32 + scl;
    float rgv[16];
#pragma unroll
    for (int jj = 0; jj < 16; ++jj) rgv[jj] = bf2f(rp[(long)jj * 1024]);
#pragma unroll
    for (int tt = 0; tt < 32; ++tt) {
      const float v = cb + cw[0] * xn[tt] + cw[1] * xn[tt + 1] + cw[2] * xn[tt + 2] + cw[3] * xn[tt + 3];
      ((u16*)xcb)[(tg * 32 + tt) * 72 + cc] = f2bf(v);
    }
    if (ch + 1 < 16) {
      const u16* xp = XR + ((long)b * 2048 + s0 + 128 + tg * 32) * 1024 + hd * 64 + cc;
#pragma unroll
      for (int jj = 0; jj < 35; ++jj) xn[jj] = bf2f(xp[(long)(jj - 3) * 1024]);
    }
    __syncthreads();
#pragma unroll
    for (int m2 = 0; m2 < 2; ++m2) {
      const int mt = mth * 2 + m2;
      f32x16 acc = zero16();
#pragma unroll
      for (int ks = 0; ks < 4; ++ks) {
        const bf16x8 fa = *(const bf16x8*)(WT + (wr * 32 + r32) * 144 + ks * 32 + h * 16);
        const bf16x8 fb = *(const bf16x8*)(xcb + (mt * 32 + r32) * 144 + ks * 32 + h * 16);
        acc = MFMA32(fa, fb, acc);
      }
      const int t = mt * 32 + r32;
#pragma unroll
      for (int e = 0; e < 8; ++e) {
        const int rho = (e & 3) + 8 * (e >> 2) + 4 * h;
        const int cl = wr * 16 + rho;
        const float r = sigmoidf_(acc[e] + ba[e]), ii = sigmoidf_(acc[e + 8] + bx[e]);
        const float la = r * sp[e];
        const float a = __expf(la);
        const float om2 = fmaxf(__builtin_fmaf(-a, a, 1.f), 0.f);
        const float xcv = bf2f(((const u16*)xcb)[t * 72 + chalf * 32 + cl]);
        AL[t * 33 + cl] = a;
        BL[t * 33 + cl] = __builtin_amdgcn_sqrtf(om2) * ii * xcv;
      }
    }
    __syncthreads();
    {
      float a[16], bq[16];
      float P = 1.f, H = 0.f;
#pragma unroll
      for (int jj = 0; jj < 16; ++jj) { a[jj] = AL[(seg * 16 + jj) * 33 + scl]; bq[jj] = BL[(seg * 16 + jj) * 33 + scl]; H = a[jj] * H + bq[jj]; P *= a[jj]; }
      segP[seg * 32 + scl] = P; segH[seg * 32 + scl] = H;
      __syncthreads();
      float hh = carry[(ch & 1) * 32 + scl];
      for (int s2 = 0; s2 < seg; ++s2) hh = segP[s2 * 32 + scl] * hh + segH[s2 * 32 + scl];
#pragma unroll
      for (int jj = 0; jj < 16; ++jj) { hh = a[jj] * hh + bq[jj]; rp[(long)jj * 1024] = f2bf(hh * rgv[jj]); }
      if (seg == 7) carry[((ch + 1) & 1) * 32 + scl] = hh;
    }
  }
  __syncthreads();
}

DI void compress_item(const Params& p, int item, char* smem) {
  const int tid = otid(), lane = tid & 63, w = tid >> 6, r32 = lane & 31, h = lane >> 5;
  const int kv = item & 1, mt = item >> 1;
  char* ws = p.ws;
  const u16* w2T = (const u16*)(ws + OFF_W1 + (kv ? W1_WV2 : W1_WK2));
  const float* cb = (const float*)(ws + OFF_SM + SM_CKV) + kv * 256;
  u16* hid = (u16*)(ws + OFF_SM + SM_HID) + (long)item * 65536;
  {
    TileSrc src; src.A = (const u16*)(ws + OFF_KV) + (long)kv * KV_ELEMS + (long)mt * 256 * 1024; src.lda = 1024;
    src.Bt = (const u16*)(ws + OFF_W1 + (kv ? W1_WV1 : W1_WK1)); src.ldb = 2048;
    f32x4 acc[4][8];
    zero_acc<4>(acc);
    Stg st;
    gemm512<4, 4>(acc, src, 2048, smem, st, false, src, false);
    epi512<4, 4>(acc, 0, 0, [&](int m, int n, float a, float b, float c, float d) {
      const float4 cv = *(const float4*)(cb + n);
      store4bf(hid + m * 256 + n, geluf_(a + cv.x), geluf_(b + cv.y), geluf_(c + cv.z), geluf_(d + cv.w));
    });
  }
  __syncthreads();
  f32x16 o2[2]; o2[0] = zero16(); o2[1] = zero16();
#pragma unroll 4
  for (int ks = 0; ks < 16; ++ks) {
    const bf16x8 fb = *(const bf16x8*)(hid + (w * 32 + r32) * 256 + ks * 16 + h * 8);
#pragma unroll
    for (int dt = 0; dt < 2; ++dt) {
      const bf16x8 fa = *(const bf16x8*)(w2T + (dt * 32 + r32) * 256 + ks * 16 + h * 8);
      o2[dt] = MFMA32(fa, fb, o2[dt]);
    }
  }
  const int R = mt * 256 + w * 32 + r32;
  const int bg = R >> 7, n = R & 127;
  const bool dead = (n == 127);
  if (kv == 0) {
    u16* KC = (u16*)(ws + OFF_SM + SM_KC) + (long)bg * 8192;
#pragma unroll
    for (int dt = 0; dt < 2; ++dt)
#pragma unroll
      for (int g4 = 0; g4 < 4; ++g4) {
        const int d = dt * 32 + 8 * g4 + 4 * h;
        if (dead) store4bf(KC + n * 64 + d, 0.f, 0.f, 0.f, 0.f);
        else store4bf(KC + n * 64 + d, o2[dt][4 * g4], o2[dt][4 * g4 + 1], o2[dt][4 * g4 + 2], o2[dt][4 * g4 + 3]);
      }
  } else {
    u16* VCT = (u16*)(ws + OFF_SM + SM_VCT) + (long)bg * 8192;
#pragma unroll
    for (int dt = 0; dt < 2; ++dt)
#pragma unroll
      for (int i = 0; i < 16; ++i) {
        const int d = dt * 32 + (i & 3) + 8 * (i >> 2) + 4 * h;
        VCT[d * 128 + n] = dead ? (u16)0 : f2bf(o2[dt][i]);
      }
  }
  __syncthreads();
}

DI void gmlp_item(const Params& p, int l, int item4, char* smem) {
  const int tid = htid(), lane = tid & 63, w = tid >> 6, r32 = lane & 31, h = lane >> 5;
  const int item = item4 >> 2, g = item4 & 3;
  const long t0 = (long)item * 128;
  char* ws = p.ws;
  const u16* GVT = (const u16*)(ws + OFF_GV) + (long)item * 1024 * 128;
  u16* U = (u16*)(ws + OFF_U);
  const u16* WSB = (const u16*)(ws + OFF_SM + SM_WSB) + (long)g * 16384;
  const long long* stats = (const long long*)(ws + OFF_SM + SM_STATS) + t0 * 2;
  const float* lng = p.in[6] + (long)l * 1024;
  const float* lnb = p.in[7] + (long)l * 1024;
  const float* bs = p.in[9] + (long)l * 512 + g * 128;
  char* ap = smem;
  float* mu = (float*)(smem + 34816);
  float* rs = mu + 128;
  float* c1 = rs + 128;
  float* c2 = c1 + 128;
  if (tid < 128) {
    const float m = (float)stats[tid * 2] * (1.f / 16777216.f / 1024.f);
    const float var = (float)stats[tid * 2 + 1] * (1.f / 16777216.f / 1024.f) - m * m;
    mu[tid] = m; rs[tid] = rsqrtf(fmaxf(var, 0.f) + 1e-6f);
  }
  __syncthreads();
#pragma unroll 2
  for (int i = 0; i < 8; ++i) {
    const int idx = tid + 256 * i;
    const int t = idx >> 4, ch = (idx & 15) * 8;
    const uint4 wv = *(const uint4*)(WSB + t * 128 + ch);
    const unsigned wu[4] = {wv.x, wv.y, wv.z, wv.w};
    float a1 = 0.f, a2 = 0.f;
    uint4 o;
    unsigned* ou = (unsigned*)&o;
#pragma unroll
    for (int e = 0; e < 4; ++e) {
      const float w0 = bflo(wu[e]), w1 = bfhi(wu[e]);
      const unsigned pk = pack2(w0 * rs[ch + 2 * e], w1 * rs[ch + 2 * e + 1]);
      ou[e] = pk;
      a1 += bflo(pk) * mu[ch + 2 * e] + bfhi(pk) * mu[ch + 2 * e + 1];
      a2 += w0 + w1;
    }
    *(uint4*)(ap + t * 272 + ch * 2) = o;
#pragma unroll
    for (int off = 8; off >= 1; off >>= 1) { a1 += __shfl_xor(a1, off); a2 += __shfl_xor(a2, off); }
    if ((idx & 15) == 0) { c1[t] = a1; c2[t] = a2; }
  }
  __syncthreads();
#pragma unroll 1
  for (int dh = 0; dh < 2; ++dh) {
    const int c0 = g * 256 + dh * 128;
    bf16x8 fa[8];
#pragma unroll
    for (int ks = 0; ks < 8; ++ks) fa[ks] = *(const bf16x8*)(GVT + (long)(c0 + w * 32 + r32) * 128 + ks * 16 + h * 8);
    f32x16 acc[4];
#pragma unroll
    for (int mi = 0; mi < 4; ++mi) acc[mi] = zero16();
#pragma unroll
    for (int ks = 0; ks < 8; ++ks) {
#pragma unroll
      for (int mi = 0; mi < 4; ++mi) {
        if (mi >= (ks >> 1)) {
          const bf16x8 fb = *(const bf16x8*)(ap + (mi * 32 + r32) * 272 + ks * 32 + h * 16);
          acc[mi] = MFMA32(fa[ks], fb, acc[mi]);
        }
      }
    }
#pragma unroll
    for (int mi = 0; mi < 4; ++mi) {
      const int t = mi * 32 + r32;
      const float k1 = c1[t], k2 = c2[t], bias = bs[t];
#pragma unroll
      for (int g4 = 0; g4 < 4; ++g4) {
        const int d = c0 + w * 32 + 8 * g4 + 4 * h;
        const float4 gg = *(const float4*)(lng + d), bb = *(const float4*)(lnb + d);
        u16* up = U + (t0 + t) * 1024 + d;
        const uint2 uv = *(const uint2*)up;
        store4bf(up, bflo(uv.x) * (gg.x * (acc[mi][4 * g4] - k1) + bb.x * k2 + bias), bfhi(uv.x) * (gg.y * (acc[mi][4 * g4 + 1] - k1) + bb.y * k2 + bias),
                 bflo(uv.y) * (gg.z * (acc[mi][4 * g4 + 2] - k1) + bb.z * k2 + bias), bfhi(uv.y) * (gg.w * (acc[mi][4 * g4 + 3] - k1) + bb.w * k2 + bias));
      }
    }
  }
  __syncthreads();
}

DI void load_tile64(char* dst, const u16* __restrict__ src, long stride) {
  const int tid = htid();
#pragma unroll
  for (int i = 0; i < 2; ++i) { const int idx = tid + 256 * i; const int r = idx >> 3, c = idx & 7; *(uint4*)(dst + r * 144 + c * 16) = *(const uint4*)(src + (long)r * stride + c * 8); }
}
DI f32x16 qk_sub(const char* ldsK, int kr0, const bf16x8 (&qf)[4], int r32, int h) {
  f32x16 s = zero16();
#pragma unroll
  for (int ks = 0; ks < 4; ++ks) { const bf16x8 kf = *(const bf16x8*)(ldsK + (kr0 + r32) * 144 + ks * 32 + h * 16); s = MFMA32(kf, qf[ks], s); }
  return s;
}
DI void pv_sub(f32x16 (&o)[2], const char* ldsV, int key0, const f32x16& pt, int r32, int h) {
#pragma unroll
  for (int s2 = 0; s2 < 2; ++s2) {
    union { uint4 u; bf16x8 v; } pb;
    pb.u.x = pack2(pt[8 * s2 + 0], pt[8 * s2 + 1]); pb.u.y = pack2(pt[8 * s2 + 2], pt[8 * s2 + 3]);
    pb.u.z = pack2(pt[8 * s2 + 4], pt[8 * s2 + 5]); pb.u.w = pack2(pt[8 * s2 + 6], pt[8 * s2 + 7]);
#pragma unroll
    for (int dt = 0; dt < 2; ++dt) {
      const char* vp = ldsV + (dt * 32 + r32) * 136 + (key0 + 16 * s2 + 4 * h) * 2;
      union { uint4 u; bf16x8 v; } vf;
      const uint2 lo = *(const uint2*)vp, hi = *(const uint2*)(vp + 16);
      vf.u.x = lo.x; vf.u.y = lo.y; vf.u.z = hi.x; vf.u.w = hi.y;
      o[dt] = MFMA32(vf.v, pb.v, o[dt]);
    }
  }
}
#define LOG2E_F 1.4426950408889634f
DI void flash_tile(f32x16 (&O)[2], float& m_run, float& l_run, const char* ldsK, const char* ldsV,
                                          const bf16x8 (&qf)[4], int hi, int lo, int r32, int h) {
  f32x16 s[2];
  s[0] = qk_sub(ldsK, 0, qf, r32, h); s[1] = qk_sub(ldsK, 32, qf, r32, h);
  const bool full = (hi >= 59) && (lo < 0);
  bool rowsel = true;
  if (__builtin_amdgcn_ballot_w64(full) != ~0ull) {
    const bool rowmask = (lo < 0) && (hi >= 59 || hi < 0);
    if (__builtin_amdgcn_ballot_w64(rowmask) == ~0ull) {
      rowsel = hi >= 0;
    } else {
#pragma unroll
      for (int sub = 0; sub < 2; ++sub)
#pragma unroll
        for (int i = 0; i < 16; ++i) {
          const int c = sub * 32 + (i & 3) + 8 * (i >> 2);
          s[sub][i] = (c <= hi && c > lo) ? s[sub][i] : -1e30f;
        }
    }
  }
  float mt = fmaxf(s[0][0], s[1][0]);
#pragma unroll
  for (int i = 1; i < 16; ++i) mt = fmaxf(mt, fmaxf(s[0][i], s[1][i]));
  mt = fmaxf(mt, __shfl_xor(mt, 32));
  mt = rowsel ? mt : -1e30f;
  const float m_new = fmaxf(m_run, mt);
  const float mc = rowsel ? fmaxf(m_new, -1e20f) * LOG2E_F : 1e30f;
  float ls = 0.f;
#pragma unroll
  for (int sub = 0; sub < 2; ++sub)
#pragma unroll
    for (int i = 0; i < 16; ++i) { const float pv = __builtin_amdgcn_exp2f(__builtin_fmaf(s[sub][i], LOG2E_F, -mc)); s[sub][i] = pv; ls += pv; }
  if (__builtin_amdgcn_ballot_w64(m_new != m_run) != 0ull) {
    const float alpha = __builtin_amdgcn_exp2f((m_run - fmaxf(m_new, -1e20f)) * LOG2E_F);
    l_run *= alpha;
#pragma unroll
    for (int dt = 0; dt < 2; ++dt)
#pragma unroll
      for (int i = 0; i < 16; ++i) O[dt][i] *= alpha;
  }
  l_run += ls; m_run = m_new;
  pv_sub(O, ldsV, 0, s[0], r32, h);
  pv_sub(O, ldsV, 32, s[1], r32, h);
}

DI void attn_item(const Params& p, int item, char* smem) {
  const int tid = otid(), lane = tid & 63, w = tid >> 6, r32 = lane & 31, h = lane >> 5;
  const int bg = item & 31, kk = (item >> 5) & 7, rr = (item >> 8) & 3;
  const int qt = (item & 0x10000) ? (31 - ((item >> 5) & 31))
                                  : ((rr == 0) ? (31 - kk) : ((rr == 1) ? (16 + kk) : ((rr == 2) ? (15 - kk) : kk)));
  const int b = bg >> 2, g = bg & 3;
  const int t0 = qt * 64, t = t0 + (w >> 2) * 32 + r32, cur = qt;
  const int hd = g * 4 + (w & 3);
  const long tok = (long)b * 2048 + t;
  char* ws = p.ws;
  u16* Q = (u16*)(ws + OFF_Q);
  float* impA = (float*)(smem + 36864);
  float* impB = (float*)(smem + 70656);
  float* impT = (float*)(smem + 104448);
  unsigned* selm = (unsigned*)(smem + 112896);
  const int lr = tid >> 3, lc = tid & 7;
  const int ldoff = lr * 144 + lc * 16;
  const u16* KS = (const u16*)(ws + OFF_KV) + 2 * KV_ELEMS + (long)bg * 131072;
  const u16* VST = (const u16*)(ws + OFF_KV) + 3 * KV_ELEMS + (long)bg * 131072;
  const u16* KW = (const u16*)(ws + OFF_KV) + 4 * KV_ELEMS + (long)bg * 131072;
  const u16* VWT = (const u16*)(ws + OFF_KV) + 5 * KV_ELEMS + (long)bg * 131072;
  const int jlo = (t0 - 511 > 0) ? ((t0 - 511) >> 6) : 0;
  const int ns = cur + 1, ntile = ns + (cur - jlo + 1);
  u32x4 pkA, pvA, pkB, pvB;
#define ATT_ISSUE(i_, K_, V_) do { const int ii_ = (i_); const bool sl_ = ii_ < ns; const int j_ = sl_ ? ii_ : (jlo + ii_ - ns); \
    K_ = *(const u32x4*)((sl_ ? KS : KW) + (long)j_ * 4096 + lr * 64 + lc * 8); \
    V_ = *(const u32x4*)((sl_ ? VST : VWT) + j_ * 64 + (long)lr * 2048 + lc * 8); } while (0)
  bf16x8 qf[4];
#pragma unroll
  for (int ks = 0; ks < 4; ++ks) {
    u32x4 x = *(const u32x4*)(Q + tok * 1024 + hd * 64 + ks * 16 + h * 8);
#pragma unroll
    for (int e = 0; e < 4; ++e) {
      const float lo = bflo(x[e]) * 0.125f, hi = bfhi(x[e]) * 0.125f;
      x[e] = (__float_as_uint(lo) >> 16) | (__float_as_uint(hi) & 0xffff0000u);
    }
    qf[ks] = __builtin_bit_cast(bf16x8, x);
  }
  const float* NG = (const float*)(ws + OFF_NG) + tok * 48 + hd * 3;
  const float g0 = NG[0], g1 = NG[1], g2 = NG[2];
  f32x16 res[2];
  {
    const u16* KC = (const u16*)(ws + OFF_SM + SM_KC) + (long)bg * 8192;
    const u16* VCT = (const u16*)(ws + OFF_SM + SM_VCT) + (long)bg * 8192;
    const int nsub = ((qt * 4 + 2) >> 5) + 1;
    {
      const u32x4 k0 = *(const u32x4*)(KC + lr * 64 + lc * 8), k1 = *(const u32x4*)(KC + 4096 + lr * 64 + lc * 8);
      const u32x4 v0 = *(const u32x4*)(VCT + lr * 128 + lc * 8), v1 = *(const u32x4*)(VCT + lr * 128 + 64 + lc * 8);
      *(u32x4*)(smem + ldoff) = k0; *(u32x4*)(smem + 18432 + ldoff) = k1;
      { const int vo = lr * 136 + lc * 16;
        uint2 a; a.x = v0[0]; a.y = v0[1]; *(uint2*)(smem + 9216 + vo) = a; a.x = v0[2]; a.y = v0[3]; *(uint2*)(smem + 9216 + vo + 8) = a;
        a.x = v1[0]; a.y = v1[1]; *(uint2*)(smem + 27648 + vo) = a; a.x = v1[2]; a.y = v1[3]; *(uint2*)(smem + 27648 + vo + 8) = a; }
    }
    ATT_ISSUE(0, pkA, pvA);
    ATT_ISSUE(1, pkB, pvB);
    __syncthreads();
    const char* K0 = smem; const char* V0 = smem + 9216; const char* K1 = smem + 18432; const char* V1 = smem + 27648;
    f32x16 sc[4];
    sc[0] = qk_sub(K0, 0, qf, r32, h);
    sc[1] = zero16(); sc[2] = zero16(); sc[3] = zero16();
    if (nsub > 1) sc[1] = qk_sub(K0, 32, qf, r32, h);
    if (nsub > 2) sc[2] = qk_sub(K1, 0, qf, r32, h);
    if (nsub > 3) sc[3] = qk_sub(K1, 32, qf, r32, h);
    float mx = -1e30f;
    const int nlim = ((t - 31) >> 4) - 4 * h;
#pragma unroll
    for (int sub = 0; sub < 4; ++sub)
#pragma unroll
      for (int i = 0; i < 16; ++i) {
        const int c = sub * 32 + (i & 3) + 8 * (i >> 2);
        const float v = (c <= nlim) ? sc[sub][i] : -1e30f;
        sc[sub][i] = v; mx = fmaxf(mx, v);
      }
    mx = fmaxf(mx, __shfl_xor(mx, 32));
    const float mxc = fmaxf(mx, -1e20f) * LOG2E_F;
    float lsum = 0.f;
#pragma unroll
    for (int sub = 0; sub < 4; ++sub)
#pragma unroll
      for (int i = 0; i < 16; ++i) { const float pvv = __builtin_amdgcn_exp2f(__builtin_fmaf(sc[sub][i], LOG2E_F, -mxc)); sc[sub][i] = pvv; lsum += pvv; }
    lsum += __shfl_xor(lsum, 32);
    const float inv = (t >= 31) ? (1.f / lsum) : 0.f;
#pragma unroll
    for (int sub = 0; sub < 4; ++sub)
#pragma unroll
      for (int i = 0; i < 16; ++i) sc[sub][i] *= inv;
    const int qloc = (w >> 2) * 32 + r32, hh4 = w & 3;
#pragma unroll
    for (int sub = 0; sub < 4; ++sub)
#pragma unroll
      for (int g4 = 0; g4 < 4; ++g4) {
        const int mi = 8 * sub + 2 * g4 + h;
        const float p3 = 0.5f * sc[sub][4 * g4 + 3];
        impA[(hh4 * 64 + qloc) * 33 + mi] = sc[sub][4 * g4] + sc[sub][4 * g4 + 1] + sc[sub][4 * g4 + 2] + p3;
        impB[(hh4 * 64 + qloc) * 33 + mi + 1] = p3;
      }
    __syncthreads();
    {
      const int q = tid >> 3, jj = (tid & 7) * 4;
#pragma unroll
      for (int e = 0; e < 4; ++e) {
        const int j = jj + e;
        float tot = 0.f;
#pragma unroll
        for (int ww = 0; ww < 4; ++ww) tot += impA[(ww * 64 + q) * 33 + j];
        if (j > 0) {
#pragma unroll
          for (int ww = 0; ww < 4; ++ww) tot += impB[(ww * 64 + q) * 33 + j];
        }
        impT[q * 33 + j] = tot;
      }
      if (tid < 64) selm[tid] = 0u;
    }
    __syncthreads();
    f32x16 oc[2]; oc[0] = zero16(); oc[1] = zero16();
    pv_sub(oc, V0, 0, sc[0], r32, h);
    if (nsub > 1) pv_sub(oc, V0, 32, sc[1], r32, h);
    if (nsub > 2) pv_sub(oc, V1, 0, sc[2], r32, h);
    if (nsub > 3) pv_sub(oc, V1, 32, sc[3], r32, h);
#pragma unroll
    for (int dt = 0; dt < 2; ++dt)
#pragma unroll
      for (int i = 0; i < 16; ++i) res[dt][i] = g0 * oc[dt][i];
    {
      const int q = tid >> 3, jj = (tid & 7) * 4;
      unsigned bits = 0u;
      for (int e = 0; e < 4; ++e) {
        const int j = jj + e;
        bool sel;
        if (j > cur) sel = false;
        else if (j == 0 || j >= cur - 1) sel = true;
        else if (cur - 2 <= 13) sel = true;
        else {
          const float v = impT[q * 33 + j];
          int rank = 0;
          for (int j2 = 1; j2 <= cur - 2; ++j2) { const float v2 = impT[q * 33 + j2]; rank += ((v2 > v) || (v2 == v && j2 < j)) ? 1 : 0; }
          sel = rank < 13;
        }
        if (sel) bits |= (1u << j);
      }
      atomicOr(&selm[q], bits);
    }
    __syncthreads();
  }
  const unsigned mymask = selm[(w >> 2) * 32 + r32];
  {
    f32x16 O[2]; O[0] = zero16(); O[1] = zero16();
    float m_run = -1e30f, l_run = 0.f;
    auto step = [&](int i, u32x4& pk, u32x4& pv) {
      char* bk = smem + (i & 1) * 18432;
      *(u32x4*)(bk + ldoff) = pk;
      { const int vo = lr * 136 + lc * 16; uint2 a; a.x = pv[0]; a.y = pv[1]; *(uint2*)(bk + 9216 + vo) = a; a.x = pv[2]; a.y = pv[3]; *(uint2*)(bk + 9216 + vo + 8) = a; }
      __syncthreads();
      if (i + 2 < ntile) ATT_ISSUE(i + 2, pk, pv);
      if (i == ns) {
        const float l = l_run + __shfl_xor(l_run, 32);
        const float sc_ = g1 / l;
#pragma unroll
        for (int dt = 0; dt < 2; ++dt)
#pragma unroll
          for (int e = 0; e < 16; ++e) { res[dt][e] += sc_ * O[dt][e]; O[dt][e] = 0.f; }
        m_run = -1e30f; l_run = 0.f;
      }
      const bool sl = i < ns;
      const int j = sl ? i : (jlo + i - ns);
      const int kb = j * 64;
      const int hi = (sl && !((mymask >> j) & 1u)) ? -1 : (t - kb - 4 * h);
      const int lo = sl ? -100000 : (t - 512 - kb - 4 * h);
      flash_tile(O, m_run, l_run, bk, bk + 9216, qf, hi, lo, r32, h);
    };
#pragma unroll 1
    for (int i = 0; i < ntile; i += 2) {
      step(i, pkA, pvA);
      if (i + 1 < ntile) step(i + 1, pkB, pvB);
    }
    const float l = l_run + __shfl_xor(l_run, 32);
    const float sc_ = g2 / l;
#pragma unroll
    for (int dt = 0; dt < 2; ++dt)
#pragma unroll
      for (int e = 0; e < 16; ++e) res[dt][e] += sc_ * O[dt][e];
  }
#undef ATT_ISSUE
#pragma unroll
  for (int dt = 0; dt < 2; ++dt)
#pragma unroll
    for (int g4 = 0; g4 < 4; ++g4)
      store4bf(Q + tok * 1024 + hd * 64 + dt * 32 + 8 * g4 + 4 * h, res[dt][4 * g4], res[dt][4 * g4 + 1], res[dt][4 * g4 + 2], res[dt][4 * g4 + 3]);
  __syncthreads();
}

DI TileSrc srcE(const Params& p, int step) {
  const int item = step / 6, r = step % 6, k = r >> 1, isv = r & 1;
  const int nt = item & 7, mt = item >> 3;
  const size_t yo = (k == 0) ? OFF_U : ((k == 1) ? OFF_Q : OFF_RG);
  TileSrc t;
  t.A = (const u16*)(p.ws + (isv ? yo : OFF_HB)) + (long)mt * 256 * 1024; t.lda = 1024;
  t.Bt = (const u16*)(p.ws + OFF_W1 + (isv ? W1_WBR : W1_WMG)) + ((long)k * 1024 + nt * 128) * 1024; t.ldb = 1024;
  return t;
}
DI void phaseE_tile(const Params& p, int item, char* smem, Stg& st, bool pre, int nitem, bool hasnxt) {
  const int nt = item & 7, mt = item >> 3;
  const int m0 = mt * 256, n0 = nt * 128;
  char* ws = p.ws;
  f32x4 R[4][4];
  zero_acc<2>(R);
#pragma unroll 1
  for (int k = 0; k < 3; ++k) {
    f32x4 acc[4][4];
    zero_acc<2>(acc);
    gemm512<2, 2>(acc, srcE(p, item * 6 + k * 2), 1024, smem, st, pre || (k > 0), srcE(p, item * 6 + k * 2 + 1), true);
    uint4* gs = (uint4*)(ws + OFF_KV + 25165824) + (size_t)blockIdx.x * 4096 + otid();
#pragma unroll
    for (int a = 0; a < 4; ++a) {
#pragma unroll
      for (int b2 = 0; b2 < 2; ++b2) {
        uint4 v;
        v.x = pack2(sigmoidf_(acc[a][2 * b2][0]), sigmoidf_(acc[a][2 * b2][1]));
        v.y = pack2(sigmoidf_(acc[a][2 * b2][2]), sigmoidf_(acc[a][2 * b2][3]));
        v.z = pack2(sigmoidf_(acc[a][2 * b2 + 1][0]), sigmoidf_(acc[a][2 * b2 + 1][1]));
        v.w = pack2(sigmoidf_(acc[a][2 * b2 + 1][2]), sigmoidf_(acc[a][2 * b2 + 1][3]));
        gs[(a * 2 + b2) * 512] = v;
      }
      __builtin_amdgcn_sched_barrier(0);
    }
    zero_acc<2>(acc);
    {
      const bool last = (k == 2);
      gemm512<2, 2>(acc, srcE(p, item * 6 + k * 2 + 1), 1024, smem, st, true, last ? srcE(p, nitem * 6) : srcE(p, item * 6 + k * 2 + 2), last ? hasnxt : true);
    }
#pragma unroll
    for (int a = 0; a < 4; ++a) {
#pragma unroll
      for (int b2 = 0; b2 < 2; ++b2) {
        const uint4 v = gs[(a * 2 + b2) * 512];
        R[a][2 * b2][0] += bflo(v.x) * acc[a][2 * b2][0]; R[a][2 * b2][1] += bfhi(v.x) * acc[a][2 * b2][1];
        R[a][2 * b2][2] += bflo(v.y) * acc[a][2 * b2][2]; R[a][2 * b2][3] += bfhi(v.y) * acc[a][2 * b2][3];
        R[a][2 * b2 + 1][0] += bflo(v.z) * acc[a][2 * b2 + 1][0]; R[a][2 * b2 + 1][1] += bfhi(v.z) * acc[a][2 * b2 + 1][1];
        R[a][2 * b2 + 1][2] += bflo(v.w) * acc[a][2 * b2 + 1][2]; R[a][2 * b2 + 1][3] += bfhi(v.w) * acc[a][2 * b2 + 1][3];
      }
      __builtin_amdgcn_sched_barrier(0);
    }
  }
  u16* M = (u16*)(ws + OFF_MERGED);
  epi512_rows16<2, 2>(R, m0, n0, M, 1024, 0, [](float v) { return v; });
}

DI TileSrc srcP(const u16* A, long lda, const u16* Bt, long ldb, int item) {
  const int nt = item & 3, mt = item >> 2;
  TileSrc t; t.A = A + (long)mt * 256 * lda; t.lda = lda; t.Bt = Bt + (long)nt * 256 * ldb; t.ldb = ldb;
  return t;
}
DI void gemm_f32out_tile(const u16* A, long lda, const u16* Bt, long ldb, int K, u16* C, int item, char* smem, Stg& st, bool pre, int nitem, bool hasnxt) {
  const int nt = item & 3, mt = item >> 2;
  const int m0 = mt * 256, n0 = nt * 256;
  f32x4 acc[4][8];
  zero_acc<4>(acc);
  gemm512<4, 4>(acc, srcP(A, lda, Bt, ldb, item), K, smem, st, pre, srcP(A, lda, Bt, ldb, nitem), hasnxt);
  epi512<4, 4>(acc, m0, n0, [&](int m, int n, float a, float b, float c, float d) { store4bf(C + (long)m * 1024 + n, a, b, c, d); });
}

DI TileSrc srcH(const Params& p, int item) {
  const int nt = item % 22, mt = item / 22;
  TileSrc t; t.A = (const u16*)(p.ws + OFF_HB) + (long)mt * 256 * 1024; t.lda = 1024; t.Bt = (const u16*)(p.ws + OFF_W2 + W2_WFI) + (long)nt * 256 * 1024; t.ldb = 1024;
  return t;
}
DI void phaseH_tile(const Params& p, int item, char* smem, Stg& st, bool pre, int nitem, bool hasnxt) {
  const int nt = item % 22, mt = item / 22;
  const int m0 = mt * 256, n0 = nt * 256;
  char* ws = p.ws;
  f32x4 acc[4][8];
  zero_acc<4>(acc);
  gemm512<4, 4>(acc, srcH(p, item), 1024, smem, st, pre, srcH(p, nitem), hasnxt);
  u16* ACT = (u16*)(ws + OFF_ACT);
  const int tid = otid(), lane = tid & 63, wid = tid >> 6, wm = wid >> 2, wn = wid & 3, r16 = lane & 15, q = lane >> 4;
#pragma unroll
  for (int mf = 0; mf < 8; ++mf) {
    const int m = m0 + wm * 128 + mf * 16 + r16;
    float o[2][4];
#pragma unroll
    for (int nf = 0; nf < 2; ++nf)
#pragma unroll
      for (int e = 0; e < 4; ++e) { const float gt = acc[nf][mf][e], up = acc[nf + 2][mf][e]; o[nf][e] = gt * sigmoidf_(gt) * up; }
    auto rx = __builtin_amdgcn_permlane16_swap(pack2(o[0][0], o[0][1]), pack2(o[1][0], o[1][1]), false, false);
    auto ry = __builtin_amdgcn_permlane16_swap(pack2(o[0][2], o[0][3]), pack2(o[1][2], o[1][3]), false, false);
    const int j = ((n0 + wn * 64) >> 6) * 32 + (q & 1) * 16 + (q >> 1) * 8;
    uint4 ov; ov.x = rx[0]; ov.y = ry[0]; ov.z = rx[1]; ov.w = ry[1];
    *(uint4*)(ACT + (long)m * 2816 + j) = ov;
    __builtin_amdgcn_sched_barrier(0);
  }
}

DI void phaseH_half_tile(const Params& p, int mt, int n0, char* smem) {
  const int m0 = mt * 256;
  char* ws = p.ws;
  f32x4 acc[4][4];
  zero_acc<2>(acc);
  {
    Stg st;
    TileSrc t; t.A = (const u16*)(ws + OFF_HB) + (long)m0 * 1024; t.lda = 1024; t.Bt = (const u16*)(ws + OFF_W2 + W2_WFI) + (long)n0 * 1024; t.ldb = 1024;
    gemm512<2, 2>(acc, t, 1024, smem, st, false, t, false);
  }
  u16* ACT = (u16*)(ws + OFF_ACT);
  const int tid = otid(), lane = tid & 63, wid = tid >> 6, wm = wid >> 1, wn = wid & 1, r16 = lane & 15, q = lane >> 4;
#pragma unroll
  for (int mf = 0; mf < 4; ++mf) {
    const int m = m0 + wm * 64 + mf * 16 + r16;
    float o[2][4];
#pragma unroll
    for (int nf = 0; nf < 2; ++nf)
#pragma unroll
      for (int e = 0; e < 4; ++e) { const float gt = acc[nf][mf][e], up = acc[nf + 2][mf][e]; o[nf][e] = gt * sigmoidf_(gt) * up; }
    auto rx = __builtin_amdgcn_permlane16_swap(pack2(o[0][0], o[0][1]), pack2(o[1][0], o[1][1]), false, false);
    auto ry = __builtin_amdgcn_permlane16_swap(pack2(o[0][2], o[0][3]), pack2(o[1][2], o[1][3]), false, false);
    const int j = ((n0 + wn * 64) >> 6) * 32 + (q & 1) * 16 + (q >> 1) * 8;
    uint4 ov; ov.x = rx[0]; ov.y = ry[0]; ov.z = rx[1]; ov.w = ry[1];
    *(uint4*)(ACT + (long)m * 2816 + j) = ov;
    __builtin_amdgcn_sched_barrier(0);
  }
}

DI void rowsq_exchange(const f32x4 (&acc)[4][8], float* xch, unsigned* cnt, int mt, int nt, char* smem, float* rsv) {
  const int tid = otid(), lane = tid & 63, wid = tid >> 6, wm = wid >> 2, wn = wid & 3, r16 = lane & 15, q = lane >> 4;
  float* part = (float*)smem;
#pragma unroll
  for (int mf = 0; mf < 8; ++mf) {
    float ss = 0.f;
#pragma unroll
    for (int nf = 0; nf < 4; ++nf) ss += acc[nf][mf][0] * acc[nf][mf][0] + acc[nf][mf][1] * acc[nf][mf][1] + acc[nf][mf][2] * acc[nf][mf][2] + acc[nf][mf][3] * acc[nf][mf][3];
    ss += __shfl_xor(ss, 16); ss += __shfl_xor(ss, 32);
    if (q == 0) part[wn * 256 + wm * 128 + mf * 16 + r16] = ss;
  }
  __syncthreads();
  if (tid < 256) {
    const float P = part[tid] + part[256 + tid] + part[512 + tid] + part[768 + tid];
    __hip_atomic_store(xch + ((long)mt * 4 + nt) * 256 + tid, P, __ATOMIC_RELAXED, __HIP_MEMORY_SCOPE_AGENT);
  }
  asm volatile("s_waitcnt vmcnt(0)" ::: "memory");
  __syncthreads();
  if (tid == 0) {
    __hip_atomic_fetch_add(cnt + mt, 1u, __ATOMIC_RELAXED, __HIP_MEMORY_SCOPE_AGENT);
    while (__hip_atomic_load(cnt + mt, __ATOMIC_RELAXED, __HIP_MEMORY_SCOPE_AGENT) < 4u) __builtin_amdgcn_s_sleep(1);
  }
  __syncthreads();
  if (tid < 256) {
    float S = 0.f;
#pragma unroll
    for (int j = 0; j < 4; ++j) S += __hip_atomic_load(xch + ((long)mt * 4 + j) * 256 + tid, __ATOMIC_RELAXED, __HIP_MEMORY_SCOPE_AGENT);
    rsv[tid] = rsqrtf(S * (1.f / 1024.f) + 1e-6f);
  }
  __syncthreads();
}
DI void fused_norm_tile(const Params& p, const u16* A, long lda, const u16* Bt, long ldb, int K, int use, const float* res_in, float* res_out,
                        const float* g_post, const float* g_next, u16* hnext, bool zero_stats, char* smem) {
  const int bid = blockIdx.x;
  const int mt = (bid & 7) * 8 + ((bid >> 3) & 7), nt = bid >> 6;
  const int m0 = mt * 256, n0 = nt * 256;
  char* ws = p.ws;
  f32x4 acc[4][8];
  zero_acc<4>(acc);
  {
    Stg st;
    const TileSrc src = srcP(A, lda, Bt, ldb, mt * 4 + nt);
    gemm512<4, 4>(acc, src, K, smem, st, false, src, false);
  }
  float* xch = (float*)(ws + OFF_NG);
  unsigned* cnt = (unsigned*)(ws + OFF_SM + SM_BAR) + 16 + use * 128;
  float* rsv = (float*)(smem + 4096);
  const int tid = otid(), lane = tid & 63, wid = tid >> 6, wm = wid >> 2, wn = wid & 3, r16 = lane & 15, q = lane >> 4;
  rowsq_exchange(acc, xch, cnt, mt, nt, smem, rsv);
#pragma unroll
  for (int mf = 0; mf < 8; ++mf) {
    const int ml = wm * 128 + mf * 16 + r16;
    const float rs = rsv[ml];
#pragma unroll
    for (int nf = 0; nf < 4; ++nf) {
      const int n = n0 + wn * 64 + nf * 16 + q * 4;
      const float4 xv = *(const float4*)(res_in + (long)(m0 + ml) * 1024 + n);
      const float4 gv = *(const float4*)(g_post + n);
      acc[nf][mf][0] = xv.x + acc[nf][mf][0] * rs * gv.x; acc[nf][mf][1] = xv.y + acc[nf][mf][1] * rs * gv.y;
      acc[nf][mf][2] = xv.z + acc[nf][mf][2] * rs * gv.z; acc[nf][mf][3] = xv.w + acc[nf][mf][3] * rs * gv.w;
      float4 o; o.x = acc[nf][mf][0]; o.y = acc[nf][mf][1]; o.z = acc[nf][mf][2]; o.w = acc[nf][mf][3];
      *(float4*)(res_out + (long)(m0 + ml) * 1024 + n) = o;
    }
    __builtin_amdgcn_sched_barrier(0);
  }
  if (hnext) {
    __syncthreads();
    rowsq_exchange(acc, xch + 65536, cnt + 64, mt, nt, smem, rsv);
#pragma unroll
    for (int mf = 0; mf < 8; ++mf) {
      const int ml = wm * 128 + mf * 16 + r16;
      const float rs = rsv[ml];
#pragma unroll
      for (int pp = 0; pp < 2; ++pp) {
        const int na = n0 + wn * 64 + 2 * pp * 16 + q * 4;
        const float4 ga = *(const float4*)(g_next + na), gb = *(const float4*)(g_next + na + 16);
        auto rx = __builtin_amdgcn_permlane16_swap(pack2(acc[2 * pp][mf][0] * rs * ga.x, acc[2 * pp][mf][1] * rs * ga.y),
                                                   pack2(acc[2 * pp + 1][mf][0] * rs * gb.x, acc[2 * pp + 1][mf][1] * rs * gb.y), false, false);
        auto ry = __builtin_amdgcn_permlane16_swap(pack2(acc[2 * pp][mf][2] * rs * ga.z, acc[2 * pp][mf][3] * rs * ga.w),
                                                   pack2(acc[2 * pp + 1][mf][2] * rs * gb.z, acc[2 * pp + 1][mf][3] * rs * gb.w), false, false);
        const int n = n0 + wn * 64 + (2 * pp + (q & 1)) * 16 + (q >> 1) * 8;
        uint4 o; o.x = rx[0]; o.y = ry[0]; o.z = rx[1]; o.w = ry[1];
        *(uint4*)(hnext + (long)(m0 + ml) * 1024 + n) = o;
      }
      __builtin_amdgcn_sched_barrier(0);
    }
  }
  if (zero_stats && nt == 0 && tid < 256) {
    unsigned long long* stz = (unsigned long long*)(ws + OFF_SM + SM_STATS) + (long)(m0 + tid) * 2;
    unsigned long long zz = 0ull; asm volatile("" : "+v"(zz));
    stz[0] = zz; stz[1] = zz;
  }
  __syncthreads();
}

#ifndef PHMASK
#define PHMASK 0x3ff
#endif
#define PH_ON(i) ((PHMASK >> (i)) & 1)
DI void run_phase(const Params& p, int ph, char* smem, int csub = 7) {
  const int G = gridDim.x, bid = blockIdx.x;
  char* ws = p.ws;
  int half = ((int)__builtin_amdgcn_workitem_id_x()) >> 8;
  asm volatile("" : "+v"(half));
  half = __builtin_amdgcn_readfirstlane(half);
  char* hsm = smem + half * 65536;
  if (ph == 0) {
    if (!PH_ON(9)) return;
    const int n = 2048 + CONV1_ITEMS / 2;
    for (int it = bid; it < n; it += G) {
      if (it < 2048) row_item(it, p.in[0], nullptr, nullptr, nullptr, p.in[1], (u16*)(ws + OFF_HB), (unsigned long long*)(ws + OFF_SM + SM_STATS));
      else conv1_item(p, 0, (it - 2048) * 2 + half, hsm);
    }
    return;
  }
  const int l = (ph - 1) / 9, sp = (ph - 1) % 9;
  switch (sp) {
    case 0: if (!PH_ON(0)) break; {
      Stg st; bool pre = false;
      if (G == 256) {
        int mt, nt, mt2, nt2;
        xcd_tile(0, 27, mt, nt);
        for (int r = 0; r < 6; ++r) { const bool hn = (r < 5); xcd_tile(r + 1, 27, mt2, nt2); phaseB_tile(p, mt * 27 + nt, smem, st, pre, mt2 * 27 + nt2, hn); pre = hn; mt = mt2; nt = nt2; }
        {
          const int x = bid & 7, lb = bid >> 3, tix = lb >> 1;
          phaseB_half_tile(p, x * 8 + (tix & 7), (24 + (tix >> 3)) * 256 + (lb & 1) * 128, smem);
        }
      } else
      for (int it = bid; it < 64 * 27; it += G) { const bool hn = (it + G < 64 * 27); phaseB_tile(p, it, smem, st, pre, it + G, hn); pre = hn; }
      break;
    }
    case 1: if (!PH_ON(1)) break;
      if (G >= 192) {
        if (bid < 128) { if (csub & 1) rglru_item(p, l, bid * 2 + half, hsm); }
        else if (bid < 160) { if (csub & 2) compress_item(p, bid - 128, smem); }
        else {
          for (int e = bid - 160; e < 64 + 256; e += G - 160) {
            if (e < 64) { if (csub & 4) nsa_item(p, e, smem); }
            else { if (csub & 4) gmlp_item(p, l, (e - 64) * 2 + half, hsm); }
          }
        }
#ifndef NO_CD_MERGE
        if (G == 256) {
          unsigned* cq = (unsigned*)(ws + OFF_SM + SM_BAR) + 600 + l * 2;
          const int tidr = (int)__builtin_amdgcn_workitem_id_x();
          if (bid >= 128) {
            asm volatile("s_waitcnt vmcnt(0)" ::: "memory");
            __syncthreads();
            if (tidr == 0) {
              __builtin_amdgcn_fence(__ATOMIC_RELEASE, "agent");
              const unsigned mine = (bid < 160) ? 1u : (unsigned)(((63 - (bid - 160)) / 96) + 1);
              __hip_atomic_fetch_add(cq + 1, (bid < 160 || bid - 160 < 64) ? mine : 0u, __ATOMIC_RELAXED, __HIP_MEMORY_SCOPE_AGENT);
            }
          }
          unsigned* qslot = (unsigned*)(smem + 114688);
          if (tidr == 0) {
            while (__hip_atomic_load(cq + 1, __ATOMIC_RELAXED, __HIP_MEMORY_SCOPE_AGENT) < 96u) __builtin_amdgcn_s_sleep(2);
            __builtin_amdgcn_fence(__ATOMIC_ACQUIRE, "agent");
          }
          for (;;) {
            __syncthreads();
            if (tidr == 0) *qslot = __hip_atomic_fetch_add(cq, 1u, __ATOMIC_RELAXED, __HIP_MEMORY_SCOPE_AGENT);
            __syncthreads();
            const unsigned idx = *qslot;
            if (idx >= 1024u) break;
            attn_item(p, (int)idx | 0x10000, smem);
          }
        }
#endif
      } else {
        for (int e = bid; e < 128 + 32 + 256; e += G) {
          if (e < 128) { if (csub & 1) rglru_item(p, l, e * 2 + half, hsm); }
          else if (e < 160) { if (csub & 2) compress_item(p, e - 128, smem); }
          else { if (csub & 4) gmlp_item(p, l, (e - 160) * 2 + half, hsm); }
        }
      }
      break;
    case 2: if (!PH_ON(2)) break;
#ifndef NO_CD_MERGE
      if (G == 256) break;
#endif
      for (int it = bid; it < 1024; it += G) attn_item(p, it, smem); break;
    case 3: if (!PH_ON(3)) break;
      {
        Stg st; bool pre = false;
        for (int it = bid; it < 512 + CONV2_TILES / 2; it += G) {
          if (it < 512) {
            const bool hn = (it + G < 512);
            int e0 = it, e1 = it + G;
            if (G == 256) { const int x = bid & 7, lb = bid >> 3; const int t0_ = (it >> 8) * 32 + lb, t1_ = t0_ + 32; e0 = (x * 8 + (t0_ & 7)) * 8 + (t0_ >> 3); e1 = (x * 8 + (t1_ & 7)) * 8 + (t1_ >> 3); }
            phaseE_tile(p, e0, smem, st, pre, e1, hn); pre = hn;
          }
          else conv2_item(p, l, (it - 512) * 2 + half, hsm);
        }
      }
      break;
    case 4: if (!PH_ON(4)) break;
      if (G == 256) {
        fused_norm_tile(p, (const u16*)(ws + OFF_MERGED), 1024, (const u16*)(ws + OFF_W2 + W2_WO), 1024, 1024, l * 2 + 0,
                        (l == 0) ? p.in[0] : p.out, p.out, p.in[2] + l * 1024, p.in[3] + l * 1024, (u16*)(ws + OFF_HB), false, smem);
      } else
      {
        Stg st; bool pre = false;
        for (int it = bid; it < 256; it += G) { const bool hn = (it + G < 256);
          const int e0 = (G == 256) ? (((bid & 7) * 8 + ((bid >> 3) & 7)) * 4 + (bid >> 6)) : it;
          gemm_f32out_tile((const u16*)(ws + OFF_MERGED), 1024, (const u16*)(ws + OFF_W2 + W2_WO), 1024, 1024, (u16*)(ws + OFF_TBUF), e0, smem, st, pre, it + G, hn); pre = hn; }
      }
      break;
    case 5: if (!PH_ON(5)) break;
      for (int it = bid; it < 2048; it += G)
        row_item(it, (l == 0) ? p.in[0] : p.out, (const u16*)(ws + OFF_TBUF), p.in[2] + l * 1024, p.out, p.in[3] + l * 1024, (u16*)(ws + OFF_HB), nullptr);
      break;
    case 6: if (!PH_ON(6)) break; {
      Stg st; bool pre = false;
      if (G == 256) {
        int mt, nt, mt2, nt2;
        xcd_tile(0, 22, mt, nt);
        for (int r = 0; r < 5; ++r) { const bool hn = (r < 4); xcd_tile(r + 1, 22, mt2, nt2); phaseH_tile(p, mt * 22 + nt, smem, st, pre, mt2 * 22 + nt2, hn); pre = hn; mt = mt2; nt = nt2; }
        {
          const int x = bid & 7, lb = bid >> 3, tix = lb >> 1;
          phaseH_half_tile(p, x * 8 + (tix & 7), (20 + (tix >> 3)) * 256 + (lb & 1) * 128, smem);
        }
      } else
      for (int it = bid; it < 64 * 22; it += G) { const bool hn = (it + G < 64 * 22); phaseH_tile(p, it, smem, st, pre, it + G, hn); pre = hn; }
      break;
    }
    case 7: if (!PH_ON(7)) break;
      if (G == 256) {
        const bool nxt = (l + 1 < 2);
        fused_norm_tile(p, (const u16*)(ws + OFF_ACT), 2816, (const u16*)(ws + OFF_W2 + W2_WFO), 2816, 2816, l * 2 + 1,
                        p.out, p.out, p.in[4] + l * 1024, nxt ? (p.in[1] + (l + 1) * 1024) : nullptr, nxt ? (u16*)(ws + OFF_HB) : nullptr, nxt, smem);
        if (nxt) for (int it = bid; it < CONV1_ITEMS / 2; it += G) conv1_item(p, l + 1, it * 2 + half, hsm);
      } else
      {
        Stg st; bool pre = false;
        for (int it = bid; it < 256; it += G) { const bool hn = (it + G < 256);
          const int e0 = (G == 256) ? (((bid & 7) * 8 + ((bid >> 3) & 7)) * 4 + (bid >> 6)) : it;
          gemm_f32out_tile((const u16*)(ws + OFF_ACT), 2816, (const u16*)(ws + OFF_W2 + W2_WFO), 2816, 2816, (u16*)(ws + OFF_TBUF), e0, smem, st, pre, it + G, hn); pre = hn; }
      }
      break;
    case 8: if (!PH_ON(8)) break; {
      const bool nxt = (l + 1 < 2);
      const int n = 2048 + (nxt ? CONV1_ITEMS / 2 : 0);
      for (int it = bid; it < n; it += G) {
        if (it < 2048) row_item(it, p.out, (const u16*)(ws + OFF_TBUF), p.in[4] + l * 1024, p.out, nxt ? (p.in[1] + (l + 1) * 1024) : nullptr, nxt ? (u16*)(ws + OFF_HB) : nullptr, (unsigned long long*)(ws + OFF_SM + SM_STATS));
        else conv1_item(p, l + 1, (it - 2048) * 2 + half, hsm);
      }
      break;
    }
  }
}

constexpr int N_PHASES = 19;

__global__ void __launch_bounds__(NTHR, 2) mega_kernel(Params p, int ph0, int ph1) {
  extern __shared__ __attribute__((aligned(16))) char smem[];
  cg::grid_group grid = cg::this_grid();
#ifdef TIMER_MASK
  unsigned long long tacc = 0, tprev = wall_clock64();
#endif
  unsigned* gbar = (unsigned*)(p.ws + OFF_SM + SM_BAR);
  if (blockIdx.x == 0) { __hip_atomic_store(gbar + threadIdx.x, 0u, __ATOMIC_RELAXED, __HIP_MEMORY_SCOPE_AGENT); __hip_atomic_store(gbar + 512 + threadIdx.x, 0u, __ATOMIC_RELAXED, __HIP_MEMORY_SCOPE_AGENT); }
  const bool fused_rows = (gridDim.x == 256);
  unsigned nbar = 0;
  for (int ph = ph0; ph < ph1; ++ph) {
    if (fused_rows && ph >= 1) { const int kd = (ph - 1) % 9; if (kd == 5 || kd == 8) continue;
#ifndef NO_CD_MERGE
      if (kd == 2) continue;
#endif
    }
#ifdef CSUB
    if (ph >= 1 && ((ph - 1) % 9) == 1) {
      for (int c = 1; c <= 4; c <<= 1) {
        run_phase(p, ph, smem, c);
        grid.sync();
        const unsigned long long tn = wall_clock64(); if (c == CSUB) tacc += tn - tprev; tprev = tn;
      }
      continue;
    }
#endif
    run_phase(p, ph, smem);
#ifdef TIMER_MASK
    grid.sync();
    { const unsigned long long tn = wall_clock64(); const int kind = (ph == 0) ? 9 : ((ph - 1) % 9); if ((TIMER_MASK >> kind) & 1) tacc += tn - tprev; tprev = tn; }
#else
    if (ph + 1 < ph1) {
      if (ph == ph0) grid.sync();
      else {
        asm volatile("s_waitcnt vmcnt(0)" ::: "memory");
        __syncthreads();
        ++nbar;
        if (threadIdx.x == 0) {
          __builtin_amdgcn_fence(__ATOMIC_RELEASE, "agent");
          __hip_atomic_fetch_add(gbar, 1u, __ATOMIC_RELAXED, __HIP_MEMORY_SCOPE_AGENT);
          const unsigned target = nbar * gridDim.x;
          while (__hip_atomic_load(gbar, __ATOMIC_RELAXED, __HIP_MEMORY_SCOPE_AGENT) < target) __builtin_amdgcn_s_sleep(2);
          __builtin_amdgcn_fence(__ATOMIC_ACQUIRE, "agent");
        }
        __syncthreads();
      }
    }
#endif
  }
#ifdef TIMER_MASK
  if (blockIdx.x == 0 && threadIdx.x == 0) p.out[0] += (float)tacc * 0.001f;
#endif
}

extern "C" void kernel_launch(void* const* d_in, const int* in_sizes, int n_in, void* d_out, int out_size, void* d_ws, size_t ws_size,
                              hipStream_t stream) {
  static int grid_blocks = 0;
  if (!grid_blocks) {
    int dev = 0, cus = 0, per_cu = 0;
    (void)hipGetDevice(&dev);
    (void)hipDeviceGetAttribute(&cus, hipDeviceAttributeMultiprocessorCount, dev);
    (void)hipFuncSetAttribute((const void*)mega_kernel, hipFuncAttributeMaxDynamicSharedMemorySize, LDS_BYTES);
    (void)hipOccupancyMaxActiveBlocksPerMultiprocessor(&per_cu, mega_kernel, NTHR, LDS_BYTES);
    if (per_cu < 1) per_cu = 1;
    if (per_cu > 1) per_cu = 1;
    grid_blocks = cus * per_cu;
    if (ws_size < WS_NEED) fprintf(stderr, "kernel_launch: workspace too small: %zu < %zu\n", ws_size, (size_t)WS_NEED);
  }
  Params p{};
  for (int i = 0; i < 29; ++i) p.in[i] = (const float*)d_in[i];
  p.out = (float*)d_out;
  p.ws = (char*)d_ws;
#if MK_MULTI
  for (int ph = 0; ph < N_PHASES; ++ph) {
    hipLaunchKernelGGL(mega_kernel, dim3(grid_blocks), dim3(NTHR), LDS_BYTES, stream, p, ph, ph + 1);
  }
#else
  int ph0 = 0, ph1 = N_PHASES;
  void* args[] = {&p, &ph0, &ph1};
  hipError_t e = hipLaunchCooperativeKernel((void*)mega_kernel, dim3(grid_blocks), dim3(NTHR), args, LDS_BYTES, stream);
  if (e != hipSuccess) fprintf(stderr, "cooperative launch failed: %s (grid %d)\n", hipGetErrorString(e), grid_blocks);
#endif
}
```

```cpp
#include <hip/hip_runtime.h>
#include <hip/hip_cooperative_groups.h>
#include <cstdio>
namespace cg = cooperative_groups;

#ifndef MK_MULTI
#define MK_MULTI 0
#endif

typedef unsigned short u16;
using bf16x8 = __attribute__((ext_vector_type(8))) short;
using f32x16 = __attribute__((ext_vector_type(16))) float;
using u32x4 = __attribute__((ext_vector_type(4))) unsigned;
using f32x4 = __attribute__((ext_vector_type(4))) float;
#define MFMA16(a, b, c) __builtin_amdgcn_mfma_f32_16x16x32_bf16((a), (b), (c), 0, 0, 0)
#define DI __device__ __forceinline__
#define MFMA32(a, b, c) __builtin_amdgcn_mfma_f32_32x32x16_bf16((a), (b), (c), 0, 0, 0)

constexpr int T_ = 16384;
constexpr int NTHR = 512;
constexpr int LDS_BYTES = 131072;

constexpr size_t SZ32 = 33554432;
constexpr size_t OFF_HB = 0;
constexpr size_t OFF_U = 1 * SZ32;
constexpr size_t OFF_GV = 2 * SZ32;
constexpr size_t OFF_Q = 3 * SZ32;
constexpr size_t OFF_XR = 4 * SZ32;
constexpr size_t OFF_RG = 5 * SZ32;
constexpr size_t OFF_KV = 6 * SZ32;
constexpr size_t KV_ELEMS = 4194304;
constexpr size_t OFF_NG = OFF_KV + 50331648;
constexpr size_t OFF_SM = OFF_NG + 3145728;
constexpr size_t SM_KC = 0, SM_VCT = 524288, SM_CKV = 1048576, SM_WSB = 1050624, SM_HID = 1310720, SM_STATS = 5505024, SM_BAR = 5767168;
constexpr size_t OFF_W1 = OFF_SM + 6291456;
constexpr size_t W1_WIN = 0, W1_WMG = 14155776, W1_WBR = W1_WMG + 6291456, W1_WK1 = W1_WBR + 6291456, W1_WV1 = W1_WK1 + 1048576, W1_WK2 = W1_WV1 + 1048576, W1_WV2 = W1_WK2 + 32768, W1_WNS = W1_WV2 + 32768;
constexpr size_t WS_NEED = OFF_W1 + W1_WNS + 131072;
constexpr size_t OFF_TBUF = OFF_XR;
constexpr size_t OFF_W2 = OFF_KV;
constexpr size_t W2_WO = 0, W2_WFI = 2097152, W2_WFO = 13631488;
constexpr size_t OFF_ACT = OFF_U;
constexpr size_t OFF_MERGED = OFF_GV;

struct Params { const float* in[29]; float* out; char* ws; };

DI int otid() { int t = (int)__builtin_amdgcn_workitem_id_x(); asm volatile("" : "+v"(t)); return t; }
DI int htid() { int t = (int)__builtin_amdgcn_workitem_id_x() & 255; asm volatile("" : "+v"(t)); return t; }
DI u16 f2bf(float x) { unsigned u = __float_as_uint(x); u += 0x7fffu + ((u >> 16) & 1u); return (u16)(u >> 16); }
DI float bf2f(u16 b) { return __uint_as_float(((unsigned)b) << 16); }
typedef __bf16 bf2_t __attribute__((ext_vector_type(2)));
typedef float f2_t __attribute__((ext_vector_type(2)));
DI unsigned pack2(float a, float b) { f2_t v; v.x = a; v.y = b; return __builtin_bit_cast(unsigned, __builtin_convertvector(v, bf2_t)); }
DI float bflo(unsigned w) { return __uint_as_float(w << 16); }
DI float bfhi(unsigned w) { return __uint_as_float(w & 0xffff0000u); }
DI float rcpf(float x) { return __builtin_amdgcn_rcpf(x); }
DI float sigmoidf_(float x) { return rcpf(1.f + __expf(-x)); }
DI float geluf_(float x) { float y = 1.5957691216f * (x + 0.044715f * x * x * x); return x * rcpf(1.f + __expf(-y)); }
DI float wave_sum(float v) {
#pragma unroll
  for (int o = 32; o >= 1; o >>= 1) v += __shfl_xor(v, o);
  return v;
}
DI float lane_swap1(float v) { const int u = (int)__float_as_uint(v); return __uint_as_float((unsigned)__builtin_amdgcn_update_dpp(u, u, 0xB1, 0xF, 0xF, false)); }
DI unsigned lane_swap2u(unsigned v) { return (unsigned)__builtin_amdgcn_update_dpp((int)v, (int)v, 0x4E, 0xF, 0xF, false); }
DI uint2 quad_transpose_pack(float a, float b, float c, float d, int k) {
  const int odd = k & 1, hi2 = k >> 1;
  const float r0 = lane_swap1(odd ? a : b), r1 = lane_swap1(odd ? c : d);
  const unsigned W0 = odd ? pack2(r0, b) : pack2(a, r0);
  const unsigned W1 = odd ? pack2(r1, d) : pack2(c, r1);
  const unsigned rcv = lane_swap2u(hi2 ? W0 : W1);
  uint2 o; o.x = hi2 ? rcv : W0; o.y = hi2 ? W1 : rcv;
  return o;
}
DI f32x16 zero16() { f32x16 v;
#pragma unroll
  for (int i = 0; i < 16; ++i) v[i] = 0.f;
  return v; }
DI void store4bf(u16* p, float a, float b, float c, float d) { uint2 v; v.x = pack2(a, b); v.y = pack2(c, d); *(uint2*)p = v; }

struct TileSrc { const u16* A; long lda; const u16* Bt; long ldb; };
struct Stg { u32x4 a0, a1, a2, a3, b0, b1, b2, b3; };
template <int MI, int WN> DI void gemm512(f32x4 (&acc)[4][2 * MI], const TileSrc cur, int K, char* smem, Stg& st, bool pre, const TileSrc nxt, bool hasnxt) {
  const int tid = otid(), lane = tid & 63, wid = tid >> 6;
  const int wm = wid / WN, wn = wid % WN;
  const int r16 = lane & 15, q = lane >> 4;
  const int lr = tid >> 3, lc = tid & 7;
  const int soff = lr * 128 + ((lc ^ ((lr >> 1) & 7)) << 4);
  const u16* ga = cur.A + (long)lr * cur.lda + lc * 8;
  const u16* gb = cur.Bt + (long)lr * cur.ldb + lc * 8;
  long a64 = 64 * cur.lda, b64 = 64 * cur.ldb;
  const int nk = K >> 6;
#define G512_LOAD() do { st.a0 = *(const u32x4*)(ga); st.a1 = *(const u32x4*)(ga + a64); st.a2 = *(const u32x4*)(ga + 2 * a64); st.a3 = *(const u32x4*)(ga + 3 * a64); \
    st.b0 = *(const u32x4*)(gb); if (WN > 1) st.b1 = *(const u32x4*)(gb + b64); if (WN > 2) { st.b2 = *(const u32x4*)(gb + 2 * b64); st.b3 = *(const u32x4*)(gb + 3 * b64); } } while (0)
#define G512_STORE(d) do { *(u32x4*)((d) + soff) = st.a0; *(u32x4*)((d) + soff + 8192) = st.a1; *(u32x4*)((d) + soff + 16384) = st.a2; *(u32x4*)((d) + soff + 24576) = st.a3; \
    *(u32x4*)((d) + 32768 + soff) = st.b0; if (WN > 1) *(u32x4*)((d) + 32768 + soff + 8192) = st.b1; if (WN > 2) { *(u32x4*)((d) + 32768 + soff + 16384) = st.b2; *(u32x4*)((d) + 32768 + soff + 24576) = st.b3; } } while (0)
  if (!pre) G512_LOAD();
  G512_STORE(smem);
  ga += 64; gb += 64;
  G512_LOAD();
  const int sw = r16 >> 1;
  for (int kt = 0; kt < nk; ++kt) {
    __syncthreads();
    if (kt + 1 < nk) {
      char* d = smem + ((kt + 1) & 1) * 65536;
      G512_STORE(d);
      if (kt + 2 < nk) { ga += 64; gb += 64; G512_LOAD(); }
      else if (hasnxt) {
        ga = nxt.A + (long)lr * nxt.lda + lc * 8; gb = nxt.Bt + (long)lr * nxt.ldb + lc * 8; a64 = 64 * nxt.lda; b64 = 64 * nxt.ldb;
        G512_LOAD();
      }
    }
    const char* sa = smem + (kt & 1) * 65536;
    const char* sb = sa + 32768;
#pragma unroll
    for (int ks = 0; ks < 2; ++ks) {
      bf16x8 fa[4];
      const int coff = ((ks * 4 + q) ^ sw) << 4;
#pragma unroll
      for (int nf = 0; nf < 4; ++nf) fa[nf] = *(const bf16x8*)(sb + (wn * 64 + nf * 16 + r16) * 128 + coff);
      constexpr int MG = (MI >= 2) ? 4 : 2;
      for (int mh = 0; mh < (2 * MI) / MG; ++mh) {
        bf16x8 fb[MG];
#pragma unroll
        for (int mf = 0; mf < MG; ++mf) fb[mf] = *(const bf16x8*)(sa + (wm * (MI * 32) + (mh * MG + mf) * 16 + r16) * 128 + coff);
#pragma unroll
        for (int nf = 0; nf < 4; ++nf)
#pragma unroll
          for (int mf = 0; mf < MG; ++mf) acc[nf][mh * MG + mf] = MFMA16(fa[nf], fb[mf], acc[nf][mh * MG + mf]);
      }
    }
  }
  if (nk & 1) __syncthreads();
#undef G512_LOAD
#undef G512_STORE
}
template <int MI, int WN, class F> DI void epi512(const f32x4 (&acc)[4][2 * MI], int m0, int n0, F f) {
  const int tid = otid(), lane = tid & 63, wid = tid >> 6, wm = wid / WN, wn = wid % WN, r16 = lane & 15, q = lane >> 4;
#pragma unroll
  for (int nf = 0; nf < 4; ++nf) {
#pragma unroll
    for (int mf = 0; mf < 2 * MI; ++mf) {
      const int m = m0 + wm * (MI * 32) + mf * 16 + r16;
      const int n = n0 + wn * 64 + nf * 16 + q * 4;
      f(m, n, acc[nf][mf][0], acc[nf][mf][1], acc[nf][mf][2], acc[nf][mf][3]);
      __builtin_amdgcn_sched_barrier(0);
    }
  }
}
template <int MI, int WN, class TF> DI void epi512_rows16(const f32x4 (&acc)[4][2 * MI], int m0, int n0, u16* dst, long ld, int coladj, TF tf) {
  const int tid = otid(), lane = tid & 63, wid = tid >> 6, wm = wid / WN, wn = wid % WN, r16 = lane & 15, q = lane >> 4;
#pragma unroll
  for (int mf = 0; mf < 2 * MI; ++mf) {
    const int m = m0 + wm * (MI * 32) + mf * 16 + r16;
#pragma unroll
    for (int pp = 0; pp < 2; ++pp) {
      const unsigned ax = pack2(tf(acc[2 * pp][mf][0]), tf(acc[2 * pp][mf][1])), ay = pack2(tf(acc[2 * pp][mf][2]), tf(acc[2 * pp][mf][3]));
      const unsigned bx = pack2(tf(acc[2 * pp + 1][mf][0]), tf(acc[2 * pp + 1][mf][1])), by = pack2(tf(acc[2 * pp + 1][mf][2]), tf(acc[2 * pp + 1][mf][3]));
      auto rx = __builtin_amdgcn_permlane16_swap(ax, bx, false, false);
      auto ry = __builtin_amdgcn_permlane16_swap(ay, by, false, false);
      const int n = n0 + wn * 64 + (2 * pp + (q & 1)) * 16 + (q >> 1) * 8;
      uint4 o; o.x = rx[0]; o.y = ry[0]; o.z = rx[1]; o.w = ry[1];
      *(uint4*)(dst + (long)m * ld + n + coladj) = o;
    }
    __builtin_amdgcn_sched_barrier(0);
  }
}
template <int MI, int WN, class AF> DI void epi512_rows16_at(const f32x4 (&acc)[4][2 * MI], int m0, int n0, AF af) {
  const int tid = otid(), lane = tid & 63, wid = tid >> 6, wm = wid / WN, wn = wid % WN, r16 = lane & 15, q = lane >> 4;
#pragma unroll
  for (int mf = 0; mf < 2 * MI; ++mf) {
    const int m = m0 + wm * (MI * 32) + mf * 16 + r16;
#pragma unroll
    for (int pp = 0; pp < 2; ++pp) {
      auto rx = __builtin_amdgcn_permlane16_swap(pack2(acc[2 * pp][mf][0], acc[2 * pp][mf][1]), pack2(acc[2 * pp + 1][mf][0], acc[2 * pp + 1][mf][1]), false, false);
      auto ry = __builtin_amdgcn_permlane16_swap(pack2(acc[2 * pp][mf][2], acc[2 * pp][mf][3]), pack2(acc[2 * pp + 1][mf][2], acc[2 * pp + 1][mf][3]), false, false);
      const int n = n0 + wn * 64 + (2 * pp + (q & 1)) * 16 + (q >> 1) * 8;
      uint4 o; o.x = rx[0]; o.y = ry[0]; o.z = rx[1]; o.w = ry[1];
      *(uint4*)af(m, n) = o;
    }
    __builtin_amdgcn_sched_barrier(0);
  }
}
template <int MI> DI void zero_acc(f32x4 (&acc)[4][2 * MI]) {
#pragma unroll
  for (int a = 0; a < 4; ++a)
#pragma unroll
    for (int b = 0; b < 2 * MI; ++b) { acc[a][b][0] = 0.f; acc[a][b][1] = 0.f; acc[a][b][2] = 0.f; acc[a][b][3] = 0.f; }
}

template <int NI> DI void gemm_h(f32x16 (&acc)[NI][2], const u16* __restrict__ A, long lda, const u16* __restrict__ Bt, long ldb, int K, char* smem) {
  const int tid = htid(), lane = tid & 63, wid = tid >> 6;
  const int wm = wid >> 1, wn = wid & 1;
  const int r32 = lane & 31, h = lane >> 5;
  const int lr = tid >> 3, lc = tid & 7;
  const u16* ga = A + (long)lr * lda + lc * 8;
  const u16* gb = Bt + (long)lr * ldb + lc * 8;
  const int soff = lr * 128 + ((lc ^ ((lr & 7) ^ ((lr >> 3) & 1))) << 4);
  uint4 ra[4], rb[2 * NI];
  const int nk = K >> 6;
#pragma unroll
  for (int i = 0; i < 4; ++i) ra[i] = *(const uint4*)(ga + (long)(32 * i) * lda);
#pragma unroll
  for (int i = 0; i < 2 * NI; ++i) rb[i] = *(const uint4*)(gb + (long)(32 * i) * ldb);
#pragma unroll
  for (int i = 0; i < 4; ++i) *(uint4*)(smem + soff + i * 4096) = ra[i];
#pragma unroll
  for (int i = 0; i < 2 * NI; ++i) *(uint4*)(smem + 16384 + soff + i * 4096) = rb[i];
  __syncthreads();
  const int sw = (r32 & 7) ^ ((r32 >> 3) & 1);
  for (int kt = 0; kt < nk; ++kt) {
    const bool more = (kt + 1 < nk);
    if (more) {
      ga += 64; gb += 64;
#pragma unroll
      for (int i = 0; i < 4; ++i) ra[i] = *(const uint4*)(ga + (long)(32 * i) * lda);
#pragma unroll
      for (int i = 0; i < 2 * NI; ++i) rb[i] = *(const uint4*)(gb + (long)(32 * i) * ldb);
    }
    const char* sa = smem + (kt & 1) * 32768;
    const char* sb = sa + 16384;
#pragma unroll
    for (int ks = 0; ks < 4; ++ks) {
      bf16x8 fa[NI], fb[2];
      const int coff = ((ks * 2 + h) ^ sw) << 4;
#pragma unroll
      for (int ni = 0; ni < NI; ++ni) fa[ni] = *(const bf16x8*)(sb + (wn * (32 * NI) + ni * 32 + r32) * 128 + coff);
#pragma unroll
      for (int mi = 0; mi < 2; ++mi) fb[mi] = *(const bf16x8*)(sa + (wm * 64 + mi * 32 + r32) * 128 + coff);
#pragma unroll
      for (int ni = 0; ni < NI; ++ni)
#pragma unroll
        for (int mi = 0; mi < 2; ++mi) acc[ni][mi] = MFMA32(fa[ni], fb[mi], acc[ni][mi]);
    }
    if (more) {
      char* d = smem + ((kt + 1) & 1) * 32768;
#pragma unroll
      for (int i = 0; i < 4; ++i) *(uint4*)(d + soff + i * 4096) = ra[i];
#pragma unroll
      for (int i = 0; i < 2 * NI; ++i) *(uint4*)(d + 16384 + soff + i * 4096) = rb[i];
    }
    __syncthreads();
  }
}

template <int NI, class F> DI void epi_h(const f32x16 (&acc)[NI][2], int m0, int n0, F f) {
  const int lane = htid() & 63, wid = htid() >> 6, wm = wid >> 1, wn = wid & 1, r32 = lane & 31, h = lane >> 5;
#pragma unroll
  for (int ni = 0; ni < NI; ++ni)
#pragma unroll
    for (int mi = 0; mi < 2; ++mi) {
      const int m = m0 + wm * 64 + mi * 32 + r32;
#pragma unroll
      for (int g4 = 0; g4 < 4; ++g4) {
        const int n = n0 + wn * (32 * NI) + ni * 32 + 8 * g4 + 4 * h;
        f(m, n, acc[ni][mi][4 * g4 + 0], acc[ni][mi][4 * g4 + 1], acc[ni][mi][4 * g4 + 2], acc[ni][mi][4 * g4 + 3]);
      }
    }
}

DI int srccol(int mode, int param, int n) {
  if (mode == 0) return n + param;
  if (mode == 1) { if (n < 4608) return n; if (n < 6656) return n + 48; if (n < 6704) return n - 2048; return -1; }
  if (mode == 3) return (n < 48) ? (4608 + n) : -1;
  const int blk = n >> 6, w = n & 63;
  return (w < 32) ? (blk * 32 + w) : (2816 + blk * 32 + (w - 32));
}
DI void conv_tile(const float* __restrict__ src, int lds_, u16* __restrict__ dst, int K, int mode, int param, int tile, char* smem) {
  const int tid = htid();
  const int ntk = K >> 6;
  const int k0 = (tile % ntk) * 64, n0 = (tile / ntk) * 64;
  float* tl = (float*)smem;
  {
    const int c = tid & 63, i0 = tid >> 6;
    const int sc = srccol(mode, param, n0 + c);
#pragma unroll
    for (int j = 0; j < 16; ++j) { const int k = i0 + 4 * j; tl[k * 65 + c] = (sc >= 0) ? src[(long)(k0 + k) * lds_ + sc] : 0.f; }
  }
  __syncthreads();
#pragma unroll
  for (int jj = 0; jj < 2; ++jj) {
    const int nl = (tid >> 3) + 32 * jj, kc = tid & 7;
    float v[8];
#pragma unroll
    for (int e = 0; e < 8; ++e) v[e] = tl[(kc * 8 + e) * 65 + nl];
    uint4 o; o.x = pack2(v[0], v[1]); o.y = pack2(v[2], v[3]); o.z = pack2(v[4], v[5]); o.w = pack2(v[6], v[7]);
    *(uint4*)(dst + (long)(n0 + nl) * K + k0 + kc * 8) = o;
  }
  __syncthreads();
}

constexpr int CONV1_TILES = 1728 + 768 + 768 + 256 + 8 + 16;
constexpr int CONV1_ITEMS = CONV1_TILES + 8 + 32;
DI void conv1_item(const Params& p, int l, int t, char* smem) {
  char* w1 = p.ws + OFF_W1;
  const int tid = htid();
  if (t < CONV1_TILES) {
    const float* win = p.in[5] + (long)l * 1024 * 9776;
    if (t < 1728) { conv_tile(win, 9776, (u16*)(w1 + W1_WIN), 1024, 1, 0, t, smem); return; }
    t -= 1728;
    if (t < 768) { conv_tile(win, 9776, (u16*)(w1 + W1_WMG), 1024, 0, 6704, t, smem); return; }
    t -= 768;
    if (t < 768) { const int k = t >> 8; conv_tile(p.in[23 + k] + (long)l * 1048576, 1024, (u16*)(w1 + W1_WBR) + (long)k * 1048576, 1024, 0, 0, t & 255, smem); return; }
    t -= 768;
    if (t < 256) { const int kv = t >> 7; conv_tile(p.in[kv ? 14 : 12] + (long)l * 524288, 256, (u16*)(w1 + (kv ? W1_WV1 : W1_WK1)), 2048, 0, 0, t & 127, smem); return; }
    t -= 256;
    if (t < 8) { const int kv = t >> 2; conv_tile(p.in[kv ? 15 : 13] + (long)l * 16384, 64, (u16*)(w1 + (kv ? W1_WV2 : W1_WK2)), 256, 0, 0, t & 3, smem); return; }
    t -= 8;
    { conv_tile(win, 9776, (u16*)(w1 + W1_WNS), 1024, 3, 0, t, smem); return; }
  }
  t -= CONV1_TILES;
  if (t < 8) {
    const int kv = t >> 2, jg = t & 3;
    const float* pe = p.in[10 + kv] + (long)l * 2048;
    const float* w = p.in[kv ? 14 : 12] + (long)l * 524288;
    const int j = jg * 64 + (tid & 63), ksl = tid >> 6;
    float s = 0.f;
    for (int kk = ksl * 512; kk < ksl * 512 + 512; kk += 16) {
      float wv[16];
#pragma unroll
      for (int u = 0; u < 16; ++u) wv[u] = w[(long)(kk + u) * 256 + j];
#pragma unroll
      for (int u = 0; u < 16; ++u) s += pe[kk + u] * wv[u];
    }
    float* red = (float*)smem;
    red[tid] = s;
    __syncthreads();
    if (tid < 64) { float r = red[tid] + red[tid + 64] + red[tid + 128] + red[tid + 192]; ((float*)(p.ws + OFF_SM + SM_CKV))[kv * 256 + jg * 64 + tid] = r; }
    __syncthreads();
    return;
  }
  t -= 8;
  {
    const float* wsrc = p.in[8] + (long)l * 65536;
    u16* dst = (u16*)(p.ws + OFF_SM + SM_WSB);
    const int e0 = t * 2048 + tid * 8;
    const int tt = (e0 >> 7) & 127, s0 = e0 & 127;
    float v[8];
#pragma unroll
    for (int e = 0; e < 8; ++e) v[e] = (s0 + e <= tt) ? wsrc[e0 + e] : 0.f;
    uint4 o; o.x = pack2(v[0], v[1]); o.y = pack2(v[2], v[3]); o.z = pack2(v[4], v[5]); o.w = pack2(v[6], v[7]);
    *(uint4*)(dst + e0) = o;
  }
}
constexpr int CONV2_TILES = 256 + 1408 + 704;
DI void conv2_item(const Params& p, int l, int t, char* smem) {
  char* w2 = p.ws + OFF_W2;
  if (t < 256) { conv_tile(p.in[26] + (long)l * 1048576, 1024, (u16*)(w2 + W2_WO), 1024, 0, 0, t, smem); return; }
  t -= 256;
  if (t < 1408) { conv_tile(p.in[27] + (long)l * 1024 * 5632, 5632, (u16*)(w2 + W2_WFI), 1024, 2, 0, t, smem); return; }
  t -= 1408;
  conv_tile(p.in[28] + (long)l * 2816 * 1024, 1024, (u16*)(w2 + W2_WFO), 2816, 0, 0, t, smem);
}

DI void row_item(int item, const float* __restrict__ res_in, const u16* __restrict__ delta, const float* __restrict__ g_post,
                 float* __restrict__ res_out, const float* __restrict__ g_next, u16* __restrict__ hnext, unsigned long long* __restrict__ stats) {
  const int lane = otid() & 63;
  const long row = (long)item * 8 + (otid() >> 6);
  float x[16];
#pragma unroll
  for (int j = 0; j < 4; ++j) { const float4 v = *(const float4*)(res_in + row * 1024 + j * 256 + lane * 4); x[4 * j] = v.x; x[4 * j + 1] = v.y; x[4 * j + 2] = v.z; x[4 * j + 3] = v.w; }
  if (delta) {
    float d[16]; float ss = 0.f;
#pragma unroll
    for (int j = 0; j < 4; ++j) { const uint2 v = *(const uint2*)(delta + row * 1024 + j * 256 + lane * 4); d[4 * j] = bflo(v.x); d[4 * j + 1] = bfhi(v.x); d[4 * j + 2] = bflo(v.y); d[4 * j + 3] = bfhi(v.y); }
#pragma unroll
    for (int i = 0; i < 16; ++i) ss += d[i] * d[i];
    ss = wave_sum(ss);
    const float rs = rsqrtf(ss * (1.f / 1024.f) + 1e-6f);
#pragma unroll
    for (int j = 0; j < 4; ++j) {
      const float4 g = *(const float4*)(g_post + j * 256 + lane * 4);
      x[4 * j] += d[4 * j] * rs * g.x; x[4 * j + 1] += d[4 * j + 1] * rs * g.y; x[4 * j + 2] += d[4 * j + 2] * rs * g.z; x[4 * j + 3] += d[4 * j + 3] * rs * g.w;
      float4 o; o.x = x[4 * j]; o.y = x[4 * j + 1]; o.z = x[4 * j + 2]; o.w = x[4 * j + 3];
      *(float4*)(res_out + row * 1024 + j * 256 + lane * 4) = o;
    }
  }
  if (hnext) {
    if (stats && lane < 2) { unsigned long long zz = 0ull; asm volatile("" : "+v"(zz)); stats[row * 2 + lane] = zz; }
    float ss = 0.f;
#pragma unroll
    for (int i = 0; i < 16; ++i) ss += x[i] * x[i];
    ss = wave_sum(ss);
    const float rs = rsqrtf(ss * (1.f / 1024.f) + 1e-6f);
#pragma unroll
    for (int j = 0; j < 4; ++j) {
      const float4 g = *(const float4*)(g_next + j * 256 + lane * 4);
      store4bf(hnext + row * 1024 + j * 256 + lane * 4, x[4 * j] * rs * g.x, x[4 * j + 1] * rs * g.y, x[4 * j + 2] * rs * g.z, x[4 * j + 3] * rs * g.w);
    }
  }
}

DI bool xcd_tile(int round, int NT, int& mt, int& nt) {
  const int bid = blockIdx.x, x = bid & 7, lb = bid >> 3;
  const int ti = round * 32 + lb;
  mt = x * 8 + (ti & 7); nt = ti >> 3;
  return nt < NT;
}
DI TileSrc srcB(const Params& p, int item) {
  const int nt = item % 27, mt = item / 27;
  TileSrc t; t.A = (const u16*)(p.ws + OFF_HB) + (long)mt * 256 * 1024; t.lda = 1024; t.Bt = (const u16*)(p.ws + OFF_W1 + W1_WIN) + (long)nt * 256 * 1024; t.ldb = 1024;
  return t;
}
DI void phaseB_tile(const Params& p, int item, char* smem, Stg& st, bool pre, int nitem, bool hasnxt) {
  const int nt = item % 27, mt = item / 27;
  const int m0 = mt * 256, n0 = nt * 256;
  char* ws = p.ws;
  f32x4 acc[4][8];
  zero_acc<4>(acc);
  gemm512<4, 4>(acc, srcB(p, item), 1024, smem, st, pre, srcB(p, nitem), hasnxt);
  if (n0 < 1024) {
    u16* U = (u16*)(ws + OFF_U);
    epi512_rows16<4, 4>(acc, m0, n0, U, 1024, 0, [](float v) { return geluf_(v); });
  } else if (n0 < 2048) {
    u16* G = (u16*)(ws + OFF_GV);
    unsigned long long* stats = (unsigned long long*)(ws + OFF_SM + SM_STATS);
    const int tid = otid(), lane = tid & 63, wid = tid >> 6, wm = wid >> 2, wn = wid & 3, r16 = lane & 15, q = lane >> 4;
#pragma unroll
    for (int mf = 0; mf < 8; ++mf) {
      const int m = m0 + wm * 128 + mf * 16 + r16;
      float s1 = 0.f, s2 = 0.f;
#pragma unroll
      for (int nf = 0; nf < 4; ++nf) {
        const int d = n0 - 1024 + wn * 64 + nf * 16 + q * 4;
        float gg[4];
#pragma unroll
        for (int e = 0; e < 4; ++e) { gg[e] = geluf_(acc[nf][mf][e]); s1 += gg[e]; s2 += gg[e] * gg[e]; }
        const int k4 = lane & 3;
        *(uint2*)(G + ((long)(m >> 7) * 1024 + d + k4) * 128 + ((m & 127) - k4)) = quad_transpose_pack(gg[0], gg[1], gg[2], gg[3], k4);
      }
      s1 += __shfl_xor(s1, 16); s2 += __shfl_xor(s2, 16);
      s1 += __shfl_xor(s1, 32); s2 += __shfl_xor(s2, 32);
      if (q == 0) {
        atomicAdd(stats + (long)m * 2, (unsigned long long)(long long)__float2ll_rn(s1 * 16777216.f));
        atomicAdd(stats + (long)m * 2 + 1, (unsigned long long)(long long)__float2ll_rn(s2 * 16777216.f));
      }
      __builtin_amdgcn_sched_barrier(0);
    }
  } else if (n0 < 3072) {
    u16* Q = (u16*)(ws + OFF_Q);
    epi512_rows16<4, 4>(acc, m0, n0, Q, 1024, -2048, [](float v) { return v; });
  } else if (n0 < 4608) {
    const int i6 = (n0 - 3072) >> 8;
    u16* base = (u16*)(ws + OFF_KV) + (long)i6 * KV_ELEMS;
    if (i6 == 3 || i6 == 5) {
      epi512<4, 4>(acc, m0, n0, [&](int m, int n, float a, float b, float c, float d) {
        const int cc = n - 3072, g = (cc >> 6) & 3, dd = cc & 63, bb = m >> 11, s = m & 2047;
        const int k4 = (int)__builtin_amdgcn_workitem_id_x() & 3;
        *(uint2*)(base + ((long)(bb * 4 + g) * 64 + dd + k4) * 2048 + (s - k4)) = quad_transpose_pack(a, b, c, d, k4);
      });
    } else {
      epi512_rows16_at<4, 4>(acc, m0, n0, [&](int m, int n) {
        const int cc = n - 3072, g = (cc >> 6) & 3, dd = cc & 63, bb = m >> 11, s = m & 2047;
        return base + ((long)(bb * 4 + g) * 2048 + s) * 64 + dd;
      });
    }
  } else if (n0 < 5632) {
    u16* X = (u16*)(ws + OFF_XR);
    epi512_rows16<4, 4>(acc, m0, n0, X, 1024, -4608, [](float v) { return v; });
  } else if (n0 < 6656) {
    u16* R = (u16*)(ws + OFF_RG);
    epi512_rows16<4, 4>(acc, m0, n0, R, 1024, -5632, [](float v) { return geluf_(v); });
  } else {
    float* NG = (float*)(ws + OFF_NG);
    epi512<4, 4>(acc, m0, n0, [&](int m, int n, float a, float b, float c, float d) {
      const int cc = n - 6656;
      if (cc < 48) { float4 o; o.x = sigmoidf_(a); o.y = sigmoidf_(b); o.z = sigmoidf_(c); o.w = sigmoidf_(d); *(float4*)(NG + (long)m * 48 + cc) = o; }
    });
  }
}

DI void nsa_item(const Params& p, int strip, char* smem) {
  char* ws = p.ws;
  f32x4 acc[4][2];
  zero_acc<1>(acc);
  {
    Stg st;
    TileSrc t; t.A = (const u16*)(ws + OFF_HB) + (long)strip * 256 * 1024; t.lda = 1024; t.Bt = (const u16*)(ws + OFF_W1 + W1_WNS); t.ldb = 1024;
    gemm512<1, 1>(acc, t, 1024, smem, st, false, t, false);
  }
  float* NG = (float*)(ws + OFF_NG);
  const int tid = otid(), lane = tid & 63, wid = tid >> 6, r16 = lane & 15, q = lane >> 4;
#pragma unroll
  for (int mf = 0; mf < 2; ++mf) {
    const int m = strip * 256 + wid * 32 + mf * 16 + r16;
#pragma unroll
    for (int nf = 0; nf < 3; ++nf) {
      const int c = nf * 16 + q * 4;
      float4 o; o.x = sigmoidf_(acc[nf][mf][0]); o.y = sigmoidf_(acc[nf][mf][1]); o.z = sigmoidf_(acc[nf][mf][2]); o.w = sigmoidf_(acc[nf][mf][3]);
      *(float4*)(NG + (long)m * 48 + c) = o;
    }
  }
  __syncthreads();
}
DI void phaseB_half_tile(const Params& p, int mt, int n0, char* smem) {
  const int m0 = mt * 256;
  char* ws = p.ws;
  f32x4 acc[4][4];
  zero_acc<2>(acc);
  {
    Stg st;
    TileSrc t; t.A = (const u16*)(ws + OFF_HB) + (long)m0 * 1024; t.lda = 1024; t.Bt = (const u16*)(ws + OFF_W1 + W1_WIN) + (long)n0 * 1024; t.ldb = 1024;
    gemm512<2, 2>(acc, t, 1024, smem, st, false, t, false);
  }
  u16* R = (u16*)(ws + OFF_RG);
  epi512_rows16<2, 2>(acc, m0, n0, R, 1024, -5632, [](float v) { return geluf_(v); });
}

DI void rglru_item(const Params& p, int l, int item, char* smem) {
  const int tid = htid(), lane = tid & 63, w = tid >> 6, r32 = lane & 31, h = lane >> 5;
  const int chalf = item & 1, hd = (item >> 1) & 15, b = item >> 5;
  char* xcb = smem;
  char* WT = smem + 18432;
  float* AL = (float*)(smem + 27648);
  float* BL = (float*)(smem + 44544);
  float* segP = (float*)(smem + 61440);
  float* segH = (float*)(smem + 62464);
  float* carry = (float*)(smem + 63488);
  const u16* XR = (const u16*)(p.ws + OFF_XR);
  u16* RG = (u16*)(p.ws + OFF_RG);
  {
    const float* wa = p.in[18] + (long)l * 65536 + (long)hd * 4096;
    const float* wx = p.in[20] + (long)l * 65536 + (long)hd * 4096;
#pragma unroll 4
    for (int e = 0; e < 16; ++e) {
      const int idx = tid + 256 * e;
      const int gate = idx >> 11, i = (idx >> 5) & 63, o = idx & 31;
      const float v = (gate ? wx : wa)[i * 64 + chalf * 32 + o];
      ((u16*)WT)[((o >> 4) * 32 + gate * 16 + (o & 15)) * 72 + i] = f2bf(v);
    }
    if (tid < 64) carry[tid] = 0.f;
  }
  const int cc = tid & 63, tg = tid >> 6;
  float cw[4];
#pragma unroll
  for (int jj = 0; jj < 4; ++jj) cw[jj] = p.in[16][(long)l * 4096 + jj * 1024 + hd * 64 + cc];
  const float cb = p.in[17][(long)l * 1024 + hd * 64 + cc];
  const int wr = w & 1, mth = w >> 1;
  float ba[8], bx[8], sp[8];
#pragma unroll
  for (int e = 0; e < 8; ++e) {
    const int rho = (e & 3) + 8 * (e >> 2) + 4 * h;
    const int c = hd * 64 + chalf * 32 + wr * 16 + rho;
    ba[e] = p.in[19][(long)l * 1024 + c]; bx[e] = p.in[21][(long)l * 1024 + c];
    sp[e] = -8.f * log1pf(expf(-p.in[22][(long)l * 1024 + c]));
  }
  const int scl = tid & 31, seg = tid >> 5;
  float xn[35];
  {
    const u16* xp = XR + ((long)b * 2048 + tg * 32) * 1024 + hd * 64 + cc;
#pragma unroll
    for (int jj = 0; jj < 35; ++jj) { const int s = tg * 32 + jj - 3; xn[jj] = (s >= 0) ? bf2f(xp[(long)(jj - 3) * 1024]) : 0.f; }
  }
  __syncthreads();
#pragma unroll 1
  for (int ch = 0; ch < 16; ++ch) {
    const int s0 = ch * 128;
    u16* rp = RG + ((long)b * 2048 + s0 + seg * 16) * 1024 + hd * 64 + chalf * 32 + scl;
    float rgv[16];
#pragma unroll
    for (int jj = 0; jj < 16; ++jj) rgv[jj] = bf2f(rp[(long)jj * 1024]);
#pragma unroll
    for (int tt = 0; tt < 32; ++tt) {
      const float v = cb + cw[0] * xn[tt] + cw[1] * xn[tt + 1] + cw[2] * xn[tt + 2] + cw[3] * xn[tt + 3];
      ((u16*)xcb)[(tg * 32 + tt) * 72 + cc] = f2bf(v);
    }
    if (ch + 1 < 16) {
      const u16* xp = XR + ((long)b * 2048 + s0 + 128 + tg * 32) * 1024 + hd * 64 + cc;
#pragma unroll
      for (int jj = 0; jj < 35; ++jj) xn[jj] = bf2f(xp[(long)(jj - 3) * 1024]);
    }
    __syncthreads();
#pragma unroll
    for (int m2 = 0; m2 < 2; ++m2) {
      const int mt = mth * 2 + m2;
      f32x16 acc = zero16();
#pragma unroll
      for (int ks = 0; ks < 4; ++ks) {
        const bf16x8 fa = *(const bf16x8*)(WT + (wr * 32 + r32) * 144 + ks * 32 + h * 16);
        const bf16x8 fb = *(const bf16x8*)(xcb + (mt * 32 + r32) * 144 + ks * 32 + h * 16);
        acc = MFMA32(fa, fb, acc);
      }
      const int t = mt * 32 + r32;
#pragma unroll
      for (int e = 0; e < 8; ++e) {
        const int rho = (e & 3) + 8 * (e >> 2) + 4 * h;
        const int cl = wr * 16 + rho;
        const float r = sigmoidf_(acc[e] + ba[e]), ii = sigmoidf_(acc[e + 8] + bx[e]);
        const float la = r * sp[e];
        const float a = __expf(la);
        const float om2 = fmaxf(__builtin_fmaf(-a, a, 1.f), 0.f);
        const float xcv = bf2f(((const u16*)xcb)[t * 72 + chalf * 32 + cl]);
        AL[t * 33 + cl] = a;
        BL[t * 33 + cl] = __builtin_amdgcn_sqrtf(om2) * ii * xcv;
      }
    }
    __syncthreads();
    {
      float a[16], bq[16];
      float P = 1.f, H = 0.f;
#pragma unroll
      for (int jj = 0; jj < 16; ++jj) { a[jj] = AL[(seg * 16 + jj) * 33 + scl]; bq[jj] = BL[(seg * 16 + jj) * 33 + scl]; H = a[jj] * H + bq[jj]; P *= a[jj]; }
      segP[seg * 32 + scl] = P; segH[seg * 32 + scl] = H;
      __syncthreads();
      float hh = carry[(ch & 1) * 32 + scl];
      for (int s2 = 0; s2 < seg; ++s2) hh = segP[s2 * 32 + scl] * hh + segH[s2 * 32 + scl];
#pragma unroll
      for (int jj = 0; jj < 16; ++jj) { hh = a[jj] * hh + bq[jj]; rp[(long)jj * 1024] = f2bf(hh * rgv[jj]); }
      if (seg == 7) carry[((ch + 1) & 1) * 32 + scl] = hh;
    }
  }
  __syncthreads();
}

DI void compress_item(const Params& p, int item, char* smem) {
  const int tid = otid(), lane = tid & 63, w = tid >> 6, r32 = lane & 31, h = lane >> 5;
  const int kv = item & 1, mt = item >> 1;
  char* ws = p.ws;
  const u16* w2T = (const u16*)(ws + OFF_W1 + (kv ? W1_WV2 : W1_WK2));
  const float* cb = (const float*)(ws + OFF_SM + SM_CKV) + kv * 256;
  u16* hid = (u16*)(ws + OFF_SM + SM_HID) + (long)item * 65536;
  {
    TileSrc src; src.A = (const u16*)(ws + OFF_KV) + (long)kv * KV_ELEMS + (long)mt * 256 * 1024; src.lda = 1024;
    src.Bt = (const u16*)(ws + OFF_W1 + (kv ? W1_WV1 : W1_WK1)); src.ldb = 2048;
    f32x4 acc[4][8];
    zero_acc<4>(acc);
    Stg st;
    gemm512<4, 4>(acc, src, 2048, smem, st, false, src, false);
    epi512<4, 4>(acc, 0, 0, [&](int m, int n, float a, float b, float c, float d) {
      const float4 cv = *(const float4*)(cb + n);
      store4bf(hid + m * 256 + n, geluf_(a + cv.x), geluf_(b + cv.y), geluf_(c + cv.z), geluf_(d + cv.w));
    });
  }
  __syncthreads();
  f32x16 o2[2]; o2[0] = zero16(); o2[1] = zero16();
#pragma unroll 4
  for (int ks = 0; ks < 16; ++ks) {
    const bf16x8 fb = *(const bf16x8*)(hid + (w * 32 + r32) * 256 + ks * 16 + h * 8);
#pragma unroll
    for (int dt = 0; dt < 2; ++dt) {
      const bf16x8 fa = *(const bf16x8*)(w2T + (dt * 32 + r32) * 256 + ks * 16 + h * 8);
      o2[dt] = MFMA32(fa, fb, o2[dt]);
    }
  }
  const int R = mt * 256 + w * 32 + r32;
  const int bg = R >> 7, n = R & 127;
  const bool dead = (n == 127);
  if (kv == 0) {
    u16* KC = (u16*)(ws + OFF_SM + SM_KC) + (long)bg * 8192;
#pragma unroll
    for (int dt = 0; dt < 2; ++dt)
#pragma unroll
      for (int g4 = 0; g4 < 4; ++g4) {
        const int d = dt * 32 + 8 * g4 + 4 * h;
        if (dead) store4bf(KC + n * 64 + d, 0.f, 0.f, 0.f, 0.f);
        else store4bf(KC + n * 64 + d, o2[dt][4 * g4], o2[dt][4 * g4 + 1], o2[dt][4 * g4 + 2], o2[dt][4 * g4 + 3]);
      }
  } else {
    u16* VCT = (u16*)(ws + OFF_SM + SM_VCT) + (long)bg * 8192;
#pragma unroll
    for (int dt = 0; dt < 2; ++dt)
#pragma unroll
      for (int i = 0; i < 16; ++i) {
        const int d = dt * 32 + (i & 3) + 8 * (i >> 2) + 4 * h;
        VCT[d * 128 + n] = dead ? (u16)0 : f2bf(o2[dt][i]);
      }
  }
  __syncthreads();
}

DI void gmlp_item(const Params& p, int l, int item4, char* smem) {
  const int tid = htid(), lane = tid & 63, w = tid >> 6, r32 = lane & 31, h = lane >> 5;
  const int item = item4 >> 2, g = item4 & 3;
  const long t0 = (long)item * 128;
  char* ws = p.ws;
  const u16* GVT = (const u16*)(ws + OFF_GV) + (long)item * 1024 * 128;
  u16* U = (u16*)(ws + OFF_U);
  const u16* WSB = (const u16*)(ws + OFF_SM + SM_WSB) + (long)g * 16384;
  const long long* stats = (const long long*)(ws + OFF_SM + SM_STATS) + t0 * 2;
  const float* lng = p.in[6] + (long)l * 1024;
  const float* lnb = p.in[7] + (long)l * 1024;
  const float* bs = p.in[9] + (long)l * 512 + g * 128;
  char* ap = smem;
  float* mu = (float*)(smem + 34816);
  float* rs = mu + 128;
  float* c1 = rs + 128;
  float* c2 = c1 + 128;
  if (tid < 128) {
    const float m = (float)stats[tid * 2] * (1.f / 16777216.f / 1024.f);
    const float var = (float)stats[tid * 2 + 1] * (1.f / 16777216.f / 1024.f) - m * m;
    mu[tid] = m; rs[tid] = rsqrtf(fmaxf(var, 0.f) + 1e-6f);
  }
  __syncthreads();
#pragma unroll 2
  for (int i = 0; i < 8; ++i) {
    const int idx = tid + 256 * i;
    const int t = idx >> 4, ch = (idx & 15) * 8;
    const uint4 wv = *(const uint4*)(WSB + t * 128 + ch);
    const unsigned wu[4] = {wv.x, wv.y, wv.z, wv.w};
    float a1 = 0.f, a2 = 0.f;
    uint4 o;
    unsigned* ou = (unsigned*)&o;
#pragma unroll
    for (int e = 0; e < 4; ++e) {
      const float w0 = bflo(wu[e]), w1 = bfhi(wu[e]);
      const unsigned pk = pack2(w0 * rs[ch + 2 * e], w1 * rs[ch + 2 * e + 1]);
      ou[e] = pk;
      a1 += bflo(pk) * mu[ch + 2 * e] + bfhi(pk) * mu[ch + 2 * e + 1];
      a2 += w0 + w1;
    }
    *(uint4*)(ap + t * 272 + ch * 2) = o;
#pragma unroll
    for (int off = 8; off >= 1; off >>= 1) { a1 += __shfl_xor(a1, off); a2 += __shfl_xor(a2, off); }
    if ((idx & 15) == 0) { c1[t] = a1; c2[t] = a2; }
  }
  __syncthreads();
#pragma unroll 1
  for (int dh = 0; dh < 2; ++dh) {
    const int c0 = g * 256 + dh * 128;
    bf16x8 fa[8];
#pragma unroll
    for (int ks = 0; ks < 8; ++ks) fa[ks] = *(const bf16x8*)(GVT + (long)(c0 + w * 32 + r32) * 128 + ks * 16 + h * 8);
    f32x16 acc[4];
#pragma unroll
    for (int mi = 0; mi < 4; ++mi) acc[mi] = zero16();
#pragma unroll
    for (int ks = 0; ks < 8; ++ks) {
#pragma unroll
      for (int mi = 0; mi < 4; ++mi) {
        if (mi >= (ks >> 1)) {
          const bf16x8 fb = *(const bf16x8*)(ap + (mi * 32 + r32) * 272 + ks * 32 + h * 16);
          acc[mi] = MFMA32(fa[ks], fb, acc[mi]);
        }
      }
    }
#pragma unroll
    for (int mi = 0; mi < 4; ++mi) {
      const int t = mi * 32 + r32;
      const float k1 = c1[t], k2 = c2[t], bias = bs[t];
#pragma unroll
      for (int g4 = 0; g4 < 4; ++g4) {
        const int d = c0 + w * 32 + 8 * g4 + 4 * h;
        const float4 gg = *(const float4*)(lng + d), bb = *(const float4*)(lnb + d);
        u16* up = U + (t0 + t) * 1024 + d;
        const uint2 uv = *(const uint2*)up;
        store4bf(up, bflo(uv.x) * (gg.x * (acc[mi][4 * g4] - k1) + bb.x * k2 + bias), bfhi(uv.x) * (gg.y * (acc[mi][4 * g4 + 1] - k1) + bb.y * k2 + bias),
                 bflo(uv.y) * (gg.z * (acc[mi][4 * g4 + 2] - k1) + bb.z * k2 + bias), bfhi(uv.y) * (gg.w * (acc[mi][4 * g4 + 3] - k1) + bb.w * k2 + bias));
      }
    }
  }
  __syncthreads();
}

DI void load_tile64(char* dst, const u16* __restrict__ src, long stride) {
  const int tid = htid();
#pragma unroll
  for (int i = 0; i < 2; ++i) { const int idx = tid + 256 * i; const int r = idx >> 3, c = idx & 7; *(uint4*)(dst + r * 144 + c * 16) = *(const uint4*)(src + (long)r * stride + c * 8); }
}
DI f32x16 qk_sub(const char* ldsK, int kr0, const bf16x8 (&qf)[4], int r32, int h) {
  f32x16 s = zero16();
#pragma unroll
  for (int ks = 0; ks < 4; ++ks) { const bf16x8 kf = *(const bf16x8*)(ldsK + (kr0 + r32) * 144 + ks * 32 + h * 16); s = MFMA32(kf, qf[ks], s); }
  return s;
}
DI void pv_sub(f32x16 (&o)[2], const char* ldsV, int key0, const f32x16& pt, int r32, int h) {
#pragma unroll
  for (int s2 = 0; s2 < 2; ++s2) {
    union { uint4 u; bf16x8 v; } pb;
    pb.u.x = pack2(pt[8 * s2 + 0], pt[8 * s2 + 1]); pb.u.y = pack2(pt[8 * s2 + 2], pt[8 * s2 + 3]);
    pb.u.z = pack2(pt[8 * s2 + 4], pt[8 * s2 + 5]); pb.u.w = pack2(pt[8 * s2 + 6], pt[8 * s2 + 7]);
#pragma unroll
    for (int dt = 0; dt < 2; ++dt) {
      const char* vp = ldsV + (dt * 32 + r32) * 136 + (key0 + 16 * s2 + 4 * h) * 2;
      union { uint4 u; bf16x8 v; } vf;
      const uint2 lo = *(const uint2*)vp, hi = *(const uint2*)(vp + 16);
      vf.u.x = lo.x; vf.u.y = lo.y; vf.u.z = hi.x; vf.u.w = hi.y;
      o[dt] = MFMA32(vf.v, pb.v, o[dt]);
    }
  }
}
#define LOG2E_F 1.4426950408889634f
DI void flash_tile(f32x16 (&O)[2], float& m_run, float& l_run, const char* ldsK, const char* ldsV,
                                          const bf16x8 (&qf)[4], int hi, int lo, int r32, int h) {
  f32x16 s[2];
  s[0] = qk_sub(ldsK, 0, qf, r32, h); s[1] = qk_sub(ldsK, 32, qf, r32, h);
  const bool full = (hi >= 59) && (lo < 0);
  bool rowsel = true;
  if (__builtin_amdgcn_ballot_w64(full) != ~0ull) {
    const bool rowmask = (lo < 0) && (hi >= 59 || hi < 0);
    if (__builtin_amdgcn_ballot_w64(rowmask) == ~0ull) {
      rowsel = hi >= 0;
    } else {
#pragma unroll
      for (int sub = 0; sub < 2; ++sub)
#pragma unroll
        for (int i = 0; i < 16; ++i) {
          const int c = sub * 32 + (i & 3) + 8 * (i >> 2);
          s[sub][i] = (c <= hi && c > lo) ? s[sub][i] : -1e30f;
        }
    }
  }
  float mt = fmaxf(s[0][0], s[1][0]);
#pragma unroll
  for (int i = 1; i < 16; ++i) mt = fmaxf(mt, fmaxf(s[0][i], s[1][i]));
  mt = fmaxf(mt, __shfl_xor(mt, 32));
  mt = rowsel ? mt : -1e30f;
  const float m_new = fmaxf(m_run, mt);
  const float mc = rowsel ? fmaxf(m_new, -1e20f) * LOG2E_F : 1e30f;
  float ls = 0.f;
#pragma unroll
  for (int sub = 0; sub < 2; ++sub)
#pragma unroll
    for (int i = 0; i < 16; ++i) { const float pv = __builtin_amdgcn_exp2f(__builtin_fmaf(s[sub][i], LOG2E_F, -mc)); s[sub][i] = pv; ls += pv; }
  if (__builtin_amdgcn_ballot_w64(m_new != m_run) != 0ull) {
    const float alpha = __builtin_amdgcn_exp2f((m_run - fmaxf(m_new, -1e20f)) * LOG2E_F);
    l_run *= alpha;
#pragma unroll
    for (int dt = 0; dt < 2; ++dt)
#pragma unroll
      for (int i = 0; i < 16; ++i) O[dt][i] *= alpha;
  }
  l_run += ls; m_run = m_new;
  pv_sub(O, ldsV, 0, s[0], r32, h);
  pv_sub(O, ldsV, 32, s[1], r32, h);
}

DI void attn_item(const Params& p, int item, char* smem) {
  const int tid = otid(), lane = tid & 63, w = tid >> 6, r32 = lane & 31, h = lane >> 5;
  const int bg = item & 31, kk = (item >> 5) & 7, rr = (item >> 8) & 3;
  const int qt = (item & 0x10000) ? (31 - ((item >> 5) & 31))
                                  : ((rr == 0) ? (31 - kk) : ((rr == 1) ? (16 + kk) : ((rr == 2) ? (15 - kk) : kk)));
  const int b = bg >> 2, g = bg & 3;
  const int t0 = qt * 64, t = t0 + (w >> 2) * 32 + r32, cur = qt;
  const int hd = g * 4 + (w & 3);
  const long tok = (long)b * 2048 + t;
  char* ws = p.ws;
  u16* Q = (u16*)(ws + OFF_Q);
  float* impA = (float*)(smem + 36864);
  float* impB = (float*)(smem + 70656);
  float* impT = (float*)(smem + 104448);
  unsigned* selm = (unsigned*)(smem + 112896);
  const int lr = tid >> 3, lc = tid & 7;
  const int ldoff = lr * 144 + lc * 16;
  const u16* KS = (const u16*)(ws + OFF_KV) + 2 * KV_ELEMS + (long)bg * 131072;
  const u16* VST = (const u16*)(ws + OFF_KV) + 3 * KV_ELEMS + (long)bg * 131072;
  const u16* KW = (const u16*)(ws + OFF_KV) + 4 * KV_ELEMS + (long)bg * 131072;
  const u16* VWT = (const u16*)(ws + OFF_KV) + 5 * KV_ELEMS + (long)bg * 131072;
  const int jlo = (t0 - 511 > 0) ? ((t0 - 511) >> 6) : 0;
  const int ns = cur + 1, ntile = ns + (cur - jlo + 1);
  u32x4 pkA, pvA, pkB, pvB;
#define ATT_ISSUE(i_, K_, V_) do { const int ii_ = (i_); const bool sl_ = ii_ < ns; const int j_ = sl_ ? ii_ : (jlo + ii_ - ns); \
    K_ = *(const u32x4*)((sl_ ? KS : KW) + (long)j_ * 4096 + lr * 64 + lc * 8); \
    V_ = *(const u32x4*)((sl_ ? VST : VWT) + j_ * 64 + (long)lr * 2048 + lc * 8); } while (0)
  bf16x8 qf[4];
#pragma unroll
  for (int ks = 0; ks < 4; ++ks) {
    u32x4 x = *(const u32x4*)(Q + tok * 1024 + hd * 64 + ks * 16 + h * 8);
#pragma unroll
    for (int e = 0; e < 4; ++e) {
      const float lo = bflo(x[e]) * 0.125f, hi = bfhi(x[e]) * 0.125f;
      x[e] = (__float_as_uint(lo) >> 16) | (__float_as_uint(hi) & 0xffff0000u);
    }
    qf[ks] = __builtin_bit_cast(bf16x8, x);
  }
  const float* NG = (const float*)(ws + OFF_NG) + tok * 48 + hd * 3;
  const float g0 = NG[0], g1 = NG[1], g2 = NG[2];
  f32x16 res[2];
  {
    const u16* KC = (const u16*)(ws + OFF_SM + SM_KC) + (long)bg * 8192;
    const u16* VCT = (const u16*)(ws + OFF_SM + SM_VCT) + (long)bg * 8192;
    const int nsub = ((qt * 4 + 2) >> 5) + 1;
    {
      const u32x4 k0 = *(const u32x4*)(KC + lr * 64 + lc * 8), k1 = *(const u32x4*)(KC + 4096 + lr * 64 + lc * 8);
      const u32x4 v0 = *(const u32x4*)(VCT + lr * 128 + lc * 8), v1 = *(const u32x4*)(VCT + lr * 128 + 64 + lc * 8);
      *(u32x4*)(smem + ldoff) = k0; *(u32x4*)(smem + 18432 + ldoff) = k1;
      { const int vo = lr * 136 + lc * 16;
        uint2 a; a.x = v0[0]; a.y = v0[1]; *(uint2*)(smem + 9216 + vo) = a; a.x = v0[2]; a.y = v0[3]; *(uint2*)(smem + 9216 + vo + 8) = a;
        a.x = v1[0]; a.y = v1[1]; *(uint2*)(smem + 27648 + vo) = a; a.x = v1[2]; a.y = v1[3]; *(uint2*)(smem + 27648 + vo + 8) = a; }
    }
    ATT_ISSUE(0, pkA, pvA);
    ATT_ISSUE(1, pkB, pvB);
    __syncthreads();
    const char* K0 = smem; const char* V0 = smem + 9216; const char* K1 = smem + 18432; const char* V1 = smem + 27648;
    f32x16 sc[4];
    sc[0] = qk_sub(K0, 0, qf, r32, h);
    sc[1] = zero16(); sc[2] = zero16(); sc[3] = zero16();
    if (nsub > 1) sc[1] = qk_sub(K0, 32, qf, r32, h);
    if (nsub > 2) sc[2] = qk_sub(K1, 0, qf, r32, h);
    if (nsub > 3) sc[3] = qk_sub(K1, 32, qf, r32, h);
    float mx = -1e30f;
    const int nlim = ((t - 31) >> 4) - 4 * h;
#pragma unroll
    for (int sub = 0; sub < 4; ++sub)
#pragma unroll
      for (int i = 0; i < 16; ++i) {
        const int c = sub * 32 + (i & 3) + 8 * (i >> 2);
        const float v = (c <= nlim) ? sc[sub][i] : -1e30f;
        sc[sub][i] = v; mx = fmaxf(mx, v);
      }
    mx = fmaxf(mx, __shfl_xor(mx, 32));
    const float mxc = fmaxf(mx, -1e20f) * LOG2E_F;
    float lsum = 0.f;
#pragma unroll
    for (int sub = 0; sub < 4; ++sub)
#pragma unroll
      for (int i = 0; i < 16; ++i) { const float pvv = __builtin_amdgcn_exp2f(__builtin_fmaf(sc[sub][i], LOG2E_F, -mxc)); sc[sub][i] = pvv; lsum += pvv; }
    lsum += __shfl_xor(lsum, 32);
    const float inv = (t >= 31) ? (1.f / lsum) : 0.f;
#pragma unroll
    for (int sub = 0; sub < 4; ++sub)
#pragma unroll
      for (int i = 0; i < 16; ++i) sc[sub][i] *= inv;
    const int qloc = (w >> 2) * 32 + r32, hh4 = w & 3;
#pragma unroll
    for (int sub = 0; sub < 4; ++sub)
#pragma unroll
      for (int g4 = 0; g4 < 4; ++g4) {
        const int mi = 8 * sub + 2 * g4 + h;
        const float p3 = 0.5f * sc[sub][4 * g4 + 3];
        impA[(hh4 * 64 + qloc) * 33 + mi] = sc[sub][4 * g4] + sc[sub][4 * g4 + 1] + sc[sub][4 * g4 + 2] + p3;
        impB[(hh4 * 64 + qloc) * 33 + mi + 1] = p3;
      }
    __syncthreads();
    {
      const int q = tid >> 3, jj = (tid & 7) * 4;
#pragma unroll
      for (int e = 0; e < 4; ++e) {
        const int j = jj + e;
        float tot = 0.f;
#pragma unroll
        for (int ww = 0; ww < 4; ++ww) tot += impA[(ww * 64 + q) * 33 + j];
        if (j > 0) {
#pragma unroll
          for (int ww = 0; ww < 4; ++ww) tot += impB[(ww * 64 + q) * 33 + j];
        }
        impT[q * 33 + j] = tot;
      }
      if (tid < 64) selm[tid] = 0u;
    }
    __syncthreads();
    f32x16 oc[2]; oc[0] = zero16(); oc[1] = zero16();
    pv_sub(oc, V0, 0, sc[0], r32, h);
    if (nsub > 1) pv_sub(oc, V0, 32, sc[1], r32, h);
    if (nsub > 2) pv_sub(oc, V1, 0, sc[2], r32, h);
    if (nsub > 3) pv_sub(oc, V1, 32, sc[3], r32, h);
#pragma unroll
    for (int dt = 0; dt < 2; ++dt)
#pragma unroll
      for (int i = 0; i < 16; ++i) res[dt][i] = g0 * oc[dt][i];
    {
      const int q = tid >> 3, jj = (tid & 7) * 4;
      unsigned bits = 0u;
      for (int e = 0; e < 4; ++e) {
        const int j = jj + e;
        bool sel;
        if (j > cur) sel = false;
        else if (j == 0 || j >= cur - 1) sel = true;
        else if (cur - 2 <= 13) sel = true;
        else {
          const float v = impT[q * 33 + j];
          int rank = 0;
          for (int j2 = 1; j2 <= cur - 2; ++j2) { const float v2 = impT[q * 33 + j2]; rank += ((v2 > v) || (v2 == v && j2 < j)) ? 1 : 0; }
          sel = rank < 13;
        }
        if (sel) bits |= (1u << j);
      }
      atomicOr(&selm[q], bits);
    }
    __syncthreads();
  }
  const unsigned mymask = selm[(w >> 2) * 32 + r32];
  {
    f32x16 O[2]; O[0] = zero16(); O[1] = zero16();
    float m_run = -1e30f, l_run = 0.f;
    auto step = [&](int i, u32x4& pk, u32x4& pv) {
      char* bk = smem + (i & 1) * 18432;
      *(u32x4*)(bk + ldoff) = pk;
      { const int vo = lr * 136 + lc * 16; uint2 a; a.x = pv[0]; a.y = pv[1]; *(uint2*)(bk + 9216 + vo) = a; a.x = pv[2]; a.y = pv[3]; *(uint2*)(bk + 9216 + vo + 8) = a; }
      __syncthreads();
      if (i + 2 < ntile) ATT_ISSUE(i + 2, pk, pv);
      if (i == ns) {
        const float l = l_run + __shfl_xor(l_run, 32);
        const float sc_ = g1 / l;
#pragma unroll
        for (int dt = 0; dt < 2; ++dt)
#pragma unroll
          for (int e = 0; e < 16; ++e) { res[dt][e] += sc_ * O[dt][e]; O[dt][e] = 0.f; }
        m_run = -1e30f; l_run = 0.f;
      }
      const bool sl = i < ns;
      const int j = sl ? i : (jlo + i - ns);
      const int kb = j * 64;
      const int hi = (sl && !((mymask >> j) & 1u)) ? -1 : (t - kb - 4 * h);
      const int lo = sl ? -100000 : (t - 512 - kb - 4 * h);
      flash_tile(O, m_run, l_run, bk, bk + 9216, qf, hi, lo, r32, h);
    };
#pragma unroll 1
    for (int i = 0; i < ntile; i += 2) {
      step(i, pkA, pvA);
      if (i + 1 < ntile) step(i + 1, pkB, pvB);
    }
    const float l = l_run + __shfl_xor(l_run, 32);
    const float sc_ = g2 / l;
#pragma unroll
    for (int dt = 0; dt < 2; ++dt)
#pragma unroll
      for (int e = 0; e < 16; ++e) res[dt][e] += sc_ * O[dt][e];
  }
#undef ATT_ISSUE
#pragma unroll
  for (int dt = 0; dt < 2; ++dt)
#pragma unroll
    for (int g4 = 0; g4 < 4; ++g4)
      store4bf(Q + tok * 1024 + hd * 64 + dt * 32 + 8 * g4 + 4 * h, res[dt][4 * g4], res[dt][4 * g4 + 1], res[dt][4 * g4 + 2], res[dt][4 * g4 + 3]);
  __syncthreads();
}

DI TileSrc srcE(const Params& p, int step) {
  const int item = step / 6, r = step % 6, k = r >> 1, isv = r & 1;
  const int nt = item & 7, mt = item >> 3;
  const size_t yo = (k == 0) ? OFF_U : ((k == 1) ? OFF_Q : OFF_RG);
  TileSrc t;
  t.A = (const u16*)(p.ws + (isv ? yo : OFF_HB)) + (long)mt * 256 * 1024; t.lda = 1024;
  t.Bt = (const u16*)(p.ws + OFF_W1 + (isv ? W1_WBR : W1_WMG)) + ((long)k * 1024 + nt * 128) * 1024; t.ldb = 1024;
  return t;
}
DI void phaseE_tile(const Params& p, int item, char* smem, Stg& st, bool pre, int nitem, bool hasnxt) {
  const int nt = item & 7, mt = item >> 3;
  const int m0 = mt * 256, n0 = nt * 128;
  char* ws = p.ws;
  f32x4 R[4][4];
  zero_acc<2>(R);
#pragma unroll 1
  for (int k = 0; k < 3; ++k) {
    f32x4 acc[4][4];
    zero_acc<2>(acc);
    gemm512<2, 2>(acc, srcE(p, item * 6 + k * 2), 1024, smem, st, pre || (k > 0), srcE(p, item * 6 + k * 2 + 1), true);
    uint4* gs = (uint4*)(ws + OFF_KV + 25165824) + (size_t)blockIdx.x * 4096 + otid();
#pragma unroll
    for (int a = 0; a < 4; ++a) {
#pragma unroll
      for (int b2 = 0; b2 < 2; ++b2) {
        uint4 v;
        v.x = pack2(sigmoidf_(acc[a][2 * b2][0]), sigmoidf_(acc[a][2 * b2][1]));
        v.y = pack2(sigmoidf_(acc[a][2 * b2][2]), sigmoidf_(acc[a][2 * b2][3]));
        v.z = pack2(sigmoidf_(acc[a][2 * b2 + 1][0]), sigmoidf_(acc[a][2 * b2 + 1][1]));
        v.w = pack2(sigmoidf_(acc[a][2 * b2 + 1][2]), sigmoidf_(acc[a][2 * b2 + 1][3]));
        gs[(a * 2 + b2) * 512] = v;
      }
      __builtin_amdgcn_sched_barrier(0);
    }
    zero_acc<2>(acc);
    {
      const bool last = (k == 2);
      gemm512<2, 2>(acc, srcE(p, item * 6 + k * 2 + 1), 1024, smem, st, true, last ? srcE(p, nitem * 6) : srcE(p, item * 6 + k * 2 + 2), last ? hasnxt : true);
    }
#pragma unroll
    for (int a = 0; a < 4; ++a) {
#pragma unroll
      for (int b2 = 0; b2 < 2; ++b2) {
        const uint4 v = gs[(a * 2 + b2) * 512];
        R[a][2 * b2][0] += bflo(v.x) * acc[a][2 * b2][0]; R[a][2 * b2][1] += bfhi(v.x) * acc[a][2 * b2][1];
        R[a][2 * b2][2] += bflo(v.y) * acc[a][2 * b2][2]; R[a][2 * b2][3] += bfhi(v.y) * acc[a][2 * b2][3];
        R[a][2 * b2 + 1][0] += bflo(v.z) * acc[a][2 * b2 + 1][0]; R[a][2 * b2 + 1][1] += bfhi(v.z) * acc[a][2 * b2 + 1][1];
        R[a][2 * b2 + 1][2] += bflo(v.w) * acc[a][2 * b2 + 1][2]; R[a][2 * b2 + 1][3] += bfhi(v.w) * acc[a][2 * b2 + 1][3];
      }
      __builtin_amdgcn_sched_barrier(0);
    }
  }
  u16* M = (u16*)(ws + OFF_MERGED);
  epi512_rows16<2, 2>(R, m0, n0, M, 1024, 0, [](float v) { return v; });
}

DI TileSrc srcP(const u16* A, long lda, const u16* Bt, long ldb, int item) {
  const int nt = item & 3, mt = item >> 2;
  TileSrc t; t.A = A + (long)mt * 256 * lda; t.lda = lda; t.Bt = Bt + (long)nt * 256 * ldb; t.ldb = ldb;
  return t;
}
DI void gemm_f32out_tile(const u16* A, long lda, const u16* Bt, long ldb, int K, u16* C, int item, char* smem, Stg& st, bool pre, int nitem, bool hasnxt) {
  const int nt = item & 3, mt = item >> 2;
  const int m0 = mt * 256, n0 = nt * 256;
  f32x4 acc[4][8];
  zero_acc<4>(acc);
  gemm512<4, 4>(acc, srcP(A, lda, Bt, ldb, item), K, smem, st, pre, srcP(A, lda, Bt, ldb, nitem), hasnxt);
  epi512<4, 4>(acc, m0, n0, [&](int m, int n, float a, float b, float c, float d) { store4bf(C + (long)m * 1024 + n, a, b, c, d); });
}

DI TileSrc srcH(const Params& p, int item) {
  const int nt = item % 22, mt = item / 22;
  TileSrc t; t.A = (const u16*)(p.ws + OFF_HB) + (long)mt * 256 * 1024; t.lda = 1024; t.Bt = (const u16*)(p.ws + OFF_W2 + W2_WFI) + (long)nt * 256 * 1024; t.ldb = 1024;
  return t;
}
DI void phaseH_tile(const Params& p, int item, char* smem, Stg& st, bool pre, int nitem, bool hasnxt) {
  const int nt = item % 22, mt = item / 22;
  const int m0 = mt * 256, n0 = nt * 256;
  char* ws = p.ws;
  f32x4 acc[4][8];
  zero_acc<4>(acc);
  gemm512<4, 4>(acc, srcH(p, item), 1024, smem, st, pre, srcH(p, nitem), hasnxt);
  u16* ACT = (u16*)(ws + OFF_ACT);
  const int tid = otid(), lane = tid & 63, wid = tid >> 6, wm = wid >> 2, wn = wid & 3, r16 = lane & 15, q = lane >> 4;
#pragma unroll
  for (int mf = 0; mf < 8; ++mf) {
    const int m = m0 + wm * 128 + mf * 16 + r16;
    float o[2][4];
#pragma unroll
    for (int nf = 0; nf < 2; ++nf)
#pragma unroll
      for (int e = 0; e < 4; ++e) { const float gt = acc[nf][mf][e], up = acc[nf + 2][mf][e]; o[nf][e] = gt * sigmoidf_(gt) * up; }
    auto rx = __builtin_amdgcn_permlane16_swap(pack2(o[0][0], o[0][1]), pack2(o[1][0], o[1][1]), false, false);
    auto ry = __builtin_amdgcn_permlane16_swap(pack2(o[0][2], o[0][3]), pack2(o[1][2], o[1][3]), false, false);
    const int j = ((n0 + wn * 64) >> 6) * 32 + (q & 1) * 16 + (q >> 1) * 8;
    uint4 ov; ov.x = rx[0]; ov.y = ry[0]; ov.z = rx[1]; ov.w = ry[1];
    *(uint4*)(ACT + (long)m * 2816 + j) = ov;
    __builtin_amdgcn_sched_barrier(0);
  }
}

DI void phaseH_half_tile(const Params& p, int mt, int n0, char* smem) {
  const int m0 = mt * 256;
  char* ws = p.ws;
  f32x4 acc[4][4];
  zero_acc<2>(acc);
  {
    Stg st;
    TileSrc t; t.A = (const u16*)(ws + OFF_HB) + (long)m0 * 1024; t.lda = 1024; t.Bt = (const u16*)(ws + OFF_W2 + W2_WFI) + (long)n0 * 1024; t.ldb = 1024;
    gemm512<2, 2>(acc, t, 1024, smem, st, false, t, false);
  }
  u16* ACT = (u16*)(ws + OFF_ACT);
  const int tid = otid(), lane = tid & 63, wid = tid >> 6, wm = wid >> 1, wn = wid & 1, r16 = lane & 15, q = lane >> 4;
#pragma unroll
  for (int mf = 0; mf < 4; ++mf) {
    const int m = m0 + wm * 64 + mf * 16 + r16;
    float o[2][4];
#pragma unroll
    for (int nf = 0; nf < 2; ++nf)
#pragma unroll
      for (int e = 0; e < 4; ++e) { const float gt = acc[nf][mf][e], up = acc[nf + 2][mf][e]; o[nf][e] = gt * sigmoidf_(gt) * up; }
    auto rx = __builtin_amdgcn_permlane16_swap(pack2(o[0][0], o[0][1]), pack2(o[1][0], o[1][1]), false, false);
    auto ry = __builtin_amdgcn_permlane16_swap(pack2(o[0][2], o[0][3]), pack2(o[1][2], o[1][3]), false, false);
    const int j = ((n0 + wn * 64) >> 6) * 32 + (q & 1) * 16 + (q >> 1) * 8;
    uint4 ov; ov.x = rx[0]; ov.y = ry[0]; ov.z = rx[1]; ov.w = ry[1];
    *(uint4*)(ACT + (long)m * 2816 + j) = ov;
    __builtin_amdgcn_sched_barrier(0);
  }
}

DI void rowsq_exchange(const f32x4 (&acc)[4][8], float* xch, unsigned* cnt, int mt, int nt, char* smem, float* rsv) {
  const int tid = otid(), lane = tid & 63, wid = tid >> 6, wm = wid >> 2, wn = wid & 3, r16 = lane & 15, q = lane >> 4;
  float* part = (float*)smem;
#pragma unroll
  for (int mf = 0; mf < 8; ++mf) {
    float ss = 0.f;
#pragma unroll
    for (int nf = 0; nf < 4; ++nf) ss += acc[nf][mf][0] * acc[nf][mf][0] + acc[nf][mf][1] * acc[nf][mf][1] + acc[nf][mf][2] * acc[nf][mf][2] + acc[nf][mf][3] * acc[nf][mf][3];
    ss += __shfl_xor(ss, 16); ss += __shfl_xor(ss, 32);
    if (q == 0) part[wn * 256 + wm * 128 + mf * 16 + r16] = ss;
  }
  __syncthreads();
  if (tid < 256) {
    const float P = part[tid] + part[256 + tid] + part[512 + tid] + part[768 + tid];
    __hip_atomic_store(xch + ((long)mt * 4 + nt) * 256 + tid, P, __ATOMIC_RELAXED, __HIP_MEMORY_SCOPE_AGENT);
  }
  asm volatile("s_waitcnt vmcnt(0)" ::: "memory");
  __syncthreads();
  if (tid == 0) {
    __hip_atomic_fetch_add(cnt + mt, 1u, __ATOMIC_RELAXED, __HIP_MEMORY_SCOPE_AGENT);
    while (__hip_atomic_load(cnt + mt, __ATOMIC_RELAXED, __HIP_MEMORY_SCOPE_AGENT) < 4u) __builtin_amdgcn_s_sleep(1);
  }
  __syncthreads();
  if (tid < 256) {
    float S = 0.f;
#pragma unroll
    for (int j = 0; j < 4; ++j) S += __hip_atomic_load(xch + ((long)mt * 4 + j) * 256 + tid, __ATOMIC_RELAXED, __HIP_MEMORY_SCOPE_AGENT);
    rsv[tid] = rsqrtf(S * (1.f / 1024.f) + 1e-6f);
  }
  __syncthreads();
}
DI void fused_norm_tile(const Params& p, const u16* A, long lda, const u16* Bt, long ldb, int K, int use, const float* res_in, float* res_out,
                        const float* g_post, const float* g_next, u16* hnext, bool zero_stats, char* smem) {
  const int bid = blockIdx.x;
  const int mt = (bid & 7) * 8 + ((bid >> 3) & 7), nt = bid >> 6;
  const int m0 = mt * 256, n0 = nt * 256;
  char* ws = p.ws;
  f32x4 acc[4][8];
  zero_acc<4>(acc);
  {
    Stg st;
    const TileSrc src = srcP(A, lda, Bt, ldb, mt * 4 + nt);
    gemm512<4, 4>(acc, src, K, smem, st, false, src, false);
  }
  float* xch = (float*)(ws + OFF_NG);
  unsigned* cnt = (unsigned*)(ws + OFF_SM + SM_BAR) + 16 + use * 128;
  float* rsv = (float*)(smem + 4096);
  const int tid = otid(), lane = tid & 63, wid = tid >> 6, wm = wid >> 2, wn = wid & 3, r16 = lane & 15, q = lane >> 4;
  rowsq_exchange(acc, xch, cnt, mt, nt, smem, rsv);
#pragma unroll
  for (int mf = 0; mf < 8; ++mf) {
    const int ml = wm * 128 + mf * 16 + r16;
    const float rs = rsv[ml];
#pragma unroll
    for (int nf = 0; nf < 4; ++nf) {
      const int n = n0 + wn * 64 + nf * 16 + q * 4;
      const float4 xv = *(const float4*)(res_in + (long)(m0 + ml) * 1024 + n);
      const float4 gv = *(const float4*)(g_post + n);
      acc[nf][mf][0] = xv.x + acc[nf][mf][0] * rs * gv.x; acc[nf][mf][1] = xv.y + acc[nf][mf][1] * rs * gv.y;
      acc[nf][mf][2] = xv.z + acc[nf][mf][2] * rs * gv.z; acc[nf][mf][3] = xv.w + acc[nf][mf][3] * rs * gv.w;
      float4 o; o.x = acc[nf][mf][0]; o.y = acc[nf][mf][1]; o.z = acc[nf][mf][2]; o.w = acc[nf][mf][3];
      *(float4*)(res_out + (long)(m0 + ml) * 1024 + n) = o;
    }
    __builtin_amdgcn_sched_barrier(0);
  }
  if (hnext) {
    __syncthreads();
    rowsq_exchange(acc, xch + 65536, cnt + 64, mt, nt, smem, rsv);
#pragma unroll
    for (int mf = 0; mf < 8; ++mf) {
      const int ml = wm * 128 + mf * 16 + r16;
      const float rs = rsv[ml];
#pragma unroll
      for (int pp = 0; pp < 2; ++pp) {
        const int na = n0 + wn * 64 + 2 * pp * 16 + q * 4;
        const float4 ga = *(const float4*)(g_next + na), gb = *(const float4*)(g_next + na + 16);
        auto rx = __builtin_amdgcn_permlane16_swap(pack2(acc[2 * pp][mf][0] * rs * ga.x, acc[2 * pp][mf][1] * rs * ga.y),
                                                   pack2(acc[2 * pp + 1][mf][0] * rs * gb.x, acc[2 * pp + 1][mf][1] * rs * gb.y), false, false);
        auto ry = __builtin_amdgcn_permlane16_swap(pack2(acc[2 * pp][mf][2] * rs * ga.z, acc[2 * pp][mf][3] * rs * ga.w),
                                                   pack2(acc[2 * pp + 1][mf][2] * rs * gb.z, acc[2 * pp + 1][mf][3] * rs * gb.w), false, false);
        const int n = n0 + wn * 64 + (2 * pp + (q & 1)) * 16 + (q >> 1) * 8;
        uint4 o; o.x = rx[0]; o.y = ry[0]; o.z = rx[1]; o.w = ry[1];
        *(uint4*)(hnext + (long)(m0 + ml) * 1024 + n) = o;
      }
      __builtin_amdgcn_sched_barrier(0);
    }
  }
  if (zero_stats && nt == 0 && tid < 256) {
    unsigned long long* stz = (unsigned long long*)(ws + OFF_SM + SM_STATS) + (long)(m0 + tid) * 2;
    unsigned long long zz = 0ull; asm volatile("" : "+v"(zz));
    stz[0] = zz; stz[1] = zz;
  }
  __syncthreads();
}

#ifndef PHMASK
#define PHMASK 0x3ff
#endif
#define PH_ON(i) ((PHMASK >> (i)) & 1)
DI void run_phase(const Params& p, int ph, char* smem, int csub = 7) {
  const int G = gridDim.x, bid = blockIdx.x;
  char* ws = p.ws;
  int half = ((int)__builtin_amdgcn_workitem_id_x()) >> 8;
  asm volatile("" : "+v"(half));
  half = __builtin_amdgcn_readfirstlane(half);
  char* hsm = smem + half * 65536;
  if (ph == 0) {
    if (!PH_ON(9)) return;
    const int n = 2048 + CONV1_ITEMS / 2;
    for (int it = bid; it < n; it += G) {
      if (it < 2048) row_item(it, p.in[0], nullptr, nullptr, nullptr, p.in[1], (u16*)(ws + OFF_HB), (unsigned long long*)(ws + OFF_SM + SM_STATS));
      else conv1_item(p, 0, (it - 2048) * 2 + half, hsm);
    }
    return;
  }
  const int l = (ph - 1) / 9, sp = (ph - 1) % 9;
  switch (sp) {
    case 0: if (!PH_ON(0)) break; {
      Stg st; bool pre = false;
      if (G == 256) {
        int mt, nt, mt2, nt2;
        xcd_tile(0, 27, mt, nt);
        for (int r = 0; r < 6; ++r) { const bool hn = (r < 5); xcd_tile(r + 1, 27, mt2, nt2); phaseB_tile(p, mt * 27 + nt, smem, st, pre, mt2 * 27 + nt2, hn); pre = hn; mt = mt2; nt = nt2; }
        {
          const int x = bid & 7, lb = bid >> 3, tix = lb >> 1;
          phaseB_half_tile(p, x * 8 + (tix & 7), (24 + (tix >> 3)) * 256 + (lb & 1) * 128, smem);
        }
      } else
      for (int it = bid; it < 64 * 27; it += G) { const bool hn = (it + G < 64 * 27); phaseB_tile(p, it, smem, st, pre, it + G, hn); pre = hn; }
      break;
    }
    case 1: if (!PH_ON(1)) break;
      if (G >= 192) {
        if (bid < 128) { if (csub & 1) rglru_item(p, l, bid * 2 + half, hsm); }
        else if (bid < 160) { if (csub & 2) compress_item(p, bid - 128, smem); }
        else {
          for (int e = bid - 160; e < 64 + 256; e += G - 160) {
            if (e < 64) { if (csub & 4) nsa_item(p, e, smem); }
            else { if (csub & 4) gmlp_item(p, l, (e - 64) * 2 + half, hsm); }
          }
        }
#ifndef NO_CD_MERGE
        if (G == 256) {
          unsigned* cq = (unsigned*)(ws + OFF_SM + SM_BAR) + 600 + l * 2;
          const int tidr = (int)__builtin_amdgcn_workitem_id_x();
          if (bid >= 128) {
            asm volatile("s_waitcnt vmcnt(0)" ::: "memory");
            __syncthreads();
            if (tidr == 0) {
              __builtin_amdgcn_fence(__ATOMIC_RELEASE, "agent");
              const unsigned mine = (bid < 160) ? 1u : (unsigned)(((63 - (bid - 160)) / 96) + 1);
              __hip_atomic_fetch_add(cq + 1, (bid < 160 || bid - 160 < 64) ? mine : 0u, __ATOMIC_RELAXED, __HIP_MEMORY_SCOPE_AGENT);
            }
          }
          unsigned* qslot = (unsigned*)(smem + 114688);
          if (tidr == 0) {
            while (__hip_atomic_load(cq + 1, __ATOMIC_RELAXED, __HIP_MEMORY_SCOPE_AGENT) < 96u) __builtin_amdgcn_s_sleep(2);
            __builtin_amdgcn_fence(__ATOMIC_ACQUIRE, "agent");
          }
          for (;;) {
            __syncthreads();
            if (tidr == 0) *qslot = __hip_atomic_fetch_add(cq, 1u, __ATOMIC_RELAXED, __HIP_MEMORY_SCOPE_AGENT);
            __syncthreads();
            const unsigned idx = *qslot;
            if (idx >= 1024u) break;
            attn_item(p, (int)idx | 0x10000, smem);
          }
        }
#endif
      } else {
        for (int e = bid; e < 128 + 32 + 256; e += G) {
          if (e < 128) { if (csub & 1) rglru_item(p, l, e * 2 + half, hsm); }
          else if (e < 160) { if (csub & 2) compress_item(p, e - 128, smem); }
          else { if (csub & 4) gmlp_item(p, l, (e - 160) * 2 + half, hsm); }
        }
      }
      break;
    case 2: if (!PH_ON(2)) break;
#ifndef NO_CD_MERGE
      if (G == 256) break;
#endif
      for (int it = bid; it < 1024; it += G) attn_item(p, it, smem); break;
    case 3: if (!PH_ON(3)) break;
      {
        Stg st; bool pre = false;
        for (int it = bid; it < 512 + CONV2_TILES / 2; it += G) {
          if (it < 512) {
            const bool hn = (it + G < 512);
            int e0 = it, e1 = it + G;
            if (G == 256) { const int x = bid & 7, lb = bid >> 3; const int t0_ = (it >> 8) * 32 + lb, t1_ = t0_ + 32; e0 = (x * 8 + (t0_ & 7)) * 8 + (t0_ >> 3); e1 = (x * 8 + (t1_ & 7)) * 8 + (t1_ >> 3); }
            phaseE_tile(p, e0, smem, st, pre, e1, hn); pre = hn;
          }
          else conv2_item(p, l, (it - 512) * 2 + half, hsm);
        }
      }
      break;
    case 4: if (!PH_ON(4)) break;
      if (G == 256) {
        fused_norm_tile(p, (const u16*)(ws + OFF_MERGED), 1024, (const u16*)(ws + OFF_W2 + W2_WO), 1024, 1024, l * 2 + 0,
                        (l == 0) ? p.in[0] : p.out, p.out, p.in[2] + l * 1024, p.in[3] + l * 1024, (u16*)(ws + OFF_HB), false, smem);
      } else
      {
        Stg st; bool pre = false;
        for (int it = bid; it < 256; it += G) { const bool hn = (it + G < 256);
          const int e0 = (G == 256) ? (((bid & 7) * 8 + ((bid >> 3) & 7)) * 4 + (bid >> 6)) : it;
          gemm_f32out_tile((const u16*)(ws + OFF_MERGED), 1024, (const u16*)(ws + OFF_W2 + W2_WO), 1024, 1024, (u16*)(ws + OFF_TBUF), e0, smem, st, pre, it + G, hn); pre = hn; }
      }
      break;
    case 5: if (!PH_ON(5)) break;
      for (int it = bid; it < 2048; it += G)
        row_item(it, (l == 0) ? p.in[0] : p.out, (const u16*)(ws + OFF_TBUF), p.in[2] + l * 1024, p.out, p.in[3] + l * 1024, (u16*)(ws + OFF_HB), nullptr);
      break;
    case 6: if (!PH_ON(6)) break; {
      Stg st; bool pre = false;
      if (G == 256) {
        int mt, nt, mt2, nt2;
        xcd_tile(0, 22, mt, nt);
        for (int r = 0; r < 5; ++r) { const bool hn = (r < 4); xcd_tile(r + 1, 22, mt2, nt2); phaseH_tile(p, mt * 22 + nt, smem, st, pre, mt2 * 22 + nt2, hn); pre = hn; mt = mt2; nt = nt2; }
        {
          const int x = bid & 7, lb = bid >> 3, tix = lb >> 1;
          phaseH_half_tile(p, x * 8 + (tix & 7), (20 + (tix >> 3)) * 256 + (lb & 1) * 128, smem);
        }
      } else
      for (int it = bid; it < 64 * 22; it += G) { const bool hn = (it + G < 64 * 22); phaseH_tile(p, it, smem, st, pre, it + G, hn); pre = hn; }
      break;
    }
    case 7: if (!PH_ON(7)) break;
      if (G == 256) {
        const bool nxt = (l + 1 < 2);
        fused_norm_tile(p, (const u16*)(ws + OFF_ACT), 2816, (const u16*)(ws + OFF_W2 + W2_WFO), 2816, 2816, l * 2 + 1,
                        p.out, p.out, p.in[4] + l * 1024, nxt ? (p.in[1] + (l + 1) * 1024) : nullptr, nxt ? (u16*)(ws + OFF_HB) : nullptr, nxt, smem);
        if (nxt) for (int it = bid; it < CONV1_ITEMS / 2; it += G) conv1_item(p, l + 1, it * 2 + half, hsm);
      } else
      {
        Stg st; bool pre = false;
        for (int it = bid; it < 256; it += G) { const bool hn = (it + G < 256);
          const int e0 = (G == 256) ? (((bid & 7) * 8 + ((bid >> 3) & 7)) * 4 + (bid >> 6)) : it;
          gemm_f32out_tile((const u16*)(ws + OFF_ACT), 2816, (const u16*)(ws + OFF_W2 + W2_WFO), 2816, 2816, (u16*)(ws + OFF_TBUF), e0, smem, st, pre, it + G, hn); pre = hn; }
      }
      break;
    case 8: if (!PH_ON(8)) break; {
      const bool nxt = (l + 1 < 2);
      const int n = 2048 + (nxt ? CONV1_ITEMS / 2 : 0);
      for (int it = bid; it < n; it += G) {
        if (it < 2048) row_item(it, p.out, (const u16*)(ws + OFF_TBUF), p.in[4] + l * 1024, p.out, nxt ? (p.in[1] + (l + 1) * 1024) : nullptr, nxt ? (u16*)(ws + OFF_HB) : nullptr, (unsigned long long*)(ws + OFF_SM + SM_STATS));
        else conv1_item(p, l + 1, (it - 2048) * 2 + half, hsm);
      }
      break;
    }
  }
}

constexpr int N_PHASES = 19;

__global__ void __launch_bounds__(NTHR, 2) mega_kernel(Params p, int ph0, int ph1) {
  extern __shared__ __attribute__((aligned(16))) char smem[];
  cg::grid_group grid = cg::this_grid();
#ifdef TIMER_MASK
  unsigned long long tacc = 0, tprev = wall_clock64();
#endif
  unsigned* gbar = (unsigned*)(p.ws + OFF_SM + SM_BAR);
  if (blockIdx.x == 0) { __hip_atomic_store(gbar + threadIdx.x, 0u, __ATOMIC_RELAXED, __HIP_MEMORY_SCOPE_AGENT); __hip_atomic_store(gbar + 512 + threadIdx.x, 0u, __ATOMIC_RELAXED, __HIP_MEMORY_SCOPE_AGENT); }
  const bool fused_rows = (gridDim.x == 256);
  unsigned nbar = 0;
  for (int ph = ph0; ph < ph1; ++ph) {
    if (fused_rows && ph >= 1) { const int kd = (ph - 1) % 9; if (kd == 5 || kd == 8) continue;
#ifndef NO_CD_MERGE
      if (kd == 2) continue;
#endif
    }
#ifdef CSUB
    if (ph >= 1 && ((ph - 1) % 9) == 1) {
      for (int c = 1; c <= 4; c <<= 1) {
        run_phase(p, ph, smem, c);
        grid.sync();
        const unsigned long long tn = wall_clock64(); if (c == CSUB) tacc += tn - tprev; tprev = tn;
      }
      continue;
    }
#endif
    run_phase(p, ph, smem);
#ifdef TIMER_MASK
    grid.sync();
    { const unsigned long long tn = wall_clock64(); const int kind = (ph == 0) ? 9 : ((ph - 1) % 9); if ((TIMER_MASK >> kind) & 1) tacc += tn - tprev; tprev = tn; }
#else
    if (ph + 1 < ph1) {
      if (ph == ph0) grid.sync();
      else {
        asm volatile("s_waitcnt vmcnt(0)" ::: "memory");
        __syncthreads();
        ++nbar;
        if (threadIdx.x == 0) {
          __builtin_amdgcn_fence(__ATOMIC_RELEASE, "agent");
          __hip_atomic_fetch_add(gbar, 1u, __ATOMIC_RELAXED, __HIP_MEMORY_SCOPE_AGENT);
          const unsigned target = nbar * gridDim.x;
          while (__hip_atomic_load(gbar, __ATOMIC_RELAXED, __HIP_MEMORY_SCOPE_AGENT) < target) __builtin_amdgcn_s_sleep(2);
          __builtin_amdgcn_fence(__ATOMIC_ACQUIRE, "agent");
        }
        __syncthreads();
      }
    }
#endif
  }
#ifdef TIMER_MASK
  if (blockIdx.x == 0 && threadIdx.x == 0) p.out[0] += (float)tacc * 0.001f;
#endif
}

extern "C" void kernel_launch(void* const* d_in, const int* in_sizes, int n_in, void* d_out, int out_size, void* d_ws, size_t ws_size,
                              hipStream_t stream) {
  static int grid_blocks = 0;
  if (!grid_blocks) {
    int dev = 0, cus = 0, per_cu = 0;
    (void)hipGetDevice(&dev);
    (void)hipDeviceGetAttribute(&cus, hipDeviceAttributeMultiprocessorCount, dev);
    (void)hipFuncSetAttribute((const void*)mega_kernel, hipFuncAttributeMaxDynamicSharedMemorySize, LDS_BYTES);
    (void)hipOccupancyMaxActiveBlocksPerMultiprocessor(&per_cu, mega_kernel, NTHR, LDS_BYTES);
    if (per_cu < 1) per_cu = 1;
    if (per_cu > 1) per_cu = 1;
    grid_blocks = cus * per_cu;
    if (ws_size < WS_NEED) fprintf(stderr, "kernel_launch: workspace too small: %zu < %zu\n", ws_size, (size_t)WS_NEED);
  }
  Params p{};
  for (int i = 0; i < 29; ++i) p.in[i] = (const float*)d_in[i];
  p.out = (float*)d_out;
  p.ws = (char*)d_ws;
#if MK_MULTI
  for (int ph = 0; ph < N_PHASES; ++ph) {
    hipLaunchKernelGGL(mega_kernel, dim3(grid_blocks), dim3(NTHR), LDS_BYTES, stream, p, ph, ph + 1);
  }
#else
  int ph0 = 0, ph1 = N_PHASES;
  void* args[] = {&p, &ph0, &ph1};
  hipError_t e = hipLaunchCooperativeKernel((void*)mega_kernel, dim3(grid_blocks), dim3(NTHR), args, LDS_BYTES, stream);
  if (e != hipSuccess) fprintf(stderr, "cooperative launch failed: %s (grid %d)\n", hipGetErrorString(e), grid_blocks);
#endif
}
```

```cpp
#include <hip/hip_runtime.h>
#include <hip/hip_cooperative_groups.h>
#include <cstdio>
namespace cg = cooperative_groups;

#ifndef MK_MULTI
#define MK_MULTI 0
#endif

typedef unsigned short u16;
using bf16x8 = __attribute__((ext_vector_type(8))) short;
using f32x16 = __attribute__((ext_vector_type(16))) float;
using u32x4 = __attribute__((ext_vector_type(4))) unsigned;
using f32x4 = __attribute__((ext_vector_type(4))) float;
#define MFMA16(a, b, c) __builtin_amdgcn_mfma_f32_16x16x32_bf16((a), (b), (c), 0, 0, 0)
#define DI __device__ __forceinline__
#define MFMA32(a, b, c) __builtin_amdgcn_mfma_f32_32x32x16_bf16((a), (b), (c), 0, 0, 0)

constexpr int T_ = 16384;
constexpr int NTHR = 512;
constexpr int LDS_BYTES = 131072;

constexpr size_t SZ32 = 33554432;
constexpr size_t OFF_HB = 0;
constexpr size_t OFF_U = 1 * SZ32;
constexpr size_t OFF_GV = 2 * SZ32;
constexpr size_t OFF_Q = 3 * SZ32;
constexpr size_t OFF_XR = 4 * SZ32;
constexpr size_t OFF_RG = 5 * SZ32;
constexpr size_t OFF_KV = 6 * SZ32;
constexpr size_t KV_ELEMS = 4194304;
constexpr size_t OFF_NG = OFF_KV + 50331648;
constexpr size_t OFF_SM = OFF_NG + 3145728;
constexpr size_t SM_KC = 0, SM_VCT = 524288, SM_CKV = 1048576, SM_WSB = 1050624, SM_HID = 1310720, SM_STATS = 5505024, SM_BAR = 5767168;
constexpr size_t OFF_W1 = OFF_SM + 6291456;
constexpr size_t W1_WIN = 0, W1_WMG = 14155776, W1_WBR = W1_WMG + 6291456, W1_WK1 = W1_WBR + 6291456, W1_WV1 = W1_WK1 + 1048576, W1_WK2 = W1_WV1 + 1048576, W1_WV2 = W1_WK2 + 32768, W1_WNS = W1_WV2 + 32768;
constexpr size_t WS_NEED = OFF_W1 + W1_WNS + 131072;
constexpr size_t OFF_TBUF = OFF_XR;
constexpr size_t OFF_W2 = OFF_KV;
constexpr size_t W2_WO = 0, W2_WFI = 2097152, W2_WFO = 13631488;
constexpr size_t OFF_ACT = OFF_U;
constexpr size_t OFF_MERGED = OFF_GV;

struct Params { const float* in[29]; float* out; char* ws; };

DI int otid() { int t = (int)__builtin_amdgcn_workitem_id_x(); asm volatile("" : "+v"(t)); return t; }
DI int htid() { int t = (int)__builtin_amdgcn_workitem_id_x() & 255; asm volatile("" : "+v"(t)); return t; }
DI u16 f2bf(float x) { unsigned u = __float_as_uint(x); u += 0x7fffu + ((u >> 16) & 1u); return (u16)(u >> 16); }
DI float bf2f(u16 b) { return __uint_as_float(((unsigned)b) << 16); }
typedef __bf16 bf2_t __attribute__((ext_vector_type(2)));
typedef float f2_t __attribute__((ext_vector_type(2)));
DI unsigned pack2(float a, float b) { f2_t v; v.x = a; v.y = b; return __builtin_bit_cast(unsigned, __builtin_convertvector(v, bf2_t)); }
DI float bflo(unsigned w) { return __uint_as_float(w << 16); }
DI float bfhi(unsigned w) { return __uint_as_float(w & 0xffff0000u); }
DI float rcpf(float x) { return __builtin_amdgcn_rcpf(x); }
DI float sigmoidf_(float x) { return rcpf(1.f + __expf(-x)); }
DI float geluf_(float x) { float y = 1.5957691216f * (x + 0.044715f * x * x * x); return x * rcpf(1.f + __expf(-y)); }
DI float wave_sum(float v) {
#pragma unroll
  for (int o = 32; o >= 1; o >>= 1) v += __shfl_xor(v, o);
  return v;
}
DI float lane_swap1(float v) { const int u = (int)__float_as_uint(v); return __uint_as_float((unsigned)__builtin_amdgcn_update_dpp(u, u, 0xB1, 0xF, 0xF, false)); }
DI f32x16 zero16() { f32x16 v;
#pragma unroll
  for (int i = 0; i < 16; ++i) v[i] = 0.f;
  return v; }
DI void store4bf(u16* p, float a, float b, float c, float d) { uint2 v; v.x = pack2(a, b); v.y = pack2(c, d); *(uint2*)p = v; }

struct TileSrc { const u16* A; long lda; const u16* Bt; long ldb; };
struct Stg { u32x4 a0, a1, a2, a3, b0, b1, b2, b3; };
template <int MI, int WN> DI void gemm512(f32x4 (&acc)[4][2 * MI], const TileSrc cur, int K, char* smem, Stg& st, bool pre, const TileSrc nxt, bool hasnxt) {
  const int tid = otid(), lane = tid & 63, wid = tid >> 6;
  const int wm = wid / WN, wn = wid % WN;
  const int r16 = lane & 15, q = lane >> 4;
  const int lr = tid >> 3, lc = tid & 7;
  const int soff = lr * 128 + ((lc ^ ((lr >> 1) & 7)) << 4);
  const u16* ga = cur.A + (long)lr * cur.lda + lc * 8;
  const u16* gb = cur.Bt + (long)lr * cur.ldb + lc * 8;
  long a64 = 64 * cur.lda, b64 = 64 * cur.ldb;
  const int nk = K >> 6;
#define G512_LOAD() do { st.a0 = *(const u32x4*)(ga); st.a1 = *(const u32x4*)(ga + a64); st.a2 = *(const u32x4*)(ga + 2 * a64); st.a3 = *(const u32x4*)(ga + 3 * a64); \
    st.b0 = *(const u32x4*)(gb); if (WN > 1) st.b1 = *(const u32x4*)(gb + b64); if (WN > 2) { st.b2 = *(const u32x4*)(gb + 2 * b64); st.b3 = *(const u32x4*)(gb + 3 * b64); } } while (0)
#define G512_STORE(d) do { *(u32x4*)((d) + soff) = st.a0; *(u32x4*)((d) + soff + 8192) = st.a1; *(u32x4*)((d) + soff + 16384) = st.a2; *(u32x4*)((d) + soff + 24576) = st.a3; \
    *(u32x4*)((d) + 32768 + soff) = st.b0; if (WN > 1) *(u32x4*)((d) + 32768 + soff + 8192) = st.b1; if (WN > 2) { *(u32x4*)((d) + 32768 + soff + 16384) = st.b2; *(u32x4*)((d) + 32768 + soff + 24576) = st.b3; } } while (0)
  if (!pre) G512_LOAD();
  G512_STORE(smem);
  ga += 64; gb += 64;
  G512_LOAD();
  const int sw = r16 >> 1;
  for (int kt = 0; kt < nk; ++kt) {
    __syncthreads();
    if (kt + 1 < nk) {
      char* d = smem + ((kt + 1) & 1) * 65536;
      G512_STORE(d);
      if (kt + 2 < nk) { ga += 64; gb += 64; G512_LOAD(); }
      else if (hasnxt) {
        ga = nxt.A + (long)lr * nxt.lda + lc * 8; gb = nxt.Bt + (long)lr * nxt.ldb + lc * 8; a64 = 64 * nxt.lda; b64 = 64 * nxt.ldb;
        G512_LOAD();
      }
    }
    const char* sa = smem + (kt & 1) * 65536;
    const char* sb = sa + 32768;
#pragma unroll
    for (int ks = 0; ks < 2; ++ks) {
      bf16x8 fa[4];
      const int coff = ((ks * 4 + q) ^ sw) << 4;
#pragma unroll
      for (int nf = 0; nf < 4; ++nf) fa[nf] = *(const bf16x8*)(sb + (wn * 64 + nf * 16 + r16) * 128 + coff);
      constexpr int MG = (MI >= 2) ? 4 : 2;
      for (int mh = 0; mh < (2 * MI) / MG; ++mh) {
        bf16x8 fb[MG];
#pragma unroll
        for (int mf = 0; mf < MG; ++mf) fb[mf] = *(const bf16x8*)(sa + (wm * (MI * 32) + (mh * MG + mf) * 16 + r16) * 128 + coff);
#pragma unroll
        for (int nf = 0; nf < 4; ++nf)
#pragma unroll
          for (int mf = 0; mf < MG; ++mf) acc[nf][mh * MG + mf] = MFMA16(fa[nf], fb[mf], acc[nf][mh * MG + mf]);
      }
    }
  }
  if (nk & 1) __syncthreads();
#undef G512_LOAD
#undef G512_STORE
}
template <int MI, int WN, class F> DI void epi512(const f32x4 (&acc)[4][2 * MI], int m0, int n0, F f) {
  const int tid = otid(), lane = tid & 63, wid = tid >> 6, wm = wid / WN, wn = wid % WN, r16 = lane & 15, q = lane >> 4;
#pragma unroll
  for (int nf = 0; nf < 4; ++nf) {
#pragma unroll
    for (int mf = 0; mf < 2 * MI; ++mf) {
      const int m = m0 + wm * (MI * 32) + mf * 16 + r16;
      const int n = n0 + wn * 64 + nf * 16 + q * 4;
      f(m, n, acc[nf][mf][0], acc[nf][mf][1], acc[nf][mf][2], acc[nf][mf][3]);
      __builtin_amdgcn_sched_barrier(0);
    }
  }
}
template <int MI, int WN, class TF> DI void epi512_rows16(const f32x4 (&acc)[4][2 * MI], int m0, int n0, u16* dst, long ld, int coladj, TF tf) {
  const int tid = otid(), lane = tid & 63, wid = tid >> 6, wm = wid / WN, wn = wid % WN, r16 = lane & 15, q = lane >> 4;
#pragma unroll
  for (int mf = 0; mf < 2 * MI; ++mf) {
    const int m = m0 + wm * (MI * 32) + mf * 16 + r16;
#pragma unroll
    for (int pp = 0; pp < 2; ++pp) {
      const unsigned ax = pack2(tf(acc[2 * pp][mf][0]), tf(acc[2 * pp][mf][1])), ay = pack2(tf(acc[2 * pp][mf][2]), tf(acc[2 * pp][mf][3]));
      const unsigned bx = pack2(tf(acc[2 * pp + 1][mf][0]), tf(acc[2 * pp + 1][mf][1])), by = pack2(tf(acc[2 * pp + 1][mf][2]), tf(acc[2 * pp + 1][mf][3]));
      auto rx = __builtin_amdgcn_permlane16_swap(ax, bx, false, false);
      auto ry = __builtin_amdgcn_permlane16_swap(ay, by, false, false);
      const int n = n0 + wn * 64 + (2 * pp + (q & 1)) * 16 + (q >> 1) * 8;
      uint4 o; o.x = rx[0]; o.y = ry[0]; o.z = rx[1]; o.w = ry[1];
      *(uint4*)(dst + (long)m * ld + n + coladj) = o;
    }
    __builtin_amdgcn_sched_barrier(0);
  }
}
template <int MI, int WN, class AF> DI void epi512_rows16_at(const f32x4 (&acc)[4][2 * MI], int m0, int n0, AF af) {
  const int tid = otid(), lane = tid & 63, wid = tid >> 6, wm = wid / WN, wn = wid % WN, r16 = lane & 15, q = lane >> 4;
#pragma unroll
  for (int mf = 0; mf < 2 * MI; ++mf) {
    const int m = m0 + wm * (MI * 32) + mf * 16 + r16;
#pragma unroll
    for (int pp = 0; pp < 2; ++pp) {
      auto rx = __builtin_amdgcn_permlane16_swap(pack2(acc[2 * pp][mf][0], acc[2 * pp][mf][1]), pack2(acc[2 * pp + 1][mf][0], acc[2 * pp + 1][mf][1]), false, false);
      auto ry = __builtin_amdgcn_permlane16_swap(pack2(acc[2 * pp][mf][2], acc[2 * pp][mf][3]), pack2(acc[2 * pp + 1][mf][2], acc[2 * pp + 1][mf][3]), false, false);
      const int n = n0 + wn * 64 + (2 * pp + (q & 1)) * 16 + (q >> 1) * 8;
      uint4 o; o.x = rx[0]; o.y = ry[0]; o.z = rx[1]; o.w = ry[1];
      *(uint4*)af(m, n) = o;
    }
    __builtin_amdgcn_sched_barrier(0);
  }
}
template <int MI> DI void zero_acc(f32x4 (&acc)[4][2 * MI]) {
#pragma unroll
  for (int a = 0; a < 4; ++a)
#pragma unroll
    for (int b = 0; b < 2 * MI; ++b) { acc[a][b][0] = 0.f; acc[a][b][1] = 0.f; acc[a][b][2] = 0.f; acc[a][b][3] = 0.f; }
}

template <int NI> DI void gemm_h(f32x16 (&acc)[NI][2], const u16* __restrict__ A, long lda, const u16* __restrict__ Bt, long ldb, int K, char* smem) {
  const int tid = htid(), lane = tid & 63, wid = tid >> 6;
  const int wm = wid >> 1, wn = wid & 1;
  const int r32 = lane & 31, h = lane >> 5;
  const int lr = tid >> 3, lc = tid & 7;
  const u16* ga = A + (long)lr * lda + lc * 8;
  const u16* gb = Bt + (long)lr * ldb + lc * 8;
  const int soff = lr * 128 + ((lc ^ ((lr & 7) ^ ((lr >> 3) & 1))) << 4);
  uint4 ra[4], rb[2 * NI];
  const int nk = K >> 6;
#pragma unroll
  for (int i = 0; i < 4; ++i) ra[i] = *(const uint4*)(ga + (long)(32 * i) * lda);
#pragma unroll
  for (int i = 0; i < 2 * NI; ++i) rb[i] = *(const uint4*)(gb + (long)(32 * i) * ldb);
#pragma unroll
  for (int i = 0; i < 4; ++i) *(uint4*)(smem + soff + i * 4096) = ra[i];
#pragma unroll
  for (int i = 0; i < 2 * NI; ++i) *(uint4*)(smem + 16384 + soff + i * 4096) = rb[i];
  __syncthreads();
  const int sw = (r32 & 7) ^ ((r32 >> 3) & 1);
  for (int kt = 0; kt < nk; ++kt) {
    const bool more = (kt + 1 < nk);
    if (more) {
      ga += 64; gb += 64;
#pragma unroll
      for (int i = 0; i < 4; ++i) ra[i] = *(const uint4*)(ga + (long)(32 * i) * lda);
#pragma unroll
      for (int i = 0; i < 2 * NI; ++i) rb[i] = *(const uint4*)(gb + (long)(32 * i) * ldb);
    }
    const char* sa = smem + (kt & 1) * 32768;
    const char* sb = sa + 16384;
#pragma unroll
    for (int ks = 0; ks < 4; ++ks) {
      bf16x8 fa[NI], fb[2];
      const int coff = ((ks * 2 + h) ^ sw) << 4;
#pragma unroll
      for (int ni = 0; ni < NI; ++ni) fa[ni] = *(const bf16x8*)(sb + (wn * (32 * NI) + ni * 32 + r32) * 128 + coff);
#pragma unroll
      for (int mi = 0; mi < 2; ++mi) fb[mi] = *(const bf16x8*)(sa + (wm * 64 + mi * 32 + r32) * 128 + coff);
#pragma unroll
      for (int ni = 0; ni < NI; ++ni)
#pragma unroll
        for (int mi = 0; mi < 2; ++mi) acc[ni][mi] = MFMA32(fa[ni], fb[mi], acc[ni][mi]);
    }
    if (more) {
      char* d = smem + ((kt + 1) & 1) * 32768;
#pragma unroll
      for (int i = 0; i < 4; ++i) *(uint4*)(d + soff + i * 4096) = ra[i];
#pragma unroll
      for (int i = 0; i < 2 * NI; ++i) *(uint4*)(d + 16384 + soff + i * 4096) = rb[i];
    }
    __syncthreads();
  }
}

template <int NI, class F> DI void epi_h(const f32x16 (&acc)[NI][2], int m0, int n0, F f) {
  const int lane = htid() & 63, wid = htid() >> 6, wm = wid >> 1, wn = wid & 1, r32 = lane & 31, h = lane >> 5;
#pragma unroll
  for (int ni = 0; ni < NI; ++ni)
#pragma unroll
    for (int mi = 0; mi < 2; ++mi) {
      const int m = m0 + wm * 64 + mi * 32 + r32;
#pragma unroll
      for (int g4 = 0; g4 < 4; ++g4) {
        const int n = n0 + wn * (32 * NI) + ni * 32 + 8 * g4 + 4 * h;
        f(m, n, acc[ni][mi][4 * g4 + 0], acc[ni][mi][4 * g4 + 1], acc[ni][mi][4 * g4 + 2], acc[ni][mi][4 * g4 + 3]);
      }
    }
}

DI int srccol(int mode, int param, int n) {
  if (mode == 0) return n + param;
  if (mode == 1) { if (n < 4608) return n; if (n < 6656) return n + 48; if (n < 6704) return n - 2048; return -1; }
  if (mode == 3) return (n < 48) ? (4608 + n) : -1;
  const int blk = n >> 6, w = n & 63;
  return (w < 32) ? (blk * 32 + w) : (2816 + blk * 32 + (w - 32));
}
DI void conv_tile(const float* __restrict__ src, int lds_, u16* __restrict__ dst, int K, int mode, int param, int tile, char* smem) {
  const int tid = htid();
  const int ntk = K >> 6;
  const int k0 = (tile % ntk) * 64, n0 = (tile / ntk) * 64;
  float* tl = (float*)smem;
  {
    const int c = tid & 63, i0 = tid >> 6;
    const int sc = srccol(mode, param, n0 + c);
#pragma unroll
    for (int j = 0; j < 16; ++j) { const int k = i0 + 4 * j; tl[k * 65 + c] = (sc >= 0) ? src[(long)(k0 + k) * lds_ + sc] : 0.f; }
  }
  __syncthreads();
#pragma unroll
  for (int jj = 0; jj < 2; ++jj) {
    const int nl = (tid >> 3) + 32 * jj, kc = tid & 7;
    float v[8];
#pragma unroll
    for (int e = 0; e < 8; ++e) v[e] = tl[(kc * 8 + e) * 65 + nl];
    uint4 o; o.x = pack2(v[0], v[1]); o.y = pack2(v[2], v[3]); o.z = pack2(v[4], v[5]); o.w = pack2(v[6], v[7]);
    *(uint4*)(dst + (long)(n0 + nl) * K + k0 + kc * 8) = o;
  }
  __syncthreads();
}

constexpr int CONV1_TILES = 1728 + 768 + 768 + 256 + 8 + 16;
constexpr int CONV1_ITEMS = CONV1_TILES + 8 + 32;
DI void conv1_item(const Params& p, int l, int t, char* smem) {
  char* w1 = p.ws + OFF_W1;
  const int tid = htid();
  if (t < CONV1_TILES) {
    const float* win = p.in[5] + (long)l * 1024 * 9776;
    if (t < 1728) { conv_tile(win, 9776, (u16*)(w1 + W1_WIN), 1024, 1, 0, t, smem); return; }
    t -= 1728;
    if (t < 768) { conv_tile(win, 9776, (u16*)(w1 + W1_WMG), 1024, 0, 6704, t, smem); return; }
    t -= 768;
    if (t < 768) { const int k = t >> 8; conv_tile(p.in[23 + k] + (long)l * 1048576, 1024, (u16*)(w1 + W1_WBR) + (long)k * 1048576, 1024, 0, 0, t & 255, smem); return; }
    t -= 768;
    if (t < 256) { const int kv = t >> 7; conv_tile(p.in[kv ? 14 : 12] + (long)l * 524288, 256, (u16*)(w1 + (kv ? W1_WV1 : W1_WK1)), 2048, 0, 0, t & 127, smem); return; }
    t -= 256;
    if (t < 8) { const int kv = t >> 2; conv_tile(p.in[kv ? 15 : 13] + (long)l * 16384, 64, (u16*)(w1 + (kv ? W1_WV2 : W1_WK2)), 256, 0, 0, t & 3, smem); return; }
    t -= 8;
    { conv_tile(win, 9776, (u16*)(w1 + W1_WNS), 1024, 3, 0, t, smem); return; }
  }
  t -= CONV1_TILES;
  if (t < 8) {
    const int kv = t >> 2, jg = t & 3;
    const float* pe = p.in[10 + kv] + (long)l * 2048;
    const float* w = p.in[kv ? 14 : 12] + (long)l * 524288;
    const int j = jg * 64 + (tid & 63), ksl = tid >> 6;
    float s = 0.f;
    for (int kk = ksl * 512; kk < ksl * 512 + 512; kk += 16) {
      float wv[16];
#pragma unroll
      for (int u = 0; u < 16; ++u) wv[u] = w[(long)(kk + u) * 256 + j];
#pragma unroll
      for (int u = 0; u < 16; ++u) s += pe[kk + u] * wv[u];
    }
    float* red = (float*)smem;
    red[tid] = s;
    __syncthreads();
    if (tid < 64) { float r = red[tid] + red[tid + 64] + red[tid + 128] + red[tid + 192]; ((float*)(p.ws + OFF_SM + SM_CKV))[kv * 256 + jg * 64 + tid] = r; }
    __syncthreads();
    return;
  }
  t -= 8;
  {
    const float* wsrc = p.in[8] + (long)l * 65536;
    u16* dst = (u16*)(p.ws + OFF_SM + SM_WSB);
    const int e0 = t * 2048 + tid * 8;
    const int tt = (e0 >> 7) & 127, s0 = e0 & 127;
    float v[8];
#pragma unroll
    for (int e = 0; e < 8; ++e) v[e] = (s0 + e <= tt) ? wsrc[e0 + e] : 0.f;
    uint4 o; o.x = pack2(v[0], v[1]); o.y = pack2(v[2], v[3]); o.z = pack2(v[4], v[5]); o.w = pack2(v[6], v[7]);
    *(uint4*)(dst + e0) = o;
  }
}
constexpr int CONV2_TILES = 256 + 1408 + 704;
DI void conv2_item(const Params& p, int l, int t, char* smem) {
  char* w2 = p.ws + OFF_W2;
  if (t < 256) { conv_tile(p.in[26] + (long)l * 1048576, 1024, (u16*)(w2 + W2_WO), 1024, 0, 0, t, smem); return; }
  t -= 256;
  if (t < 1408) { conv_tile(p.in[27] + (long)l * 1024 * 5632, 5632, (u16*)(w2 + W2_WFI), 1024, 2, 0, t, smem); return; }
  t -= 1408;
  conv_tile(p.in[28] + (long)l * 2816 * 1024, 1024, (u16*)(w2 + W2_WFO), 2816, 0, 0, t, smem);
}

DI void row_item(int item, const float* __restrict__ res_in, const u16* __restrict__ delta, const float* __restrict__ g_post,
                 float* __restrict__ res_out, const float* __restrict__ g_next, u16* __restrict__ hnext, unsigned long long* __restrict__ stats) {
  const int lane = otid() & 63;
  const long row = (long)item * 8 + (otid() >> 6);
  float x[16];
#pragma unroll
  for (int j = 0; j < 4; ++j) { const float4 v = *(const float4*)(res_in + row * 1024 + j * 256 + lane * 4); x[4 * j] = v.x; x[4 * j + 1] = v.y; x[4 * j + 2] = v.z; x[4 * j + 3] = v.w; }
  if (delta) {
    float d[16]; float ss = 0.f;
#pragma unroll
    for (int j = 0; j < 4; ++j) { const uint2 v = *(const uint2*)(delta + row * 1024 + j * 256 + lane * 4); d[4 * j] = bflo(v.x); d[4 * j + 1] = bfhi(v.x); d[4 * j + 2] = bflo(v.y); d[4 * j + 3] = bfhi(v.y); }
#pragma unroll
    for (int i = 0; i < 16; ++i) ss += d[i] * d[i];
    ss = wave_sum(ss);
    const float rs = rsqrtf(ss * (1.f / 1024.f) + 1e-6f);
#pragma unroll
    for (int j = 0; j < 4; ++j) {
      const float4 g = *(const float4*)(g_post + j * 256 + lane * 4);
      x[4 * j] += d[4 * j] * rs * g.x; x[4 * j + 1] += d[4 * j + 1] * rs * g.y; x[4 * j + 2] += d[4 * j + 2] * rs * g.z; x[4 * j + 3] += d[4 * j + 3] * rs * g.w;
      float4 o; o.x = x[4 * j]; o.y = x[4 * j + 1]; o.z = x[4 * j + 2]; o.w = x[4 * j + 3];
      *(float4*)(res_out + row * 1024 + j * 256 + lane * 4) = o;
    }
  }
  if (hnext) {
    if (stats && lane < 2) { unsigned long long zz = 0ull; asm volatile("" : "+v"(zz)); stats[row * 2 + lane] = zz; }
    float ss = 0.f;
#pragma unroll
    for (int i = 0; i < 16; ++i) ss += x[i] * x[i];
    ss = wave_sum(ss);
    const float rs = rsqrtf(ss * (1.f / 1024.f) + 1e-6f);
#pragma unroll
    for (int j = 0; j < 4; ++j) {
      const float4 g = *(const float4*)(g_next + j * 256 + lane * 4);
      store4bf(hnext + row * 1024 + j * 256 + lane * 4, x[4 * j] * rs * g.x, x[4 * j + 1] * rs * g.y, x[4 * j + 2] * rs * g.z, x[4 * j + 3] * rs * g.w);
    }
  }
}

DI bool xcd_tile(int round, int NT, int& mt, int& nt) {
  const int bid = blockIdx.x, x = bid & 7, lb = bid >> 3;
  const int ti = round * 32 + lb;
  mt = x * 8 + (ti & 7); nt = ti >> 3;
  return nt < NT;
}
DI TileSrc srcB(const Params& p, int item) {
  const int nt = item % 27, mt = item / 27;
  TileSrc t; t.A = (const u16*)(p.ws + OFF_HB) + (long)mt * 256 * 1024; t.lda = 1024; t.Bt = (const u16*)(p.ws + OFF_W1 + W1_WIN) + (long)nt * 256 * 1024; t.ldb = 1024;
  return t;
}
DI void phaseB_tile(const Params& p, int item, char* smem, Stg& st, bool pre, int nitem, bool hasnxt) {
  const int nt = item % 27, mt = item / 27;
  const int m0 = mt * 256, n0 = nt * 256;
  char* ws = p.ws;
  f32x4 acc[4][8];
  zero_acc<4>(acc);
  gemm512<4, 4>(acc, srcB(p, item), 1024, smem, st, pre, srcB(p, nitem), hasnxt);
  if (n0 < 1024) {
    u16* U = (u16*)(ws + OFF_U);
    epi512_rows16<4, 4>(acc, m0, n0, U, 1024, 0, [](float v) { return geluf_(v); });
  } else if (n0 < 2048) {
    u16* G = (u16*)(ws + OFF_GV);
    unsigned long long* stats = (unsigned long long*)(ws + OFF_SM + SM_STATS);
    const int tid = otid(), lane = tid & 63, wid = tid >> 6, wm = wid >> 2, wn = wid & 3, r16 = lane & 15, q = lane >> 4;
#pragma unroll
    for (int mf = 0; mf < 8; ++mf) {
      const int m = m0 + wm * 128 + mf * 16 + r16;
      float s1 = 0.f, s2 = 0.f;
#pragma unroll
      for (int nf = 0; nf < 4; ++nf) {
        const int d = n0 - 1024 + wn * 64 + nf * 16 + q * 4;
        float gg[4];
#pragma unroll
        for (int e = 0; e < 4; ++e) { gg[e] = geluf_(acc[nf][mf][e]); s1 += gg[e]; s2 += gg[e] * gg[e]; }
        const int odd = lane & 1;
        const float r0 = lane_swap1(odd ? gg[0] : gg[1]), r1 = lane_swap1(odd ? gg[2] : gg[3]);
        unsigned* gp = (unsigned*)(G + ((long)(m >> 7) * 1024 + d + odd) * 128 + ((m & 127) - odd));
        gp[0] = odd ? pack2(r0, gg[1]) : pack2(gg[0], r0);
        gp[128] = odd ? pack2(r1, gg[3]) : pack2(gg[2], r1);
      }
      s1 += __shfl_xor(s1, 16); s2 += __shfl_xor(s2, 16);
      s1 += __shfl_xor(s1, 32); s2 += __shfl_xor(s2, 32);
      if (q == 0) {
        atomicAdd(stats + (long)m * 2, (unsigned long long)(long long)__float2ll_rn(s1 * 16777216.f));
        atomicAdd(stats + (long)m * 2 + 1, (unsigned long long)(long long)__float2ll_rn(s2 * 16777216.f));
      }
      __builtin_amdgcn_sched_barrier(0);
    }
  } else if (n0 < 3072) {
    u16* Q = (u16*)(ws + OFF_Q);
    epi512_rows16<4, 4>(acc, m0, n0, Q, 1024, -2048, [](float v) { return v; });
  } else if (n0 < 4608) {
    const int i6 = (n0 - 3072) >> 8;
    u16* base = (u16*)(ws + OFF_KV) + (long)i6 * KV_ELEMS;
    if (i6 == 3 || i6 == 5) {
      epi512<4, 4>(acc, m0, n0, [&](int m, int n, float a, float b, float c, float d) {
        const int cc = n - 3072, g = (cc >> 6) & 3, dd = cc & 63, bb = m >> 11, s = m & 2047;
        const int odd = (int)__builtin_amdgcn_workitem_id_x() & 1;
        const float r0 = lane_swap1(odd ? a : b), r1 = lane_swap1(odd ? c : d);
        unsigned* q = (unsigned*)(base + ((long)(bb * 4 + g) * 64 + dd + odd) * 2048 + (s - odd));
        q[0] = odd ? pack2(r0, b) : pack2(a, r0);
        q[2048] = odd ? pack2(r1, d) : pack2(c, r1);
      });
    } else {
      epi512_rows16_at<4, 4>(acc, m0, n0, [&](int m, int n) {
        const int cc = n - 3072, g = (cc >> 6) & 3, dd = cc & 63, bb = m >> 11, s = m & 2047;
        return base + ((long)(bb * 4 + g) * 2048 + s) * 64 + dd;
      });
    }
  } else if (n0 < 5632) {
    u16* X = (u16*)(ws + OFF_XR);
    epi512_rows16<4, 4>(acc, m0, n0, X, 1024, -4608, [](float v) { return v; });
  } else if (n0 < 6656) {
    u16* R = (u16*)(ws + OFF_RG);
    epi512_rows16<4, 4>(acc, m0, n0, R, 1024, -5632, [](float v) { return geluf_(v); });
  } else {
    float* NG = (float*)(ws + OFF_NG);
    epi512<4, 4>(acc, m0, n0, [&](int m, int n, float a, float b, float c, float d) {
      const int cc = n - 6656;
      if (cc < 48) { float4 o; o.x = sigmoidf_(a); o.y = sigmoidf_(b); o.z = sigmoidf_(c); o.w = sigmoidf_(d); *(float4*)(NG + (long)m * 48 + cc) = o; }
    });
  }
}

DI void nsa_item(const Params& p, int strip, char* smem) {
  char* ws = p.ws;
  f32x4 acc[4][2];
  zero_acc<1>(acc);
  {
    Stg st;
    TileSrc t; t.A = (const u16*)(ws + OFF_HB) + (long)strip * 256 * 1024; t.lda = 1024; t.Bt = (const u16*)(ws + OFF_W1 + W1_WNS); t.ldb = 1024;
    gemm512<1, 1>(acc, t, 1024, smem, st, false, t, false);
  }
  float* NG = (float*)(ws + OFF_NG);
  const int tid = otid(), lane = tid & 63, wid = tid >> 6, r16 = lane & 15, q = lane >> 4;
#pragma unroll
  for (int mf = 0; mf < 2; ++mf) {
    const int m = strip * 256 + wid * 32 + mf * 16 + r16;
#pragma unroll
    for (int nf = 0; nf < 3; ++nf) {
      const int c = nf * 16 + q * 4;
      float4 o; o.x = sigmoidf_(acc[nf][mf][0]); o.y = sigmoidf_(acc[nf][mf][1]); o.z = sigmoidf_(acc[nf][mf][2]); o.w = sigmoidf_(acc[nf][mf][3]);
      *(float4*)(NG + (long)m * 48 + c) = o;
    }
  }
  __syncthreads();
}
DI void phaseB_half_tile(const Params& p, int mt, int n0, char* smem) {
  const int m0 = mt * 256;
  char* ws = p.ws;
  f32x4 acc[4][4];
  zero_acc<2>(acc);
  {
    Stg st;
    TileSrc t; t.A = (const u16*)(ws + OFF_HB) + (long)m0 * 1024; t.lda = 1024; t.Bt = (const u16*)(ws + OFF_W1 + W1_WIN) + (long)n0 * 1024; t.ldb = 1024;
    gemm512<2, 2>(acc, t, 1024, smem, st, false, t, false);
  }
  u16* R = (u16*)(ws + OFF_RG);
  epi512_rows16<2, 2>(acc, m0, n0, R, 1024, -5632, [](float v) { return geluf_(v); });
}

DI void rglru_item(const Params& p, int l, int item, char* smem) {
  const int tid = htid(), lane = tid & 63, w = tid >> 6, r32 = lane & 31, h = lane >> 5;
  const int chalf = item & 1, hd = (item >> 1) & 15, b = item >> 5;
  char* xcb = smem;
  char* WT = smem + 18432;
  float* AL = (float*)(smem + 27648);
  float* BL = (float*)(smem + 44544);
  float* segP = (float*)(smem + 61440);
  float* segH = (float*)(smem + 62464);
  float* carry = (float*)(smem + 63488);
  const u16* XR = (const u16*)(p.ws + OFF_XR);
  u16* RG = (u16*)(p.ws + OFF_RG);
  {
    const float* wa = p.in[18] + (long)l * 65536 + (long)hd * 4096;
    const float* wx = p.in[20] + (long)l * 65536 + (long)hd * 4096;
#pragma unroll 4
    for (int e = 0; e < 16; ++e) {
      const int idx = tid + 256 * e;
      const int gate = idx >> 11, i = (idx >> 5) & 63, o = idx & 31;
      const float v = (gate ? wx : wa)[i * 64 + chalf * 32 + o];
      ((u16*)WT)[((o >> 4) * 32 + gate * 16 + (o & 15)) * 72 + i] = f2bf(v);
    }
    if (tid < 64) carry[tid] = 0.f;
  }
  const int cc = tid & 63, tg = tid >> 6;
  float cw[4];
#pragma unroll
  for (int jj = 0; jj < 4; ++jj) cw[jj] = p.in[16][(long)l * 4096 + jj * 1024 + hd * 64 + cc];
  const float cb = p.in[17][(long)l * 1024 + hd * 64 + cc];
  const int wr = w & 1, mth = w >> 1;
  float ba[8], bx[8], sp[8];
#pragma unroll
  for (int e = 0; e < 8; ++e) {
    const int rho = (e & 3) + 8 * (e >> 2) + 4 * h;
    const int c = hd * 64 + chalf * 32 + wr * 16 + rho;
    ba[e] = p.in[19][(long)l * 1024 + c]; bx[e] = p.in[21][(long)l * 1024 + c];
    sp[e] = -8.f * log1pf(expf(-p.in[22][(long)l * 1024 + c]));
  }
  const int scl = tid & 31, seg = tid >> 5;
  float xn[35];
  {
    const u16* xp = XR + ((long)b * 2048 + tg * 32) * 1024 + hd * 64 + cc;
#pragma unroll
    for (int jj = 0; jj < 35; ++jj) { const int s = tg * 32 + jj - 3; xn[jj] = (s >= 0) ? bf2f(xp[(long)(jj - 3) * 1024]) : 0.f; }
  }
  __syncthreads();
#pragma unroll 1
  for (int ch = 0; ch < 16; ++ch) {
    const int s0 = ch * 128;
    u16* rp = RG + ((long)b * 2048 + s0 + seg * 16) * 1024 + hd * 64 + chalf * 32 + scl;
    float rgv[16];
#pragma unroll
    for (int jj = 0; jj < 16; ++jj) rgv[jj] = bf2f(rp[(long)jj * 1024]);
#pragma unroll
    for (int tt = 0; tt < 32; ++tt) {
      const float v = cb + cw[0] * xn[tt] + cw[1] * xn[tt + 1] + cw[2] * xn[tt + 2] + cw[3] * xn[tt + 3];
      ((u16*)xcb)[(tg * 32 + tt) * 72 + cc] = f2bf(v);
    }
    if (ch + 1 < 16) {
      const u16* xp = XR + ((long)b * 2048 + s0 + 128 + tg * 32) * 1024 + hd * 64 + cc;
#pragma unroll
      for (int jj = 0; jj < 35; ++jj) xn[jj] = bf2f(xp[(long)(jj - 3) * 1024]);
    }
    __syncthreads();
#pragma unroll
    for (int m2 = 0; m2 < 2; ++m2) {
      const int mt = mth * 2 + m2;
      f32x16 acc = zero16();
#pragma unroll
      for (int ks = 0; ks < 4; ++ks) {
        const bf16x8 fa = *(const bf16x8*)(WT + (wr * 32 + r32) * 144 + ks * 32 + h * 16);
        const bf16x8 fb = *(const bf16x8*)(xcb + (mt * 32 + r32) * 144 + ks * 32 + h * 16);
        acc = MFMA32(fa, fb, acc);
      }
      const int t = mt * 32 + r32;
#pragma unroll
      for (int e = 0; e < 8; ++e) {
        const int rho = (e & 3) + 8 * (e >> 2) + 4 * h;
        const int cl = wr * 16 + rho;
        const float r = sigmoidf_(acc[e] + ba[e]), ii = sigmoidf_(acc[e + 8] + bx[e]);
        const float la = r * sp[e];
        const float a = __expf(la);
        const float om2 = fmaxf(__builtin_fmaf(-a, a, 1.f), 0.f);
        const float xcv = bf2f(((const u16*)xcb)[t * 72 + chalf * 32 + cl]);
        AL[t * 33 + cl] = a;
        BL[t * 33 + cl] = __builtin_amdgcn_sqrtf(om2) * ii * xcv;
      }
    }
    __syncthreads();
    {
      float a[16], bq[16];
      float P = 1.f, H = 0.f;
#pragma unroll
      for (int jj = 0; jj < 16; ++jj) { a[jj] = AL[(seg * 16 + jj) * 33 + scl]; bq[jj] = BL[(seg * 16 + jj) * 33 + scl]; H = a[jj] * H + bq[jj]; P *= a[jj]; }
      segP[seg * 32 + scl] = P; segH[seg * 32 + scl] = H;
      __syncthreads();
      float hh = carry[(ch & 1) * 32 + scl];
      for (int s2 = 0; s2 < seg; ++s2) hh = segP[s2 * 32 + scl] * hh + segH[s2 * 32 + scl];
#pragma unroll
      for (int jj = 0; jj < 16; ++jj) { hh = a[jj] * hh + bq[jj]; rp[(long)jj * 1024] = f2bf(hh * rgv[jj]); }
      if (seg == 7) carry[((ch + 1) & 1) * 32 + scl] = hh;
    }
  }
  __syncthreads();
}

DI void compress_item(const Params& p, int item, char* smem) {
  const int tid = otid(), lane = tid & 63, w = tid >> 6, r32 = lane & 31, h = lane >> 5;
  const int kv = item & 1, mt = item >> 1;
  char* ws = p.ws;
  const u16* w2T = (const u16*)(ws + OFF_W1 + (kv ? W1_WV2 : W1_WK2));
  const float* cb = (const float*)(ws + OFF_SM + SM_CKV) + kv * 256;
  u16* hid = (u16*)(ws + OFF_SM + SM_HID) + (long)item * 65536;
  {
    TileSrc src; src.A = (const u16*)(ws + OFF_KV) + (long)kv * KV_ELEMS + (long)mt * 256 * 1024; src.lda = 1024;
    src.Bt = (const u16*)(ws + OFF_W1 + (kv ? W1_WV1 : W1_WK1)); src.ldb = 2048;
    f32x4 acc[4][8];
    zero_acc<4>(acc);
    Stg st;
    gemm512<4, 4>(acc, src, 2048, smem, st, false, src, false);
    epi512<4, 4>(acc, 0, 0, [&](int m, int n, float a, float b, float c, float d) {
      const float4 cv = *(const float4*)(cb + n);
      store4bf(hid + m * 256 + n, geluf_(a + cv.x), geluf_(b + cv.y), geluf_(c + cv.z), geluf_(d + cv.w));
    });
  }
  __syncthreads();
  f32x16 o2[2]; o2[0] = zero16(); o2[1] = zero16();
#pragma unroll 4
  for (int ks = 0; ks < 16; ++ks) {
    const bf16x8 fb = *(const bf16x8*)(hid + (w * 32 + r32) * 256 + ks * 16 + h * 8);
#pragma unroll
    for (int dt = 0; dt < 2; ++dt) {
      const bf16x8 fa = *(const bf16x8*)(w2T + (dt * 32 + r32) * 256 + ks * 16 + h * 8);
      o2[dt] = MFMA32(fa, fb, o2[dt]);
    }
  }
  const int R = mt * 256 + w * 32 + r32;
  const int bg = R >> 7, n = R & 127;
  const bool dead = (n == 127);
  if (kv == 0) {
    u16* KC = (u16*)(ws + OFF_SM + SM_KC) + (long)bg * 8192;
#pragma unroll
    for (int dt = 0; dt < 2; ++dt)
#pragma unroll
      for (int g4 = 0; g4 < 4; ++g4) {
        const int d = dt * 32 + 8 * g4 + 4 * h;
        if (dead) store4bf(KC + n * 64 + d, 0.f, 0.f, 0.f, 0.f);
        else store4bf(KC + n * 64 + d, o2[dt][4 * g4], o2[dt][4 * g4 + 1], o2[dt][4 * g4 + 2], o2[dt][4 * g4 + 3]);
      }
  } else {
    u16* VCT = (u16*)(ws + OFF_SM + SM_VCT) + (long)bg * 8192;
#pragma unroll
    for (int dt = 0; dt < 2; ++dt)
#pragma unroll
      for (int i = 0; i < 16; ++i) {
        const int d = dt * 32 + (i & 3) + 8 * (i >> 2) + 4 * h;
        VCT[d * 128 + n] = dead ? (u16)0 : f2bf(o2[dt][i]);
      }
  }
  __syncthreads();
}

DI void gmlp_item(const Params& p, int l, int item4, char* smem) {
  const int tid = htid(), lane = tid & 63, w = tid >> 6, r32 = lane & 31, h = lane >> 5;
  const int item = item4 >> 2, g = item4 & 3;
  const long t0 = (long)item * 128;
  char* ws = p.ws;
  const u16* GVT = (const u16*)(ws + OFF_GV) + (long)item * 1024 * 128;
  u16* U = (u16*)(ws + OFF_U);
  const u16* WSB = (const u16*)(ws + OFF_SM + SM_WSB) + (long)g * 16384;
  const long long* stats = (const long long*)(ws + OFF_SM + SM_STATS) + t0 * 2;
  const float* lng = p.in[6] + (long)l * 1024;
  const float* lnb = p.in[7] + (long)l * 1024;
  const float* bs = p.in[9] + (long)l * 512 + g * 128;
  char* ap = smem;
  float* mu = (float*)(smem + 34816);
  float* rs = mu + 128;
  float* c1 = rs + 128;
  float* c2 = c1 + 128;
  if (tid < 128) {
    const float m = (float)stats[tid * 2] * (1.f / 16777216.f / 1024.f);
    const float var = (float)stats[tid * 2 + 1] * (1.f / 16777216.f / 1024.f) - m * m;
    mu[tid] = m; rs[tid] = rsqrtf(fmaxf(var, 0.f) + 1e-6f);
  }
  __syncthreads();
#pragma unroll 2
  for (int i = 0; i < 8; ++i) {
    const int idx = tid + 256 * i;
    const int t = idx >> 4, ch = (idx & 15) * 8;
    const uint4 wv = *(const uint4*)(WSB + t * 128 + ch);
    const unsigned wu[4] = {wv.x, wv.y, wv.z, wv.w};
    float a1 = 0.f, a2 = 0.f;
    uint4 o;
    unsigned* ou = (unsigned*)&o;
#pragma unroll
    for (int e = 0; e < 4; ++e) {
      const float w0 = bflo(wu[e]), w1 = bfhi(wu[e]);
      const unsigned pk = pack2(w0 * rs[ch + 2 * e], w1 * rs[ch + 2 * e + 1]);
      ou[e] = pk;
      a1 += bflo(pk) * mu[ch + 2 * e] + bfhi(pk) * mu[ch + 2 * e + 1];
      a2 += w0 + w1;
    }
    *(uint4*)(ap + t * 272 + ch * 2) = o;
#pragma unroll
    for (int off = 8; off >= 1; off >>= 1) { a1 += __shfl_xor(a1, off); a2 += __shfl_xor(a2, off); }
    if ((idx & 15) == 0) { c1[t] = a1; c2[t] = a2; }
  }
  __syncthreads();
#pragma unroll 1
  for (int dh = 0; dh < 2; ++dh) {
    const int c0 = g * 256 + dh * 128;
    bf16x8 fa[8];
#pragma unroll
    for (int ks = 0; ks < 8; ++ks) fa[ks] = *(const bf16x8*)(GVT + (long)(c0 + w * 32 + r32) * 128 + ks * 16 + h * 8);
    f32x16 acc[4];
#pragma unroll
    for (int mi = 0; mi < 4; ++mi) acc[mi] = zero16();
#pragma unroll
    for (int ks = 0; ks < 8; ++ks) {
#pragma unroll
      for (int mi = 0; mi < 4; ++mi) {
        if (mi >= (ks >> 1)) {
          const bf16x8 fb = *(const bf16x8*)(ap + (mi * 32 + r32) * 272 + ks * 32 + h * 16);
          acc[mi] = MFMA32(fa[ks], fb, acc[mi]);
        }
      }
    }
#pragma unroll
    for (int mi = 0; mi < 4; ++mi) {
      const int t = mi * 32 + r32;
      const float k1 = c1[t], k2 = c2[t], bias = bs[t];
#pragma unroll
      for (int kk = 0; kk < 2; ++kk) {
        unsigned px[2], py[2];
#pragma unroll
        for (int g2 = 0; g2 < 2; ++g2) {
          const int g4 = 2 * kk + g2;
          const int d = c0 + w * 32 + 8 * g4 + 4 * h;
          const float4 gg = *(const float4*)(lng + d), bb = *(const float4*)(lnb + d);
          const uint2 uv = *(const uint2*)(U + (t0 + t) * 1024 + d);
          px[g2] = pack2(bflo(uv.x) * (gg.x * (acc[mi][4 * g4] - k1) + bb.x * k2 + bias), bfhi(uv.x) * (gg.y * (acc[mi][4 * g4 + 1] - k1) + bb.y * k2 + bias));
          py[g2] = pack2(bflo(uv.y) * (gg.z * (acc[mi][4 * g4 + 2] - k1) + bb.z * k2 + bias), bfhi(uv.y) * (gg.w * (acc[mi][4 * g4 + 3] - k1) + bb.w * k2 + bias));
        }
        auto rx = __builtin_amdgcn_permlane32_swap(px[0], px[1], false, false);
        auto ry = __builtin_amdgcn_permlane32_swap(py[0], py[1], false, false);
        uint4 o; o.x = rx[0]; o.y = ry[0]; o.z = rx[1]; o.w = ry[1];
        *(uint4*)(U + (t0 + t) * 1024 + c0 + w * 32 + 8 * (2 * kk + h)) = o;
      }
    }
  }
  __syncthreads();
}

DI void load_tile64(char* dst, const u16* __restrict__ src, long stride) {
  const int tid = htid();
#pragma unroll
  for (int i = 0; i < 2; ++i) { const int idx = tid + 256 * i; const int r = idx >> 3, c = idx & 7; *(uint4*)(dst + r * 144 + c * 16) = *(const uint4*)(src + (long)r * stride + c * 8); }
}
DI f32x16 qk_sub(const char* ldsK, int kr0, const bf16x8 (&qf)[4], int r32, int h) {
  f32x16 s = zero16();
#pragma unroll
  for (int ks = 0; ks < 4; ++ks) { const bf16x8 kf = *(const bf16x8*)(ldsK + (kr0 + r32) * 144 + ks * 32 + h * 16); s = MFMA32(kf, qf[ks], s); }
  return s;
}
DI void pv_sub(f32x16 (&o)[2], const char* ldsV, int key0, const f32x16& pt, int r32, int h) {
#pragma unroll
  for (int s2 = 0; s2 < 2; ++s2) {
    union { uint4 u; bf16x8 v; } pb;
    pb.u.x = pack2(pt[8 * s2 + 0], pt[8 * s2 + 1]); pb.u.y = pack2(pt[8 * s2 + 2], pt[8 * s2 + 3]);
    pb.u.z = pack2(pt[8 * s2 + 4], pt[8 * s2 + 5]); pb.u.w = pack2(pt[8 * s2 + 6], pt[8 * s2 + 7]);
#pragma unroll
    for (int dt = 0; dt < 2; ++dt) {
      const char* vp = ldsV + (dt * 32 + r32) * 136 + (key0 + 16 * s2 + 4 * h) * 2;
      union { uint4 u; bf16x8 v; } vf;
      const uint2 lo = *(const uint2*)vp, hi = *(const uint2*)(vp + 16);
      vf.u.x = lo.x; vf.u.y = lo.y; vf.u.z = hi.x; vf.u.w = hi.y;
      o[dt] = MFMA32(vf.v, pb.v, o[dt]);
    }
  }
}
#define LOG2E_F 1.4426950408889634f
DI void flash_tile(f32x16 (&O)[2], float& m_run, float& l_run, const char* ldsK, const char* ldsV,
                                          const bf16x8 (&qf)[4], int hi, int lo, int r32, int h) {
  f32x16 s[2];
  s[0] = qk_sub(ldsK, 0, qf, r32, h); s[1] = qk_sub(ldsK, 32, qf, r32, h);
  const bool full = (hi >= 59) && (lo < 0);
  bool rowsel = true;
  if (__builtin_amdgcn_ballot_w64(full) != ~0ull) {
    const bool rowmask = (lo < 0) && (hi >= 59 || hi < 0);
    if (__builtin_amdgcn_ballot_w64(rowmask) == ~0ull) {
      rowsel = hi >= 0;
    } else {
#pragma unroll
      for (int sub = 0; sub < 2; ++sub)
#pragma unroll
        for (int i = 0; i < 16; ++i) {
          const int c = sub * 32 + (i & 3) + 8 * (i >> 2);
          s[sub][i] = (c <= hi && c > lo) ? s[sub][i] : -1e30f;
        }
    }
  }
  float mt = fmaxf(s[0][0], s[1][0]);
#pragma unroll
  for (int i = 1; i < 16; ++i) mt = fmaxf(mt, fmaxf(s[0][i], s[1][i]));
  mt = fmaxf(mt, __shfl_xor(mt, 32));
  mt = rowsel ? mt : -1e30f;
  const float m_new = fmaxf(m_run, mt);
  const float mc = rowsel ? fmaxf(m_new, -1e20f) * LOG2E_F : 1e30f;
  float ls = 0.f;
#pragma unroll
  for (int sub = 0; sub < 2; ++sub)
#pragma unroll
    for (int i = 0; i < 16; ++i) { const float pv = __builtin_amdgcn_exp2f(__builtin_fmaf(s[sub][i], LOG2E_F, -mc)); s[sub][i] = pv; ls += pv; }
  if (__builtin_amdgcn_ballot_w64(m_new != m_run) != 0ull) {
    const float alpha = __builtin_amdgcn_exp2f((m_run - fmaxf(m_new, -1e20f)) * LOG2E_F);
    l_run *= alpha;
#pragma unroll
    for (int dt = 0; dt < 2; ++dt)
#pragma unroll
      for (int i = 0; i < 16; ++i) O[dt][i] *= alpha;
  }
  l_run += ls; m_run = m_new;
  pv_sub(O, ldsV, 0, s[0], r32, h);
  pv_sub(O, ldsV, 32, s[1], r32, h);
}

DI void attn_item(const Params& p, int item, char* smem) {
  const int tid = otid(), lane = tid & 63, w = tid >> 6, r32 = lane & 31, h = lane >> 5;
  const int bg = item & 31, kk = (item >> 5) & 7, rr = (item >> 8) & 3;
  const int qt = (item & 0x10000) ? (31 - ((item >> 5) & 31))
                                  : ((rr == 0) ? (31 - kk) : ((rr == 1) ? (16 + kk) : ((rr == 2) ? (15 - kk) : kk)));
  const int b = bg >> 2, g = bg & 3;
  const int t0 = qt * 64, t = t0 + (w >> 2) * 32 + r32, cur = qt;
  const int hd = g * 4 + (w & 3);
  const long tok = (long)b * 2048 + t;
  char* ws = p.ws;
  u16* Q = (u16*)(ws + OFF_Q);
  float* impA = (float*)(smem + 36864);
  float* impB = (float*)(smem + 70656);
  float* impT = (float*)(smem + 104448);
  unsigned* selm = (unsigned*)(smem + 112896);
  const int lr = tid >> 3, lc = tid & 7;
  const int ldoff = lr * 144 + lc * 16;
  const u16* KS = (const u16*)(ws + OFF_KV) + 2 * KV_ELEMS + (long)bg * 131072;
  const u16* VST = (const u16*)(ws + OFF_KV) + 3 * KV_ELEMS + (long)bg * 131072;
  const u16* KW = (const u16*)(ws + OFF_KV) + 4 * KV_ELEMS + (long)bg * 131072;
  const u16* VWT = (const u16*)(ws + OFF_KV) + 5 * KV_ELEMS + (long)bg * 131072;
  const int jlo = (t0 - 511 > 0) ? ((t0 - 511) >> 6) : 0;
  const int ns = cur + 1, ntile = ns + (cur - jlo + 1);
  u32x4 pkA, pvA, pkB, pvB;
#define ATT_ISSUE(i_, K_, V_) do { const int ii_ = (i_); const bool sl_ = ii_ < ns; const int j_ = sl_ ? ii_ : (jlo + ii_ - ns); \
    K_ = *(const u32x4*)((sl_ ? KS : KW) + (long)j_ * 4096 + lr * 64 + lc * 8); \
    V_ = *(const u32x4*)((sl_ ? VST : VWT) + j_ * 64 + (long)lr * 2048 + lc * 8); } while (0)
  bf16x8 qf[4];
#pragma unroll
  for (int ks = 0; ks < 4; ++ks) {
    u32x4 x = *(const u32x4*)(Q + tok * 1024 + hd * 64 + ks * 16 + h * 8);
#pragma unroll
    for (int e = 0; e < 4; ++e) {
      const float lo = bflo(x[e]) * 0.125f, hi = bfhi(x[e]) * 0.125f;
      x[e] = (__float_as_uint(lo) >> 16) | (__float_as_uint(hi) & 0xffff0000u);
    }
    qf[ks] = __builtin_bit_cast(bf16x8, x);
  }
  const float* NG = (const float*)(ws + OFF_NG) + tok * 48 + hd * 3;
  const float g0 = NG[0], g1 = NG[1], g2 = NG[2];
  f32x16 res[2];
  {
    const u16* KC = (const u16*)(ws + OFF_SM + SM_KC) + (long)bg * 8192;
    const u16* VCT = (const u16*)(ws + OFF_SM + SM_VCT) + (long)bg * 8192;
    const int nsub = ((qt * 4 + 2) >> 5) + 1;
    {
      const u32x4 k0 = *(const u32x4*)(KC + lr * 64 + lc * 8), k1 = *(const u32x4*)(KC + 4096 + lr * 64 + lc * 8);
      const u32x4 v0 = *(const u32x4*)(VCT + lr * 128 + lc * 8), v1 = *(const u32x4*)(VCT + lr * 128 + 64 + lc * 8);
      *(u32x4*)(smem + ldoff) = k0; *(u32x4*)(smem + 18432 + ldoff) = k1;
      { const int vo = lr * 136 + lc * 16;
        uint2 a; a.x = v0[0]; a.y = v0[1]; *(uint2*)(smem + 9216 + vo) = a; a.x = v0[2]; a.y = v0[3]; *(uint2*)(smem + 9216 + vo + 8) = a;
        a.x = v1[0]; a.y = v1[1]; *(uint2*)(smem + 27648 + vo) = a; a.x = v1[2]; a.y = v1[3]; *(uint2*)(smem + 27648 + vo + 8) = a; }
    }
    ATT_ISSUE(0, pkA, pvA);
    ATT_ISSUE(1, pkB, pvB);
    __syncthreads();
    const char* K0 = smem; const char* V0 = smem + 9216; const char* K1 = smem + 18432; const char* V1 = smem + 27648;
    f32x16 sc[4];
    sc[0] = qk_sub(K0, 0, qf, r32, h);
    sc[1] = zero16(); sc[2] = zero16(); sc[3] = zero16();
    if (nsub > 1) sc[1] = qk_sub(K0, 32, qf, r32, h);
    if (nsub > 2) sc[2] = qk_sub(K1, 0, qf, r32, h);
    if (nsub > 3) sc[3] = qk_sub(K1, 32, qf, r32, h);
    float mx = -1e30f;
    const int nlim = ((t - 31) >> 4) - 4 * h;
#pragma unroll
    for (int sub = 0; sub < 4; ++sub)
#pragma unroll
      for (int i = 0; i < 16; ++i) {
        const int c = sub * 32 + (i & 3) + 8 * (i >> 2);
        const float v = (c <= nlim) ? sc[sub][i] : -1e30f;
        sc[sub][i] = v; mx = fmaxf(mx, v);
      }
    mx = fmaxf(mx, __shfl_xor(mx, 32));
    const float mxc = fmaxf(mx, -1e20f) * LOG2E_F;
    float lsum = 0.f;
#pragma unroll
    for (int sub = 0; sub < 4; ++sub)
#pragma unroll
      for (int i = 0; i < 16; ++i) { const float pvv = __builtin_amdgcn_exp2f(__builtin_fmaf(sc[sub][i], LOG2E_F, -mxc)); sc[sub][i] = pvv; lsum += pvv; }
    lsum += __shfl_xor(lsum, 32);
    const float inv = (t >= 31) ? (1.f / lsum) : 0.f;
#pragma unroll
    for (int sub = 0; sub < 4; ++sub)
#pragma unroll
      for (int i = 0; i < 16; ++i) sc[sub][i] *= inv;
    const int qloc = (w >> 2) * 32 + r32, hh4 = w & 3;
#pragma unroll
    for (int sub = 0; sub < 4; ++sub)
#pragma unroll
      for (int g4 = 0; g4 < 4; ++g4) {
        const int mi = 8 * sub + 2 * g4 + h;
        const float p3 = 0.5f * sc[sub][4 * g4 + 3];
        impA[(hh4 * 64 + qloc) * 33 + mi] = sc[sub][4 * g4] + sc[sub][4 * g4 + 1] + sc[sub][4 * g4 + 2] + p3;
        impB[(hh4 * 64 + qloc) * 33 + mi + 1] = p3;
      }
    __syncthreads();
    {
      const int q = tid >> 3, jj = (tid & 7) * 4;
#pragma unroll
      for (int e = 0; e < 4; ++e) {
        const int j = jj + e;
        float tot = 0.f;
#pragma unroll
        for (int ww = 0; ww < 4; ++ww) tot += impA[(ww * 64 + q) * 33 + j];
        if (j > 0) {
#pragma unroll
          for (int ww = 0; ww < 4; ++ww) tot += impB[(ww * 64 + q) * 33 + j];
        }
        impT[q * 33 + j] = tot;
      }
      if (tid < 64) selm[tid] = 0u;
    }
    __syncthreads();
    f32x16 oc[2]; oc[0] = zero16(); oc[1] = zero16();
    pv_sub(oc, V0, 0, sc[0], r32, h);
    if (nsub > 1) pv_sub(oc, V0, 32, sc[1], r32, h);
    if (nsub > 2) pv_sub(oc, V1, 0, sc[2], r32, h);
    if (nsub > 3) pv_sub(oc, V1, 32, sc[3], r32, h);
#pragma unroll
    for (int dt = 0; dt < 2; ++dt)
#pragma unroll
      for (int i = 0; i < 16; ++i) res[dt][i] = g0 * oc[dt][i];
    {
      const int q = tid >> 3, jj = (tid & 7) * 4;
      unsigned bits = 0u;
      for (int e = 0; e < 4; ++e) {
        const int j = jj + e;
        bool sel;
        if (j > cur) sel = false;
        else if (j == 0 || j >= cur - 1) sel = true;
        else if (cur - 2 <= 13) sel = true;
        else {
          const float v = impT[q * 33 + j];
          int rank = 0;
          for (int j2 = 1; j2 <= cur - 2; ++j2) { const float v2 = impT[q * 33 + j2]; rank += ((v2 > v) || (v2 == v && j2 < j)) ? 1 : 0; }
          sel = rank < 13;
        }
        if (sel) bits |= (1u << j);
      }
      atomicOr(&selm[q], bits);
    }
    __syncthreads();
  }
  const unsigned mymask = selm[(w >> 2) * 32 + r32];
  {
    f32x16 O[2]; O[0] = zero16(); O[1] = zero16();
    float m_run = -1e30f, l_run = 0.f;
    auto step = [&](int i, u32x4& pk, u32x4& pv) {
      char* bk = smem + (i & 1) * 18432;
      *(u32x4*)(bk + ldoff) = pk;
      { const int vo = lr * 136 + lc * 16; uint2 a; a.x = pv[0]; a.y = pv[1]; *(uint2*)(bk + 9216 + vo) = a; a.x = pv[2]; a.y = pv[3]; *(uint2*)(bk + 9216 + vo + 8) = a; }
      __syncthreads();
      if (i + 2 < ntile) ATT_ISSUE(i + 2, pk, pv);
      if (i == ns) {
        const float l = l_run + __shfl_xor(l_run, 32);
        const float sc_ = g1 / l;
#pragma unroll
        for (int dt = 0; dt < 2; ++dt)
#pragma unroll
          for (int e = 0; e < 16; ++e) { res[dt][e] += sc_ * O[dt][e]; O[dt][e] = 0.f; }
        m_run = -1e30f; l_run = 0.f;
      }
      const bool sl = i < ns;
      const int j = sl ? i : (jlo + i - ns);
      const int kb = j * 64;
      const int hi = (sl && !((mymask >> j) & 1u)) ? -1 : (t - kb - 4 * h);
      const int lo = sl ? -100000 : (t - 512 - kb - 4 * h);
      flash_tile(O, m_run, l_run, bk, bk + 9216, qf, hi, lo, r32, h);
    };
#pragma unroll 1
    for (int i = 0; i < ntile; i += 2) {
      step(i, pkA, pvA);
      if (i + 1 < ntile) step(i + 1, pkB, pvB);
    }
    const float l = l_run + __shfl_xor(l_run, 32);
    const float sc_ = g2 / l;
#pragma unroll
    for (int dt = 0; dt < 2; ++dt)
#pragma unroll
      for (int e = 0; e < 16; ++e) res[dt][e] += sc_ * O[dt][e];
  }
#undef ATT_ISSUE
#pragma unroll
  for (int dt = 0; dt < 2; ++dt)
#pragma unroll
    for (int kk = 0; kk < 2; ++kk) {
      auto rx = __builtin_amdgcn_permlane32_swap(pack2(res[dt][8 * kk + 0], res[dt][8 * kk + 1]), pack2(res[dt][8 * kk + 4], res[dt][8 * kk + 5]), false, false);
      auto ry = __builtin_amdgcn_permlane32_swap(pack2(res[dt][8 * kk + 2], res[dt][8 * kk + 3]), pack2(res[dt][8 * kk + 6], res[dt][8 * kk + 7]), false, false);
      uint4 o; o.x = rx[0]; o.y = ry[0]; o.z = rx[1]; o.w = ry[1];
      *(uint4*)(Q + tok * 1024 + hd * 64 + dt * 32 + 8 * (2 * kk + h)) = o;
    }
  __syncthreads();
}

DI TileSrc srcE(const Params& p, int step) {
  const int item = step / 6, r = step % 6, k = r >> 1, isv = r & 1;
  const int nt = item & 7, mt = item >> 3;
  const size_t yo = (k == 0) ? OFF_U : ((k == 1) ? OFF_Q : OFF_RG);
  TileSrc t;
  t.A = (const u16*)(p.ws + (isv ? yo : OFF_HB)) + (long)mt * 256 * 1024; t.lda = 1024;
  t.Bt = (const u16*)(p.ws + OFF_W1 + (isv ? W1_WBR : W1_WMG)) + ((long)k * 1024 + nt * 128) * 1024; t.ldb = 1024;
  return t;
}
DI void phaseE_tile(const Params& p, int item, char* smem, Stg& st, bool pre, int nitem, bool hasnxt) {
  const int nt = item & 7, mt = item >> 3;
  const int m0 = mt * 256, n0 = nt * 128;
  char* ws = p.ws;
  f32x4 R[4][4];
  zero_acc<2>(R);
#pragma unroll 1
  for (int k = 0; k < 3; ++k) {
    f32x4 acc[4][4];
    zero_acc<2>(acc);
    gemm512<2, 2>(acc, srcE(p, item * 6 + k * 2), 1024, smem, st, pre || (k > 0), srcE(p, item * 6 + k * 2 + 1), true);
    uint4* gs = (uint4*)(ws + OFF_KV + 25165824) + (size_t)blockIdx.x * 4096 + otid();
#pragma unroll
    for (int a = 0; a < 4; ++a) {
#pragma unroll
      for (int b2 = 0; b2 < 2; ++b2) {
        uint4 v;
        v.x = pack2(sigmoidf_(acc[a][2 * b2][0]), sigmoidf_(acc[a][2 * b2][1]));
        v.y = pack2(sigmoidf_(acc[a][2 * b2][2]), sigmoidf_(acc[a][2 * b2][3]));
        v.z = pack2(sigmoidf_(acc[a][2 * b2 + 1][0]), sigmoidf_(acc[a][2 * b2 + 1][1]));
        v.w = pack2(sigmoidf_(acc[a][2 * b2 + 1][2]), sigmoidf_(acc[a][2 * b2 + 1][3]));
        gs[(a * 2 + b2) * 512] = v;
      }
      __builtin_amdgcn_sched_barrier(0);
    }
    zero_acc<2>(acc);
    {
      const bool last = (k == 2);
      gemm512<2, 2>(acc, srcE(p, item * 6 + k * 2 + 1), 1024, smem, st, true, last ? srcE(p, nitem * 6) : srcE(p, item * 6 + k * 2 + 2), last ? hasnxt : true);
    }
#pragma unroll
    for (int a = 0; a < 4; ++a) {
#pragma unroll
      for (int b2 = 0; b2 < 2; ++b2) {
        const uint4 v = gs[(a * 2 + b2) * 512];
        R[a][2 * b2][0] += bflo(v.x) * acc[a][2 * b2][0]; R[a][2 * b2][1] += bfhi(v.x) * acc[a][2 * b2][1];
        R[a][2 * b2][2] += bflo(v.y) * acc[a][2 * b2][2]; R[a][2 * b2][3] += bfhi(v.y) * acc[a][2 * b2][3];
        R[a][2 * b2 + 1][0] += bflo(v.z) * acc[a][2 * b2 + 1][0]; R[a][2 * b2 + 1][1] += bfhi(v.z) * acc[a][2 * b2 + 1][1];
        R[a][2 * b2 + 1][2] += bflo(v.w) * acc[a][2 * b2 + 1][2]; R[a][2 * b2 + 1][3] += bfhi(v.w) * acc[a][2 * b2 + 1][3];
      }
      __builtin_amdgcn_sched_barrier(0);
    }
  }
  u16* M = (u16*)(ws + OFF_MERGED);
  epi512_rows16<2, 2>(R, m0, n0, M, 1024, 0, [](float v) { return v; });
}

DI TileSrc srcP(const u16* A, long lda, const u16* Bt, long ldb, int item) {
  const int nt = item & 3, mt = item >> 2;
  TileSrc t; t.A = A + (long)mt * 256 * lda; t.lda = lda; t.Bt = Bt + (long)nt * 256 * ldb; t.ldb = ldb;
  return t;
}
DI void gemm_f32out_tile(const u16* A, long lda, const u16* Bt, long ldb, int K, u16* C, int item, char* smem, Stg& st, bool pre, int nitem, bool hasnxt) {
  const int nt = item & 3, mt = item >> 2;
  const int m0 = mt * 256, n0 = nt * 256;
  f32x4 acc[4][8];
  zero_acc<4>(acc);
  gemm512<4, 4>(acc, srcP(A, lda, Bt, ldb, item), K, smem, st, pre, srcP(A, lda, Bt, ldb, nitem), hasnxt);
  epi512<4, 4>(acc, m0, n0, [&](int m, int n, float a, float b, float c, float d) { store4bf(C + (long)m * 1024 + n, a, b, c, d); });
}

DI TileSrc srcH(const Params& p, int item) {
  const int nt = item % 22, mt = item / 22;
  TileSrc t; t.A = (const u16*)(p.ws + OFF_HB) + (long)mt * 256 * 1024; t.lda = 1024; t.Bt = (const u16*)(p.ws + OFF_W2 + W2_WFI) + (long)nt * 256 * 1024; t.ldb = 1024;
  return t;
}
DI void phaseH_tile(const Params& p, int item, char* smem, Stg& st, bool pre, int nitem, bool hasnxt) {
  const int nt = item % 22, mt = item / 22;
  const int m0 = mt * 256, n0 = nt * 256;
  char* ws = p.ws;
  f32x4 acc[4][8];
  zero_acc<4>(acc);
  gemm512<4, 4>(acc, srcH(p, item), 1024, smem, st, pre, srcH(p, nitem), hasnxt);
  u16* ACT = (u16*)(ws + OFF_ACT);
  const int tid = otid(), lane = tid & 63, wid = tid >> 6, wm = wid >> 2, wn = wid & 3, r16 = lane & 15, q = lane >> 4;
#pragma unroll
  for (int mf = 0; mf < 8; ++mf) {
    const int m = m0 + wm * 128 + mf * 16 + r16;
    float o[2][4];
#pragma unroll
    for (int nf = 0; nf < 2; ++nf)
#pragma unroll
      for (int e = 0; e < 4; ++e) { const float gt = acc[nf][mf][e], up = acc[nf + 2][mf][e]; o[nf][e] = gt * sigmoidf_(gt) * up; }
    auto rx = __builtin_amdgcn_permlane16_swap(pack2(o[0][0], o[0][1]), pack2(o[1][0], o[1][1]), false, false);
    auto ry = __builtin_amdgcn_permlane16_swap(pack2(o[0][2], o[0][3]), pack2(o[1][2], o[1][3]), false, false);
    const int j = ((n0 + wn * 64) >> 6) * 32 + (q & 1) * 16 + (q >> 1) * 8;
    uint4 ov; ov.x = rx[0]; ov.y = ry[0]; ov.z = rx[1]; ov.w = ry[1];
    *(uint4*)(ACT + (long)m * 2816 + j) = ov;
    __builtin_amdgcn_sched_barrier(0);
  }
}

DI void phaseH_half_tile(const Params& p, int mt, int n0, char* smem) {
  const int m0 = mt * 256;
  char* ws = p.ws;
  f32x4 acc[4][4];
  zero_acc<2>(acc);
  {
    Stg st;
    TileSrc t; t.A = (const u16*)(ws + OFF_HB) + (long)m0 * 1024; t.lda = 1024; t.Bt = (const u16*)(ws + OFF_W2 + W2_WFI) + (long)n0 * 1024; t.ldb = 1024;
    gemm512<2, 2>(acc, t, 1024, smem, st, false, t, false);
  }
  u16* ACT = (u16*)(ws + OFF_ACT);
  const int tid = otid(), lane = tid & 63, wid = tid >> 6, wm = wid >> 1, wn = wid & 1, r16 = lane & 15, q = lane >> 4;
#pragma unroll
  for (int mf = 0; mf < 4; ++mf) {
    const int m = m0 + wm * 64 + mf * 16 + r16;
    float o[2][4];
#pragma unroll
    for (int nf = 0; nf < 2; ++nf)
#pragma unroll
      for (int e = 0; e < 4; ++e) { const float gt = acc[nf][mf][e], up = acc[nf + 2][mf][e]; o[nf][e] = gt * sigmoidf_(gt) * up; }
    auto rx = __builtin_amdgcn_permlane16_swap(pack2(o[0][0], o[0][1]), pack2(o[1][0], o[1][1]), false, false);
    auto ry = __builtin_amdgcn_permlane16_swap(pack2(o[0][2], o[0][3]), pack2(o[1][2], o[1][3]), false, false);
    const int j = ((n0 + wn * 64) >> 6) * 32 + (q & 1) * 16 + (q >> 1) * 8;
    uint4 ov; ov.x = rx[0]; ov.y = ry[0]; ov.z = rx[1]; ov.w = ry[1];
    *(uint4*)(ACT + (long)m * 2816 + j) = ov;
    __builtin_amdgcn_sched_barrier(0);
  }
}

DI void rowsq_exchange(const f32x4 (&acc)[4][8], float* xch, unsigned* cnt, int mt, int nt, char* smem, float* rsv) {
  const int tid = otid(), lane = tid & 63, wid = tid >> 6, wm = wid >> 2, wn = wid & 3, r16 = lane & 15, q = lane >> 4;
  float* part = (float*)smem;
#pragma unroll
  for (int mf = 0; mf < 8; ++mf) {
    float ss = 0.f;
#pragma unroll
    for (int nf = 0; nf < 4; ++nf) ss += acc[nf][mf][0] * acc[nf][mf][0] + acc[nf][mf][1] * acc[nf][mf][1] + acc[nf][mf][2] * acc[nf][mf][2] + acc[nf][mf][3] * acc[nf][mf][3];
    ss += __shfl_xor(ss, 16); ss += __shfl_xor(ss, 32);
    if (q == 0) part[wn * 256 + wm * 128 + mf * 16 + r16] = ss;
  }
  __syncthreads();
  if (tid < 256) {
    const float P = part[tid] + part[256 + tid] + part[512 + tid] + part[768 + tid];
    __hip_atomic_store(xch + ((long)mt * 4 + nt) * 256 + tid, P, __ATOMIC_RELAXED, __HIP_MEMORY_SCOPE_AGENT);
  }
  asm volatile("s_waitcnt vmcnt(0)" ::: "memory");
  __syncthreads();
  if (tid == 0) {
    __hip_atomic_fetch_add(cnt + mt, 1u, __ATOMIC_RELAXED, __HIP_MEMORY_SCOPE_AGENT);
    while (__hip_atomic_load(cnt + mt, __ATOMIC_RELAXED, __HIP_MEMORY_SCOPE_AGENT) < 4u) __builtin_amdgcn_s_sleep(1);
  }
  __syncthreads();
  if (tid < 256) {
    float S = 0.f;
#pragma unroll
    for (int j = 0; j < 4; ++j) S += __hip_atomic_load(xch + ((long)mt * 4 + j) * 256 + tid, __ATOMIC_RELAXED, __HIP_MEMORY_SCOPE_AGENT);
    rsv[tid] = rsqrtf(S * (1.f / 1024.f) + 1e-6f);
  }
  __syncthreads();
}
DI void fused_norm_tile(const Params& p, const u16* A, long lda, const u16* Bt, long ldb, int K, int use, const float* res_in, float* res_out,
                        const float* g_post, const float* g_next, u16* hnext, bool zero_stats, char* smem) {
  const int bid = blockIdx.x;
  const int mt = (bid & 7) * 8 + ((bid >> 3) & 7), nt = bid >> 6;
  const int m0 = mt * 256, n0 = nt * 256;
  char* ws = p.ws;
  f32x4 acc[4][8];
  zero_acc<4>(acc);
  {
    Stg st;
    const TileSrc src = srcP(A, lda, Bt, ldb, mt * 4 + nt);
    gemm512<4, 4>(acc, src, K, smem, st, false, src, false);
  }
  float* xch = (float*)(ws + OFF_NG);
  unsigned* cnt = (unsigned*)(ws + OFF_SM + SM_BAR) + 16 + use * 128;
  float* rsv = (float*)(smem + 4096);
  const int tid = otid(), lane = tid & 63, wid = tid >> 6, wm = wid >> 2, wn = wid & 3, r16 = lane & 15, q = lane >> 4;
  rowsq_exchange(acc, xch, cnt, mt, nt, smem, rsv);
#pragma unroll
  for (int mf = 0; mf < 8; ++mf) {
    const int ml = wm * 128 + mf * 16 + r16;
    const float rs = rsv[ml];
#pragma unroll
    for (int nf = 0; nf < 4; ++nf) {
      const int n = n0 + wn * 64 + nf * 16 + q * 4;
      const float4 xv = *(const float4*)(res_in + (long)(m0 + ml) * 1024 + n);
      const float4 gv = *(const float4*)(g_post + n);
      acc[nf][mf][0] = xv.x + acc[nf][mf][0] * rs * gv.x; acc[nf][mf][1] = xv.y + acc[nf][mf][1] * rs * gv.y;
      acc[nf][mf][2] = xv.z + acc[nf][mf][2] * rs * gv.z; acc[nf][mf][3] = xv.w + acc[nf][mf][3] * rs * gv.w;
      float4 o; o.x = acc[nf][mf][0]; o.y = acc[nf][mf][1]; o.z = acc[nf][mf][2]; o.w = acc[nf][mf][3];
      *(float4*)(res_out + (long)(m0 + ml) * 1024 + n) = o;
    }
    __builtin_amdgcn_sched_barrier(0);
  }
  if (hnext) {
    __syncthreads();
    rowsq_exchange(acc, xch + 65536, cnt + 64, mt, nt, smem, rsv);
#pragma unroll
    for (int mf = 0; mf < 8; ++mf) {
      const int ml = wm * 128 + mf * 16 + r16;
      const float rs = rsv[ml];
#pragma unroll
      for (int pp = 0; pp < 2; ++pp) {
        const int na = n0 + wn * 64 + 2 * pp * 16 + q * 4;
        const float4 ga = *(const float4*)(g_next + na), gb = *(const float4*)(g_next + na + 16);
        auto rx = __builtin_amdgcn_permlane16_swap(pack2(acc[2 * pp][mf][0] * rs * ga.x, acc[2 * pp][mf][1] * rs * ga.y),
                                                   pack2(acc[2 * pp + 1][mf][0] * rs * gb.x, acc[2 * pp + 1][mf][1] * rs * gb.y), false, false);
        auto ry = __builtin_amdgcn_permlane16_swap(pack2(acc[2 * pp][mf][2] * rs * ga.z, acc[2 * pp][mf][3] * rs * ga.w),
                                                   pack2(acc[2 * pp + 1][mf][2] * rs * gb.z, acc[2 * pp + 1][mf][3] * rs * gb.w), false, false);
        const int n = n0 + wn * 64 + (2 * pp + (q & 1)) * 16 + (q >> 1) * 8;
        uint4 o; o.x = rx[0]; o.y = ry[0]; o.z = rx[1]; o.w = ry[1];
        *(uint4*)(hnext + (long)(m0 + ml) * 1024 + n) = o;
      }
      __builtin_amdgcn_sched_barrier(0);
    }
  }
  if (zero_stats && nt == 0 && tid < 256) {
    unsigned long long* stz = (unsigned long long*)(ws + OFF_SM + SM_STATS) + (long)(m0 + tid) * 2;
    unsigned long long zz = 0ull; asm volatile("" : "+v"(zz));
    stz[0] = zz; stz[1] = zz;
  }
  __syncthreads();
}

#ifndef PHMASK
#define PHMASK 0x3ff
#endif
#define PH_ON(i) ((PHMASK >> (i)) & 1)
DI void run_phase(const Params& p, int ph, char* smem, int csub = 7) {
  const int G = gridDim.x, bid = blockIdx.x;
  char* ws = p.ws;
  int half = ((int)__builtin_amdgcn_workitem_id_x()) >> 8;
  asm volatile("" : "+v"(half));
  half = __builtin_amdgcn_readfirstlane(half);
  char* hsm = smem + half * 65536;
  if (ph == 0) {
    if (!PH_ON(9)) return;
    const int n = 2048 + CONV1_ITEMS / 2;
    for (int it = bid; it < n; it += G) {
      if (it < 2048) row_item(it, p.in[0], nullptr, nullptr, nullptr, p.in[1], (u16*)(ws + OFF_HB), (unsigned long long*)(ws + OFF_SM + SM_STATS));
      else conv1_item(p, 0, (it - 2048) * 2 + half, hsm);
    }
    return;
  }
  const int l = (ph - 1) / 9, sp = (ph - 1) % 9;
  switch (sp) {
    case 0: if (!PH_ON(0)) break; {
      Stg st; bool pre = false;
      if (G == 256) {
        int mt, nt, mt2, nt2;
        xcd_tile(0, 27, mt, nt);
        for (int r = 0; r < 6; ++r) { const bool hn = (r < 5); xcd_tile(r + 1, 27, mt2, nt2); phaseB_tile(p, mt * 27 + nt, smem, st, pre, mt2 * 27 + nt2, hn); pre = hn; mt = mt2; nt = nt2; }
        {
          const int x = bid & 7, lb = bid >> 3, tix = lb >> 1;
          phaseB_half_tile(p, x * 8 + (tix & 7), (24 + (tix >> 3)) * 256 + (lb & 1) * 128, smem);
        }
      } else
      for (int it = bid; it < 64 * 27; it += G) { const bool hn = (it + G < 64 * 27); phaseB_tile(p, it, smem, st, pre, it + G, hn); pre = hn; }
      break;
    }
    case 1: if (!PH_ON(1)) break;
      if (G >= 192) {
        if (bid < 128) { if (csub & 1) rglru_item(p, l, bid * 2 + half, hsm); }
        else if (bid < 160) { if (csub & 2) compress_item(p, bid - 128, smem); }
        else {
          for (int e = bid - 160; e < 64 + 256; e += G - 160) {
            if (e < 64) { if (csub & 4) nsa_item(p, e, smem); }
            else { if (csub & 4) gmlp_item(p, l, (e - 64) * 2 + half, hsm); }
          }
        }
#ifndef NO_CD_MERGE
        if (G == 256) {
          unsigned* cq = (unsigned*)(ws + OFF_SM + SM_BAR) + 600 + l * 2;
          const int tidr = (int)__builtin_amdgcn_workitem_id_x();
          if (bid >= 128) {
            asm volatile("s_waitcnt vmcnt(0)" ::: "memory");
            __syncthreads();
            if (tidr == 0) {
              __builtin_amdgcn_fence(__ATOMIC_RELEASE, "agent");
              const unsigned mine = (bid < 160) ? 1u : (unsigned)(((63 - (bid - 160)) / 96) + 1);
              __hip_atomic_fetch_add(cq + 1, (bid < 160 || bid - 160 < 64) ? mine : 0u, __ATOMIC_RELAXED, __HIP_MEMORY_SCOPE_AGENT);
            }
          }
          unsigned* qslot = (unsigned*)(smem + 114688);
          if (tidr == 0) {
            while (__hip_atomic_load(cq + 1, __ATOMIC_RELAXED, __HIP_MEMORY_SCOPE_AGENT) < 96u) __builtin_amdgcn_s_sleep(2);
            __builtin_amdgcn_fence(__ATOMIC_ACQUIRE, "agent");
          }
          for (;;) {
            __syncthreads();
            if (tidr == 0) *qslot = __hip_atomic_fetch_add(cq, 1u, __ATOMIC_RELAXED, __HIP_MEMORY_SCOPE_AGENT);
            __syncthreads();
            const unsigned idx = *qslot;
            if (idx >= 1024u) break;
            attn_item(p, (int)idx | 0x10000, smem);
          }
        }
#endif
      } else {
        for (int e = bid; e < 128 + 32 + 256; e += G) {
          if (e < 128) { if (csub & 1) rglru_item(p, l, e * 2 + half, hsm); }
          else if (e < 160) { if (csub & 2) compress_item(p, e - 128, smem); }
          else { if (csub & 4) gmlp_item(p, l, (e - 160) * 2 + half, hsm); }
        }
      }
      break;
    case 2: if (!PH_ON(2)) break;
#ifndef NO_CD_MERGE
      if (G == 256) break;
#endif
      for (int it = bid; it < 1024; it += G) attn_item(p, it, smem); break;
    case 3: if (!PH_ON(3)) break;
      {
        Stg st; bool pre = false;
        for (int it = bid; it < 512 + CONV2_TILES / 2; it += G) {
          if (it < 512) {
            const bool hn = (it + G < 512);
            int e0 = it, e1 = it + G;
            if (G == 256) { const int x = bid & 7, lb = bid >> 3; const int t0_ = (it >> 8) * 32 + lb, t1_ = t0_ + 32; e0 = (x * 8 + (t0_ & 7)) * 8 + (t0_ >> 3); e1 = (x * 8 + (t1_ & 7)) * 8 + (t1_ >> 3); }
            phaseE_tile(p, e0, smem, st, pre, e1, hn); pre = hn;
          }
          else conv2_item(p, l, (it - 512) * 2 + half, hsm);
        }
      }
      break;
    case 4: if (!PH_ON(4)) break;
      if (G == 256) {
        fused_norm_tile(p, (const u16*)(ws + OFF_MERGED), 1024, (const u16*)(ws + OFF_W2 + W2_WO), 1024, 1024, l * 2 + 0,
                        (l == 0) ? p.in[0] : p.out, p.out, p.in[2] + l * 1024, p.in[3] + l * 1024, (u16*)(ws + OFF_HB), false, smem);
      } else
      {
        Stg st; bool pre = false;
        for (int it = bid; it < 256; it += G) { const bool hn = (it + G < 256);
          const int e0 = (G == 256) ? (((bid & 7) * 8 + ((bid >> 3) & 7)) * 4 + (bid >> 6)) : it;
          gemm_f32out_tile((const u16*)(ws + OFF_MERGED), 1024, (const u16*)(ws + OFF_W2 + W2_WO), 1024, 1024, (u16*)(ws + OFF_TBUF), e0, smem, st, pre, it + G, hn); pre = hn; }
      }
      break;
    case 5: if (!PH_ON(5)) break;
      for (int it = bid; it < 2048; it += G)
        row_item(it, (l == 0) ? p.in[0] : p.out, (const u16*)(ws + OFF_TBUF), p.in[2] + l * 1024, p.out, p.in[3] + l * 1024, (u16*)(ws + OFF_HB), nullptr);
      break;
    case 6: if (!PH_ON(6)) break; {
      Stg st; bool pre = false;
      if (G == 256) {
        int mt, nt, mt2, nt2;
        xcd_tile(0, 22, mt, nt);
        for (int r = 0; r < 5; ++r) { const bool hn = (r < 4); xcd_tile(r + 1, 22, mt2, nt2); phaseH_tile(p, mt * 22 + nt, smem, st, pre, mt2 * 22 + nt2, hn); pre = hn; mt = mt2; nt = nt2; }
        {
          const int x = bid & 7, lb = bid >> 3, tix = lb >> 1;
          phaseH_half_tile(p, x * 8 + (tix & 7), (20 + (tix >> 3)) * 256 + (lb & 1) * 128, smem);
        }
      } else
      for (int it = bid; it < 64 * 22; it += G) { const bool hn = (it + G < 64 * 22); phaseH_tile(p, it, smem, st, pre, it + G, hn); pre = hn; }
      break;
    }
    case 7: if (!PH_ON(7)) break;
      if (G == 256) {
        const bool nxt = (l + 1 < 2);
        fused_norm_tile(p, (const u16*)(ws + OFF_ACT), 2816, (const u16*)(ws + OFF_W2 + W2_WFO), 2816, 2816, l * 2 + 1,
                        p.out, p.out, p.in[4] + l * 1024, nxt ? (p.in[1] + (l + 1) * 1024) : nullptr, nxt ? (u16*)(ws + OFF_HB) : nullptr, nxt, smem);
        if (nxt) for (int it = bid; it < CONV1_ITEMS / 2; it += G) conv1_item(p, l + 1, it * 2 + half, hsm);
      } else
      {
        Stg st; bool pre = false;
        for (int it = bid; it < 256; it += G) { const bool hn = (it + G < 256);
          const int e0 = (G == 256) ? (((bid & 7) * 8 + ((bid >> 3) & 7)) * 4 + (bid >> 6)) : it;
          gemm_f32out_tile((const u16*)(ws + OFF_ACT), 2816, (const u16*)(ws + OFF_W2 + W2_WFO), 2816, 2816, (u16*)(ws + OFF_TBUF), e0, smem, st, pre, it + G, hn); pre = hn; }
      }
      break;
    case 8: if (!PH_ON(8)) break; {
      const bool nxt = (l + 1 < 2);
      const int n = 2048 + (nxt ? CONV1_ITEMS / 2 : 0);
      for (int it = bid; it < n; it += G) {
        if (it < 2048) row_item(it, p.out, (const u16*)(ws + OFF_TBUF), p.in[4] + l * 1024, p.out, nxt ? (p.in[1] + (l + 1) * 1024) : nullptr, nxt ? (u16*)(ws + OFF_HB) : nullptr, (unsigned long long*)(ws + OFF_SM + SM_STATS));
        else conv1_item(p, l + 1, (it - 2048) * 2 + half, hsm);
      }
      break;
    }
  }
}

constexpr int N_PHASES = 19;

__global__ void __launch_bounds__(NTHR, 2) mega_kernel(Params p, int ph0, int ph1) {
  extern __shared__ __attribute__((aligned(16))) char smem[];
  cg::grid_group grid = cg::this_grid();
#ifdef TIMER_MASK
  unsigned long long tacc = 0, tprev = wall_clock64();
#endif
  unsigned* gbar = (unsigned*)(p.ws + OFF_SM + SM_BAR);
  if (blockIdx.x == 0) { __hip_atomic_store(gbar + threadIdx.x, 0u, __ATOMIC_RELAXED, __HIP_MEMORY_SCOPE_AGENT); __hip_atomic_store(gbar + 512 + threadIdx.x, 0u, __ATOMIC_RELAXED, __HIP_MEMORY_SCOPE_AGENT); }
  const bool fused_rows = (gridDim.x == 256);
  unsigned nbar = 0;
  for (int ph = ph0; ph < ph1; ++ph) {
    if (fused_rows && ph >= 1) { const int kd = (ph - 1) % 9; if (kd == 5 || kd == 8) continue;
#ifndef NO_CD_MERGE
      if (kd == 2) continue;
#endif
    }
#ifdef CSUB
    if (ph >= 1 && ((ph - 1) % 9) == 1) {
      for (int c = 1; c <= 4; c <<= 1) {
        run_phase(p, ph, smem, c);
        grid.sync();
        const unsigned long long tn = wall_clock64(); if (c == CSUB) tacc += tn - tprev; tprev = tn;
      }
      continue;
    }
#endif
    run_phase(p, ph, smem);
#ifdef TIMER_MASK
    grid.sync();
    { const unsigned long long tn = wall_clock64(); const int kind = (ph == 0) ? 9 : ((ph - 1) % 9); if ((TIMER_MASK >> kind) & 1) tacc += tn - tprev; tprev = tn; }
#else
    if (ph + 1 < ph1) {
      if (ph == ph0) grid.sync();
      else {
        asm volatile("s_waitcnt vmcnt(0)" ::: "memory");
        __syncthreads();
        ++nbar;
        if (threadIdx.x == 0) {
          __builtin_amdgcn_fence(__ATOMIC_RELEASE, "agent");
          __hip_atomic_fetch_add(gbar, 1u, __ATOMIC_RELAXED, __HIP_MEMORY_SCOPE_AGENT);
          const unsigned target = nbar * gridDim.x;
          while (__hip_atomic_load(gbar, __ATOMIC_RELAXED, __HIP_MEMORY_SCOPE_AGENT) < target) __builtin_amdgcn_s_sleep(2);
          __builtin_amdgcn_fence(__ATOMIC_ACQUIRE, "agent");
        }
        __syncthreads();
      }
    }
#endif
  }
#ifdef TIMER_MASK
  if (blockIdx.x == 0 && threadIdx.x == 0) p.out[0] += (float)tacc * 0.001f;
#endif
}

extern "C" void kernel_launch(void* const* d_in, const int* in_sizes, int n_in, void* d_out, int out_size, void* d_ws, size_t ws_size,
                              hipStream_t stream) {
  static int grid_blocks = 0;
  if (!grid_blocks) {
    int dev = 0, cus = 0, per_cu = 0;
    (void)hipGetDevice(&dev);
    (void)hipDeviceGetAttribute(&cus, hipDeviceAttributeMultiprocessorCount, dev);
    (void)hipFuncSetAttribute((const void*)mega_kernel, hipFuncAttributeMaxDynamicSharedMemorySize, LDS_BYTES);
    (void)hipOccupancyMaxActiveBlocksPerMultiprocessor(&per_cu, mega_kernel, NTHR, LDS_BYTES);
    if (per_cu < 1) per_cu = 1;
    if (per_cu > 1) per_cu = 1;
    grid_blocks = cus * per_cu;
    if (ws_size < WS_NEED) fprintf(stderr, "kernel_launch: workspace too small: %zu < %zu\n", ws_size, (size_t)WS_NEED);
  }
  Params p{};
  for (int i = 0; i < 29; ++i) p.in[i] = (const float*)d_in[i];
  p.out = (float*)d_out;
  p.ws = (char*)d_ws;
#if MK_MULTI
  for (int ph = 0; ph < N_PHASES; ++ph) {
    hipLaunchKernelGGL(mega_kernel, dim3(grid_blocks), dim3(NTHR), LDS_BYTES, stream, p, ph, ph + 1);
  }
#else
  int ph0 = 0, ph1 = N_PHASES;
  void* args[] = {&p, &ph0, &ph1};
  hipError_t e = hipLaunchCooperativeKernel((void*)mega_kernel, dim3(grid_blocks), dim3(NTHR), args, LDS_BYTES, stream);
  if (e != hipSuccess) fprintf(stderr, "cooperative launch failed: %s (grid %d)\n", hipGetErrorString(e), grid_blocks);
#endif
}
```

```cpp
#include <hip/hip_runtime.h>
#include <hip/hip_cooperative_groups.h>
#include <cstdio>
namespace cg = cooperative_groups;

#ifndef MK_MULTI
#define MK_MULTI 0
#endif

typedef unsigned short u16;
using bf16x8 = __attribute__((ext_vector_type(8))) short;
using f32x16 = __attribute__((ext_vector_type(16))) float;
using u32x4 = __attribute__((ext_vector_type(4))) unsigned;
using f32x4 = __attribute__((ext_vector_type(4))) float;
#define MFMA16(a, b, c) __builtin_amdgcn_mfma_f32_16x16x32_bf16((a), (b), (c), 0, 0, 0)
#define DI __device__ __forceinline__
#define MFMA32(a, b, c) __builtin_amdgcn_mfma_f32_32x32x16_bf16((a), (b), (c), 0, 0, 0)

constexpr int T_ = 16384;
constexpr int NTHR = 512;
constexpr int LDS_BYTES = 131072;

constexpr size_t SZ32 = 33554432;
constexpr size_t OFF_HB = 0;
constexpr size_t OFF_U = 1 * SZ32;
constexpr size_t OFF_GV = 2 * SZ32;
constexpr size_t OFF_Q = 3 * SZ32;
constexpr size_t OFF_XR = 4 * SZ32;
constexpr size_t OFF_RG = 5 * SZ32;
constexpr size_t OFF_KV = 6 * SZ32;
constexpr size_t KV_ELEMS = 4194304;
constexpr size_t OFF_NG = OFF_KV + 50331648;
constexpr size_t OFF_SM = OFF_NG + 3145728;
constexpr size_t SM_KC = 0, SM_VCT = 524288, SM_CKV = 1048576, SM_WSB = 1050624, SM_HID = 1310720, SM_STATS = 5505024, SM_BAR = 5767168;
constexpr size_t OFF_W1 = OFF_SM + 6291456;
constexpr size_t W1_WIN = 0, W1_WMG = 14155776, W1_WBR = W1_WMG + 6291456, W1_WK1 = W1_WBR + 6291456, W1_WV1 = W1_WK1 + 1048576, W1_WK2 = W1_WV1 + 1048576, W1_WV2 = W1_WK2 + 32768, W1_WNS = W1_WV2 + 32768;
constexpr size_t WS_NEED = OFF_W1 + W1_WNS + 131072;
constexpr size_t OFF_TBUF = OFF_XR;
constexpr size_t OFF_W2 = OFF_KV;
constexpr size_t W2_WO = 0, W2_WFI = 2097152, W2_WFO = 13631488;
constexpr size_t OFF_ACT = OFF_U;
constexpr size_t OFF_MERGED = OFF_GV;

struct Params { const float* in[29]; float* out; char* ws; };

DI int otid() { int t = (int)__builtin_amdgcn_workitem_id_x(); asm volatile("" : "+v"(t)); return t; }
DI int htid() { int t = (int)__builtin_amdgcn_workitem_id_x() & 255; asm volatile("" : "+v"(t)); return t; }

DI float bf2f(u16 b) { return __uint_as_float(((unsigned)b) << 16); }
typedef __bf16 bf2_t __attribute__((ext_vector_type(2)));
typedef float f2_t __attribute__((ext_vector_type(2)));
DI unsigned pack2(float a, float b) { f2_t v; v.x = a; v.y = b; return __builtin_bit_cast(unsigned, __builtin_convertvector(v, bf2_t)); }
DI u16 f2bf(float x) { return (u16)(pack2(x, 0.f) & 0xffffu); }
DI float bflo(unsigned w) { return __uint_as_float(w << 16); }
DI float bfhi(unsigned w) { return __uint_as_float(w & 0xffff0000u); }
DI float rcpf(float x) { return __builtin_amdgcn_rcpf(x); }
DI float sigmoidf_(float x) { return rcpf(1.f + __expf(-x)); }
DI float geluf_(float x) { float y = 1.5957691216f * (x + 0.044715f * x * x * x); return x * rcpf(1.f + __expf(-y)); }
DI float wave_sum(float v) {
#pragma unroll
  for (int o = 32; o >= 1; o >>= 1) v += __shfl_xor(v, o);
  return v;
}
DI float lane_swap1(float v) { const int u = (int)__float_as_uint(v); return __uint_as_float((unsigned)__builtin_amdgcn_update_dpp(u, u, 0xB1, 0xF, 0xF, false)); }
DI unsigned lane_swap2u(unsigned v) { return (unsigned)__builtin_amdgcn_update_dpp((int)v, (int)v, 0x4E, 0xF, 0xF, false); }
DI uint2 quad_transpose_pack(float a, float b, float c, float d, int k) {
  const int odd = k & 1, hi2 = k >> 1;
  const float r0 = lane_swap1(odd ? a : b), r1 = lane_swap1(odd ? c : d);
  const unsigned W0 = odd ? pack2(r0, b) : pack2(a, r0);
  const unsigned W1 = odd ? pack2(r1, d) : pack2(c, r1);
  const unsigned rcv = lane_swap2u(hi2 ? W0 : W1);
  uint2 o; o.x = hi2 ? rcv : W0; o.y = hi2 ? W1 : rcv;
  return o;
}
DI f32x16 zero16() { f32x16 v;
#pragma unroll
  for (int i = 0; i < 16; ++i) v[i] = 0.f;
  return v; }
DI void store4bf(u16* p, float a, float b, float c, float d) { uint2 v; v.x = pack2(a, b); v.y = pack2(c, d); *(uint2*)p = v; }

struct TileSrc { const u16* A; long lda; const u16* Bt; long ldb; };
struct Stg { u32x4 a0, a1, a2, a3, b0, b1, b2, b3; };
template <int MI, int WN> DI void gemm512(f32x4 (&acc)[4][2 * MI], const TileSrc cur, int K, char* smem, Stg& st, bool pre, const TileSrc nxt, bool hasnxt) {
  const int tid = otid(), lane = tid & 63, wid = tid >> 6;
  const int wm = wid / WN, wn = wid % WN;
  const int r16 = lane & 15, q = lane >> 4;
  const int lr = tid >> 3, lc = tid & 7;
  const int soff = lr * 128 + ((lc ^ ((lr >> 1) & 7)) << 4);
  const u16* ga = cur.A + (long)lr * cur.lda + lc * 8;
  const u16* gb = cur.Bt + (long)lr * cur.ldb + lc * 8;
  long a64 = 64 * cur.lda, b64 = 64 * cur.ldb;
  const int nk = K >> 6;
#define G512_LOAD() do { st.a0 = *(const u32x4*)(ga); st.a1 = *(const u32x4*)(ga + a64); st.a2 = *(const u32x4*)(ga + 2 * a64); st.a3 = *(const u32x4*)(ga + 3 * a64); \
    st.b0 = *(const u32x4*)(gb); if (WN > 1) st.b1 = *(const u32x4*)(gb + b64); if (WN > 2) { st.b2 = *(const u32x4*)(gb + 2 * b64); st.b3 = *(const u32x4*)(gb + 3 * b64); } } while (0)
#define G512_STORE(d) do { *(u32x4*)((d) + soff) = st.a0; *(u32x4*)((d) + soff + 8192) = st.a1; *(u32x4*)((d) + soff + 16384) = st.a2; *(u32x4*)((d) + soff + 24576) = st.a3; \
    *(u32x4*)((d) + 32768 + soff) = st.b0; if (WN > 1) *(u32x4*)((d) + 32768 + soff + 8192) = st.b1; if (WN > 2) { *(u32x4*)((d) + 32768 + soff + 16384) = st.b2; *(u32x4*)((d) + 32768 + soff + 24576) = st.b3; } } while (0)
  if (!pre) G512_LOAD();
  G512_STORE(smem);
  ga += 64; gb += 64;
  G512_LOAD();
  const int sw = r16 >> 1;
  for (int kt = 0; kt < nk; ++kt) {
    __syncthreads();
    if (kt + 1 < nk) {
      char* d = smem + ((kt + 1) & 1) * 65536;
      G512_STORE(d);
      if (kt + 2 < nk) { ga += 64; gb += 64; G512_LOAD(); }
      else if (hasnxt) {
        ga = nxt.A + (long)lr * nxt.lda + lc * 8; gb = nxt.Bt + (long)lr * nxt.ldb + lc * 8; a64 = 64 * nxt.lda; b64 = 64 * nxt.ldb;
        G512_LOAD();
      }
    }
    const char* sa = smem + (kt & 1) * 65536;
    const char* sb = sa + 32768;
#pragma unroll
    for (int ks = 0; ks < 2; ++ks) {
      bf16x8 fa[4];
      const int coff = ((ks * 4 + q) ^ sw) << 4;
#pragma unroll
      for (int nf = 0; nf < 4; ++nf) fa[nf] = *(const bf16x8*)(sb + (wn * 64 + nf * 16 + r16) * 128 + coff);
      constexpr int MG = (MI >= 2) ? 4 : 2;
      for (int mh = 0; mh < (2 * MI) / MG; ++mh) {
        bf16x8 fb[MG];
#pragma unroll
        for (int mf = 0; mf < MG; ++mf) fb[mf] = *(const bf16x8*)(sa + (wm * (MI * 32) + (mh * MG + mf) * 16 + r16) * 128 + coff);
#pragma unroll
        for (int nf = 0; nf < 4; ++nf)
#pragma unroll
          for (int mf = 0; mf < MG; ++mf) acc[nf][mh * MG + mf] = MFMA16(fa[nf], fb[mf], acc[nf][mh * MG + mf]);
      }
    }
  }
  if (nk & 1) __syncthreads();
#undef G512_LOAD
#undef G512_STORE
}
template <int MI, int WN, class F> DI void epi512(const f32x4 (&acc)[4][2 * MI], int m0, int n0, F f) {
  const int tid = otid(), lane = tid & 63, wid = tid >> 6, wm = wid / WN, wn = wid % WN, r16 = lane & 15, q = lane >> 4;
#pragma unroll
  for (int nf = 0; nf < 4; ++nf) {
#pragma unroll
    for (int mf = 0; mf < 2 * MI; ++mf) {
      const int m = m0 + wm * (MI * 32) + mf * 16 + r16;
      const int n = n0 + wn * 64 + nf * 16 + q * 4;
      f(m, n, acc[nf][mf][0], acc[nf][mf][1], acc[nf][mf][2], acc[nf][mf][3]);
      __builtin_amdgcn_sched_barrier(0);
    }
  }
}
template <int MI, int WN, class TF> DI void epi512_rows16(const f32x4 (&acc)[4][2 * MI], int m0, int n0, u16* dst, long ld, int coladj, TF tf) {
  const int tid = otid(), lane = tid & 63, wid = tid >> 6, wm = wid / WN, wn = wid % WN, r16 = lane & 15, q = lane >> 4;
#pragma unroll
  for (int mf = 0; mf < 2 * MI; ++mf) {
    const int m = m0 + wm * (MI * 32) + mf * 16 + r16;
#pragma unroll
    for (int pp = 0; pp < 2; ++pp) {
      const unsigned ax = pack2(tf(acc[2 * pp][mf][0]), tf(acc[2 * pp][mf][1])), ay = pack2(tf(acc[2 * pp][mf][2]), tf(acc[2 * pp][mf][3]));
      const unsigned bx = pack2(tf(acc[2 * pp + 1][mf][0]), tf(acc[2 * pp + 1][mf][1])), by = pack2(tf(acc[2 * pp + 1][mf][2]), tf(acc[2 * pp + 1][mf][3]));
      auto rx = __builtin_amdgcn_permlane16_swap(ax, bx, false, false);
      auto ry = __builtin_amdgcn_permlane16_swap(ay, by, false, false);
      const int n = n0 + wn * 64 + (2 * pp + (q & 1)) * 16 + (q >> 1) * 8;
      uint4 o; o.x = rx[0]; o.y = ry[0]; o.z = rx[1]; o.w = ry[1];
      *(uint4*)(dst + (long)m * ld + n + coladj) = o;
    }
    __builtin_amdgcn_sched_barrier(0);
  }
}
template <int MI, int WN, class AF> DI void epi512_rows16_at(const f32x4 (&acc)[4][2 * MI], int m0, int n0, AF af) {
  const int tid = otid(), lane = tid & 63, wid = tid >> 6, wm = wid / WN, wn = wid % WN, r16 = lane & 15, q = lane >> 4;
#pragma unroll
  for (int mf = 0; mf < 2 * MI; ++mf) {
    const int m = m0 + wm * (MI * 32) + mf * 16 + r16;
#pragma unroll
    for (int pp = 0; pp < 2; ++pp) {
      auto rx = __builtin_amdgcn_permlane16_swap(pack2(acc[2 * pp][mf][0], acc[2 * pp][mf][1]), pack2(acc[2 * pp + 1][mf][0], acc[2 * pp + 1][mf][1]), false, false);
      auto ry = __builtin_amdgcn_permlane16_swap(pack2(acc[2 * pp][mf][2], acc[2 * pp][mf][3]), pack2(acc[2 * pp + 1][mf][2], acc[2 * pp + 1][mf][3]), false, false);
      const int n = n0 + wn * 64 + (2 * pp + (q & 1)) * 16 + (q >> 1) * 8;
      uint4 o; o.x = rx[0]; o.y = ry[0]; o.z = rx[1]; o.w = ry[1];
      *(uint4*)af(m, n) = o;
    }
    __builtin_amdgcn_sched_barrier(0);
  }
}
template <int MI> DI void zero_acc(f32x4 (&acc)[4][2 * MI]) {
#pragma unroll
  for (int a = 0; a < 4; ++a)
#pragma unroll
    for (int b = 0; b < 2 * MI; ++b) { acc[a][b][0] = 0.f; acc[a][b][1] = 0.f; acc[a][b][2] = 0.f; acc[a][b][3] = 0.f; }
}

template <int NI> DI void gemm_h(f32x16 (&acc)[NI][2], const u16* __restrict__ A, long lda, const u16* __restrict__ Bt, long ldb, int K, char* smem) {
  const int tid = htid(), lane = tid & 63, wid = tid >> 6;
  const int wm = wid >> 1, wn = wid & 1;
  const int r32 = lane & 31, h = lane >> 5;
  const int lr = tid >> 3, lc = tid & 7;
  const u16* ga = A + (long)lr * lda + lc * 8;
  const u16* gb = Bt + (long)lr * ldb + lc * 8;
  const int soff = lr * 128 + ((lc ^ ((lr & 7) ^ ((lr >> 3) & 1))) << 4);
  uint4 ra[4], rb[2 * NI];
  const int nk = K >> 6;
#pragma unroll
  for (int i = 0; i < 4; ++i) ra[i] = *(const uint4*)(ga + (long)(32 * i) * lda);
#pragma unroll
  for (int i = 0; i < 2 * NI; ++i) rb[i] = *(const uint4*)(gb + (long)(32 * i) * ldb);
#pragma unroll
  for (int i = 0; i < 4; ++i) *(uint4*)(smem + soff + i * 4096) = ra[i];
#pragma unroll
  for (int i = 0; i < 2 * NI; ++i) *(uint4*)(smem + 16384 + soff + i * 4096) = rb[i];
  __syncthreads();
  const int sw = (r32 & 7) ^ ((r32 >> 3) & 1);
  for (int kt = 0; kt < nk; ++kt) {
    const bool more = (kt + 1 < nk);
    if (more) {
      ga += 64; gb += 64;
#pragma unroll
      for (int i = 0; i < 4; ++i) ra[i] = *(const uint4*)(ga + (long)(32 * i) * lda);
#pragma unroll
      for (int i = 0; i < 2 * NI; ++i) rb[i] = *(const uint4*)(gb + (long)(32 * i) * ldb);
    }
    const char* sa = smem + (kt & 1) * 32768;
    const char* sb = sa + 16384;
#pragma unroll
    for (int ks = 0; ks < 4; ++ks) {
      bf16x8 fa[NI], fb[2];
      const int coff = ((ks * 2 + h) ^ sw) << 4;
#pragma unroll
      for (int ni = 0; ni < NI; ++ni) fa[ni] = *(const bf16x8*)(sb + (wn * (32 * NI) + ni * 32 + r32) * 128 + coff);
#pragma unroll
      for (int mi = 0; mi < 2; ++mi) fb[mi] = *(const bf16x8*)(sa + (wm * 64 + mi * 32 + r32) * 128 + coff);
#pragma unroll
      for (int ni = 0; ni < NI; ++ni)
#pragma unroll
        for (int mi = 0; mi < 2; ++mi) acc[ni][mi] = MFMA32(fa[ni], fb[mi], acc[ni][mi]);
    }
    if (more) {
      char* d = smem + ((kt + 1) & 1) * 32768;
#pragma unroll
      for (int i = 0; i < 4; ++i) *(uint4*)(d + soff + i * 4096) = ra[i];
#pragma unroll
      for (int i = 0; i < 2 * NI; ++i) *(uint4*)(d + 16384 + soff + i * 4096) = rb[i];
    }
    __syncthreads();
  }
}

template <int NI, class F> DI void epi_h(const f32x16 (&acc)[NI][2], int m0, int n0, F f) {
  const int lane = htid() & 63, wid = htid() >> 6, wm = wid >> 1, wn = wid & 1, r32 = lane & 31, h = lane >> 5;
#pragma unroll
  for (int ni = 0; ni < NI; ++ni)
#pragma unroll
    for (int mi = 0; mi < 2; ++mi) {
      const int m = m0 + wm * 64 + mi * 32 + r32;
#pragma unroll
      for (int g4 = 0; g4 < 4; ++g4) {
        const int n = n0 + wn * (32 * NI) + ni * 32 + 8 * g4 + 4 * h;
        f(m, n, acc[ni][mi][4 * g4 + 0], acc[ni][mi][4 * g4 + 1], acc[ni][mi][4 * g4 + 2], acc[ni][mi][4 * g4 + 3]);
      }
    }
}

DI int srccol(int mode, int param, int n) {
  if (mode == 0) return n + param;
  if (mode == 1) { if (n < 4608) return n; if (n < 6656) return n + 48; if (n < 6704) return n - 2048; return -1; }
  if (mode == 3) return (n < 48) ? (4608 + n) : -1;
  const int blk = n >> 6, w = n & 63;
  return (w < 32) ? (blk * 32 + w) : (2816 + blk * 32 + (w - 32));
}
DI void conv_tile(const float* __restrict__ src, int lds_, u16* __restrict__ dst, int K, int mode, int param, int tile, char* smem) {
  const int tid = htid();
  const int ntk = K >> 6;
  const int k0 = (tile % ntk) * 64, n0 = (tile / ntk) * 64;
  float* tl = (float*)smem;
  {
    const int c = tid & 63, i0 = tid >> 6;
    const int sc = srccol(mode, param, n0 + c);
#pragma unroll
    for (int j = 0; j < 16; ++j) { const int k = i0 + 4 * j; tl[k * 65 + c] = (sc >= 0) ? src[(long)(k0 + k) * lds_ + sc] : 0.f; }
  }
  __syncthreads();
#pragma unroll
  for (int jj = 0; jj < 2; ++jj) {
    const int nl = (tid >> 3) + 32 * jj, kc = tid & 7;
    float v[8];
#pragma unroll
    for (int e = 0; e < 8; ++e) v[e] = tl[(kc * 8 + e) * 65 + nl];
    uint4 o; o.x = pack2(v[0], v[1]); o.y = pack2(v[2], v[3]); o.z = pack2(v[4], v[5]); o.w = pack2(v[6], v[7]);
    *(uint4*)(dst + (long)(n0 + nl) * K + k0 + kc * 8) = o;
  }
  __syncthreads();
}

constexpr int CONV1_TILES = 1728 + 768 + 768 + 256 + 8 + 16;
constexpr int CONV1_ITEMS = CONV1_TILES + 8 + 32;
DI void conv1_item(const Params& p, int l, int t, char* smem) {
  char* w1 = p.ws + OFF_W1;
  const int tid = htid();
  if (t < CONV1_TILES) {
    const float* win = p.in[5] + (long)l * 1024 * 9776;
    if (t < 1728) { conv_tile(win, 9776, (u16*)(w1 + W1_WIN), 1024, 1, 0, t, smem); return; }
    t -= 1728;
    if (t < 768) { conv_tile(win, 9776, (u16*)(w1 + W1_WMG), 1024, 0, 6704, t, smem); return; }
    t -= 768;
    if (t < 768) { const int k = t >> 8; conv_tile(p.in[23 + k] + (long)l * 1048576, 1024, (u16*)(w1 + W1_WBR) + (long)k * 1048576, 1024, 0, 0, t & 255, smem); return; }
    t -= 768;
    if (t < 256) { const int kv = t >> 7; conv_tile(p.in[kv ? 14 : 12] + (long)l * 524288, 256, (u16*)(w1 + (kv ? W1_WV1 : W1_WK1)), 2048, 0, 0, t & 127, smem); return; }
    t -= 256;
    if (t < 8) { const int kv = t >> 2; conv_tile(p.in[kv ? 15 : 13] + (long)l * 16384, 64, (u16*)(w1 + (kv ? W1_WV2 : W1_WK2)), 256, 0, 0, t & 3, smem); return; }
    t -= 8;
    { conv_tile(win, 9776, (u16*)(w1 + W1_WNS), 1024, 3, 0, t, smem); return; }
  }
  t -= CONV1_TILES;
  if (t < 8) {
    const int kv = t >> 2, jg = t & 3;
    const float* pe = p.in[10 + kv] + (long)l * 2048;
    const float* w = p.in[kv ? 14 : 12] + (long)l * 524288;
    const int j = jg * 64 + (tid & 63), ksl = tid >> 6;
    float s = 0.f;
    for (int kk = ksl * 512; kk < ksl * 512 + 512; kk += 16) {
      float wv[16];
#pragma unroll
      for (int u = 0; u < 16; ++u) wv[u] = w[(long)(kk + u) * 256 + j];
#pragma unroll
      for (int u = 0; u < 16; ++u) s += pe[kk + u] * wv[u];
    }
    float* red = (float*)smem;
    red[tid] = s;
    __syncthreads();
    if (tid < 64) { float r = red[tid] + red[tid + 64] + red[tid + 128] + red[tid + 192]; ((float*)(p.ws + OFF_SM + SM_CKV))[kv * 256 + jg * 64 + tid] = r; }
    __syncthreads();
    return;
  }
  t -= 8;
  {
    const float* wsrc = p.in[8] + (long)l * 65536;
    u16* dst = (u16*)(p.ws + OFF_SM + SM_WSB);
    const int e0 = t * 2048 + tid * 8;
    const int tt = (e0 >> 7) & 127, s0 = e0 & 127;
    float v[8];
#pragma unroll
    for (int e = 0; e < 8; ++e) v[e] = (s0 + e <= tt) ? wsrc[e0 + e] : 0.f;
    uint4 o; o.x = pack2(v[0], v[1]); o.y = pack2(v[2], v[3]); o.z = pack2(v[4], v[5]); o.w = pack2(v[6], v[7]);
    *(uint4*)(dst + e0) = o;
  }
}
constexpr int CONV2_TILES = 256 + 1408 + 704;
DI void conv2_item(const Params& p, int l, int t, char* smem) {
  char* w2 = p.ws + OFF_W2;
  if (t < 256) { conv_tile(p.in[26] + (long)l * 1048576, 1024, (u16*)(w2 + W2_WO), 1024, 0, 0, t, smem); return; }
  t -= 256;
  if (t < 1408) { conv_tile(p.in[27] + (long)l * 1024 * 5632, 5632, (u16*)(w2 + W2_WFI), 1024, 2, 0, t, smem); return; }
  t -= 1408;
  conv_tile(p.in[28] + (long)l * 2816 * 1024, 1024, (u16*)(w2 + W2_WFO), 2816, 0, 0, t, smem);
}

DI void row_item(int item, const float* __restrict__ res_in, const u16* __restrict__ delta, const float* __restrict__ g_post,
                 float* __restrict__ res_out, const float* __restrict__ g_next, u16* __restrict__ hnext, unsigned long long* __restrict__ stats) {
  const int lane = otid() & 63;
  const long row = (long)item * 8 + (otid() >> 6);
  float x[16];
#pragma unroll
  for (int j = 0; j < 4; ++j) { const float4 v = *(const float4*)(res_in + row * 1024 + j * 256 + lane * 4); x[4 * j] = v.x; x[4 * j + 1] = v.y; x[4 * j + 2] = v.z; x[4 * j + 3] = v.w; }
  if (delta) {
    float d[16]; float ss = 0.f;
#pragma unroll
    for (int j = 0; j < 4; ++j) { const uint2 v = *(const uint2*)(delta + row * 1024 + j * 256 + lane * 4); d[4 * j] = bflo(v.x); d[4 * j + 1] = bfhi(v.x); d[4 * j + 2] = bflo(v.y); d[4 * j + 3] = bfhi(v.y); }
#pragma unroll
    for (int i = 0; i < 16; ++i) ss += d[i] * d[i];
    ss = wave_sum(ss);
    const float rs = rsqrtf(ss * (1.f / 1024.f) + 1e-6f);
#pragma unroll
    for (int j = 0; j < 4; ++j) {
      const float4 g = *(const float4*)(g_post + j * 256 + lane * 4);
      x[4 * j] += d[4 * j] * rs * g.x; x[4 * j + 1] += d[4 * j + 1] * rs * g.y; x[4 * j + 2] += d[4 * j + 2] * rs * g.z; x[4 * j + 3] += d[4 * j + 3] * rs * g.w;
      float4 o; o.x = x[4 * j]; o.y = x[4 * j + 1]; o.z = x[4 * j + 2]; o.w = x[4 * j + 3];
      *(float4*)(res_out + row * 1024 + j * 256 + lane * 4) = o;
    }
  }
  if (hnext) {
    if (stats && lane < 2) { unsigned long long zz = 0ull; asm volatile("" : "+v"(zz)); stats[row * 2 + lane] = zz; }
    float ss = 0.f;
#pragma unroll
    for (int i = 0; i < 16; ++i) ss += x[i] * x[i];
    ss = wave_sum(ss);
    const float rs = rsqrtf(ss * (1.f / 1024.f) + 1e-6f);
#pragma unroll
    for (int j = 0; j < 4; ++j) {
      const float4 g = *(const float4*)(g_next + j * 256 + lane * 4);
      store4bf(hnext + row * 1024 + j * 256 + lane * 4, x[4 * j] * rs * g.x, x[4 * j + 1] * rs * g.y, x[4 * j + 2] * rs * g.z, x[4 * j + 3] * rs * g.w);
    }
  }
}

DI bool xcd_tile(int round, int NT, int& mt, int& nt) {
  const int bid = blockIdx.x, x = bid & 7, lb = bid >> 3;
  const int ti = round * 32 + lb;
  mt = x * 8 + (ti & 7); nt = ti >> 3;
  return nt < NT;
}
DI TileSrc srcB(const Params& p, int item) {
  const int nt = item % 27, mt = item / 27;
  TileSrc t; t.A = (const u16*)(p.ws + OFF_HB) + (long)mt * 256 * 1024; t.lda = 1024; t.Bt = (const u16*)(p.ws + OFF_W1 + W1_WIN) + (long)nt * 256 * 1024; t.ldb = 1024;
  return t;
}
DI void phaseB_tile(const Params& p, int item, char* smem, Stg& st, bool pre, int nitem, bool hasnxt) {
  const int nt = item % 27, mt = item / 27;
  const int m0 = mt * 256, n0 = nt * 256;
  char* ws = p.ws;
  f32x4 acc[4][8];
  zero_acc<4>(acc);
  gemm512<4, 4>(acc, srcB(p, item), 1024, smem, st, pre, srcB(p, nitem), hasnxt);
  if (n0 < 1024) {
    u16* U = (u16*)(ws + OFF_U);
    epi512_rows16<4, 4>(acc, m0, n0, U, 1024, 0, [](float v) { return geluf_(v); });
  } else if (n0 < 2048) {
    u16* G = (u16*)(ws + OFF_GV);
    unsigned long long* stats = (unsigned long long*)(ws + OFF_SM + SM_STATS);
    const int tid = otid(), lane = tid & 63, wid = tid >> 6, wm = wid >> 2, wn = wid & 3, r16 = lane & 15, q = lane >> 4;
#pragma unroll
    for (int mf = 0; mf < 8; ++mf) {
      const int m = m0 + wm * 128 + mf * 16 + r16;
      float s1 = 0.f, s2 = 0.f;
#pragma unroll
      for (int nf = 0; nf < 4; ++nf) {
        const int d = n0 - 1024 + wn * 64 + nf * 16 + q * 4;
        float gg[4];
#pragma unroll
        for (int e = 0; e < 4; ++e) { gg[e] = geluf_(acc[nf][mf][e]); s1 += gg[e]; s2 += gg[e] * gg[e]; }
        const int k4 = lane & 3;
        *(uint2*)(G + ((long)(m >> 7) * 1024 + d + k4) * 128 + ((m & 127) - k4)) = quad_transpose_pack(gg[0], gg[1], gg[2], gg[3], k4);
      }
      s1 += __shfl_xor(s1, 16); s2 += __shfl_xor(s2, 16);
      s1 += __shfl_xor(s1, 32); s2 += __shfl_xor(s2, 32);
      if (q == 0) {
        atomicAdd(stats + (long)m * 2, (unsigned long long)(long long)__float2ll_rn(s1 * 16777216.f));
        atomicAdd(stats + (long)m * 2 + 1, (unsigned long long)(long long)__float2ll_rn(s2 * 16777216.f));
      }
      __builtin_amdgcn_sched_barrier(0);
    }
  } else if (n0 < 3072) {
    u16* Q = (u16*)(ws + OFF_Q);
    epi512_rows16<4, 4>(acc, m0, n0, Q, 1024, -2048, [](float v) { return v; });
  } else if (n0 < 4608) {
    const int i6 = (n0 - 3072) >> 8;
    u16* base = (u16*)(ws + OFF_KV) + (long)i6 * KV_ELEMS;
    if (i6 == 3 || i6 == 5) {
      epi512<4, 4>(acc, m0, n0, [&](int m, int n, float a, float b, float c, float d) {
        const int cc = n - 3072, g = (cc >> 6) & 3, dd = cc & 63, bb = m >> 11, s = m & 2047;
        const int k4 = (int)__builtin_amdgcn_workitem_id_x() & 3;
        *(uint2*)(base + ((long)(bb * 4 + g) * 64 + dd + k4) * 2048 + (s - k4)) = quad_transpose_pack(a, b, c, d, k4);
      });
    } else {
      epi512_rows16_at<4, 4>(acc, m0, n0, [&](int m, int n) {
        const int cc = n - 3072, g = (cc >> 6) & 3, dd = cc & 63, bb = m >> 11, s = m & 2047;
        return base + ((long)(bb * 4 + g) * 2048 + s) * 64 + dd;
      });
    }
  } else if (n0 < 5632) {
    u16* X = (u16*)(ws + OFF_XR);
    epi512_rows16<4, 4>(acc, m0, n0, X, 1024, -4608, [](float v) { return v; });
  } else if (n0 < 6656) {
    u16* R = (u16*)(ws + OFF_RG);
    epi512_rows16<4, 4>(acc, m0, n0, R, 1024, -5632, [](float v) { return geluf_(v); });
  } else {
    float* NG = (float*)(ws + OFF_NG);
    epi512<4, 4>(acc, m0, n0, [&](int m, int n, float a, float b, float c, float d) {
      const int cc = n - 6656;
      if (cc < 48) { float4 o; o.x = sigmoidf_(a); o.y = sigmoidf_(b); o.z = sigmoidf_(c); o.w = sigmoidf_(d); *(float4*)(NG + (long)m * 48 + cc) = o; }
    });
  }
}

DI void nsa_item(const Params& p, int strip, char* smem) {
  char* ws = p.ws;
  f32x4 acc[4][2];
  zero_acc<1>(acc);
  {
    Stg st;
    TileSrc t; t.A = (const u16*)(ws + OFF_HB) + (long)strip * 256 * 1024; t.lda = 1024; t.Bt = (const u16*)(ws + OFF_W1 + W1_WNS); t.ldb = 1024;
    gemm512<1, 1>(acc, t, 1024, smem, st, false, t, false);
  }
  float* NG = (float*)(ws + OFF_NG);
  const int tid = otid(), lane = tid & 63, wid = tid >> 6, r16 = lane & 15, q = lane >> 4;
#pragma unroll
  for (int mf = 0; mf < 2; ++mf) {
    const int m = strip * 256 + wid * 32 + mf * 16 + r16;
#pragma unroll
    for (int nf = 0; nf < 3; ++nf) {
      const int c = nf * 16 + q * 4;
      float4 o; o.x = sigmoidf_(acc[nf][mf][0]); o.y = sigmoidf_(acc[nf][mf][1]); o.z = sigmoidf_(acc[nf][mf][2]); o.w = sigmoidf_(acc[nf][mf][3]);
      *(float4*)(NG + (long)m * 48 + c) = o;
    }
  }
  __syncthreads();
}
DI void phaseB_half_tile(const Params& p, int mt, int n0, char* smem) {
  const int m0 = mt * 256;
  char* ws = p.ws;
  f32x4 acc[4][4];
  zero_acc<2>(acc);
  {
    Stg st;
    TileSrc t; t.A = (const u16*)(ws + OFF_HB) + (long)m0 * 1024; t.lda = 1024; t.Bt = (const u16*)(ws + OFF_W1 + W1_WIN) + (long)n0 * 1024; t.ldb = 1024;
    gemm512<2, 2>(acc, t, 1024, smem, st, false, t, false);
  }
  u16* R = (u16*)(ws + OFF_RG);
  epi512_rows16<2, 2>(acc, m0, n0, R, 1024, -5632, [](float v) { return geluf_(v); });
}

DI void rglru_item(const Params& p, int l, int item, char* smem) {
  const int tid = htid(), lane = tid & 63, w = tid >> 6, r32 = lane & 31, h = lane >> 5;
  const int chalf = item & 1, hd = (item >> 1) & 15, b = item >> 5;
  char* xcb = smem;
  char* WT = smem + 18432;
  float* AL = (float*)(smem + 27648);
  float* BL = (float*)(smem + 44544);
  float* segP = (float*)(smem + 61440);
  float* segH = (float*)(smem + 62464);
  float* carry = (float*)(smem + 63488);
  const u16* XR = (const u16*)(p.ws + OFF_XR);
  u16* RG = (u16*)(p.ws + OFF_RG);
  {
    const float* wa = p.in[18] + (long)l * 65536 + (long)hd * 4096;
    const float* wx = p.in[20] + (long)l * 65536 + (long)hd * 4096;
#pragma unroll 4
    for (int e = 0; e < 16; ++e) {
      const int idx = tid + 256 * e;
      const int gate = idx >> 11, i = (idx >> 5) & 63, o = idx & 31;
      const float v = (gate ? wx : wa)[i * 64 + chalf * 32 + o];
      ((u16*)WT)[((o >> 4) * 32 + gate * 16 + (o & 15)) * 72 + i] = f2bf(v);
    }
    if (tid < 64) carry[tid] = 0.f;
  }
  const int cc = tid & 63, tg = tid >> 6;
  float cw[4];
#pragma unroll
  for (int jj = 0; jj < 4; ++jj) cw[jj] = p.in[16][(long)l * 4096 + jj * 1024 + hd * 64 + cc];
  const float cb = p.in[17][(long)l * 1024 + hd * 64 + cc];
  const int wr = w & 1, mth = w >> 1;
  float ba[8], bx[8], sp[8];
#pragma unroll
  for (int e = 0; e < 8; ++e) {
    const int rho = (e & 3) + 8 * (e >> 2) + 4 * h;
    const int c = hd * 64 + chalf * 32 + wr * 16 + rho;
    ba[e] = p.in[19][(long)l * 1024 + c]; bx[e] = p.in[21][(long)l * 1024 + c];
    sp[e] = -8.f * log1pf(expf(-p.in[22][(long)l * 1024 + c]));
  }
  const int scl = tid & 31, seg = tid >> 5;
  float xn[35];
  {
    const u16* xp = XR + ((long)b * 2048 + tg * 32) * 1024 + hd * 64 + cc;
#pragma unroll
    for (int jj = 0; jj < 35; ++jj) { const int s = tg * 32 + jj - 3; xn[jj] = (s >= 0) ? bf2f(xp[(long)(jj - 3) * 1024]) : 0.f; }
  }
  __syncthreads();
#pragma unroll 1
  for (int ch = 0; ch < 16; ++ch) {
    const int s0 = ch * 128;
    u16* rp = RG + ((long)b * 2048 + s0 + seg * 16) * 1024 + hd * 64 + chalf * 32 + scl;
    float rgv[16];
#pragma unroll
    for (int jj = 0; jj < 16; ++jj) rgv[jj] = bf2f(rp[(long)jj * 1024]);
#pragma unroll
    for (int tt = 0; tt < 32; ++tt) {
      const float v = cb + cw[0] * xn[tt] + cw[1] * xn[tt + 1] + cw[2] * xn[tt + 2] + cw[3] * xn[tt + 3];
      ((u16*)xcb)[(tg * 32 + tt) * 72 + cc] = f2bf(v);
    }
    if (ch + 1 < 16) {
      const u16* xp = XR + ((long)b * 2048 + s0 + 128 + tg * 32) * 1024 + hd * 64 + cc;
#pragma unroll
      for (int jj = 0; jj < 35; ++jj) xn[jj] = bf2f(xp[(long)(jj - 3) * 1024]);
    }
    __syncthreads();
#pragma unroll
    for (int m2 = 0; m2 < 2; ++m2) {
      const int mt = mth * 2 + m2;
      f32x16 acc = zero16();
#pragma unroll
      for (int ks = 0; ks < 4; ++ks) {
        const bf16x8 fa = *(const bf16x8*)(WT + (wr * 32 + r32) * 144 + ks * 32 + h * 16);
        const bf16x8 fb = *(const bf16x8*)(xcb + (mt * 32 + r32) * 144 + ks * 32 + h * 16);
        acc = MFMA32(fa, fb, acc);
      }
      const int t = mt * 32 + r32;
#pragma unroll
      for (int e = 0; e < 8; ++e) {
        const int rho = (e & 3) + 8 * (e >> 2) + 4 * h;
        const int cl = wr * 16 + rho;
        const float r = sigmoidf_(acc[e] + ba[e]), ii = sigmoidf_(acc[e + 8] + bx[e]);
        const float la = r * sp[e];
        const float a = __expf(la);
        const float om2 = fmaxf(__builtin_fmaf(-a, a, 1.f), 0.f);
        const float xcv = bf2f(((const u16*)xcb)[t * 72 + chalf * 32 + cl]);
        AL[t * 33 + cl] = a;
        BL[t * 33 + cl] = __builtin_amdgcn_sqrtf(om2) * ii * xcv;
      }
    }
    __syncthreads();
    {
      float a[16], bq[16];
      float P = 1.f, H = 0.f;
#pragma unroll
      for (int jj = 0; jj < 16; ++jj) { a[jj] = AL[(seg * 16 + jj) * 33 + scl]; bq[jj] = BL[(seg * 16 + jj) * 33 + scl]; H = a[jj] * H + bq[jj]; P *= a[jj]; }
      segP[seg * 32 + scl] = P; segH[seg * 32 + scl] = H;
      __syncthreads();
      float hh = carry[(ch & 1) * 32 + scl];
      for (int s2 = 0; s2 < seg; ++s2) hh = segP[s2 * 32 + scl] * hh + segH[s2 * 32 + scl];
#pragma unroll
      for (int jj = 0; jj < 16; ++jj) { hh = a[jj] * hh + bq[jj]; rp[(long)jj * 1024] = f2bf(hh * rgv[jj]); }
      if (seg == 7) carry[((ch + 1) & 1) * 32 + scl] = hh;
    }
  }
  __syncthreads();
}

DI void compress_item(const Params& p, int item, char* smem) {
  const int tid = otid(), lane = tid & 63, w = tid >> 6, r32 = lane & 31, h = lane >> 5;
  const int kv = item & 1, mt = item >> 1;
  char* ws = p.ws;
  const u16* w2T = (const u16*)(ws + OFF_W1 + (kv ? W1_WV2 : W1_WK2));
  const float* cb = (const float*)(ws + OFF_SM + SM_CKV) + kv * 256;
  u16* hid = (u16*)(ws + OFF_SM + SM_HID) + (long)item * 65536;
  {
    TileSrc src; src.A = (const u16*)(ws + OFF_KV) + (long)kv * KV_ELEMS + (long)mt * 256 * 1024; src.lda = 1024;
    src.Bt = (const u16*)(ws + OFF_W1 + (kv ? W1_WV1 : W1_WK1)); src.ldb = 2048;
    f32x4 acc[4][8];
    zero_acc<4>(acc);
    Stg st;
    gemm512<4, 4>(acc, src, 2048, smem, st, false, src, false);
    epi512<4, 4>(acc, 0, 0, [&](int m, int n, float a, float b, float c, float d) {
      const float4 cv = *(const float4*)(cb + n);
      store4bf(hid + m * 256 + n, geluf_(a + cv.x), geluf_(b + cv.y), geluf_(c + cv.z), geluf_(d + cv.w));
    });
  }
  __syncthreads();
  f32x16 o2[2]; o2[0] = zero16(); o2[1] = zero16();
#pragma unroll 4
  for (int ks = 0; ks < 16; ++ks) {
    const bf16x8 fb = *(const bf16x8*)(hid + (w * 32 + r32) * 256 + ks * 16 + h * 8);
#pragma unroll
    for (int dt = 0; dt < 2; ++dt) {
      const bf16x8 fa = *(const bf16x8*)(w2T + (dt * 32 + r32) * 256 + ks * 16 + h * 8);
      o2[dt] = MFMA32(fa, fb, o2[dt]);
    }
  }
  const int R = mt * 256 + w * 32 + r32;
  const int bg = R >> 7, n = R & 127;
  const bool dead = (n == 127);
  if (kv == 0) {
    u16* KC = (u16*)(ws + OFF_SM + SM_KC) + (long)bg * 8192;
#pragma unroll
    for (int dt = 0; dt < 2; ++dt)
#pragma unroll
      for (int g4 = 0; g4 < 4; ++g4) {
        const int d = dt * 32 + 8 * g4 + 4 * h;
        if (dead) store4bf(KC + n * 64 + d, 0.f, 0.f, 0.f, 0.f);
        else store4bf(KC + n * 64 + d, o2[dt][4 * g4], o2[dt][4 * g4 + 1], o2[dt][4 * g4 + 2], o2[dt][4 * g4 + 3]);
      }
  } else {
    u16* VCT = (u16*)(ws + OFF_SM + SM_VCT) + (long)bg * 8192;
#pragma unroll
    for (int dt = 0; dt < 2; ++dt)
#pragma unroll
      for (int i = 0; i < 16; ++i) {
        const int d = dt * 32 + (i & 3) + 8 * (i >> 2) + 4 * h;
        VCT[d * 128 + n] = dead ? (u16)0 : f2bf(o2[dt][i]);
      }
  }
  __syncthreads();
}

DI void gmlp_item(const Params& p, int l, int item4, char* smem) {
  const int tid = htid(), lane = tid & 63, w = tid >> 6, r32 = lane & 31, h = lane >> 5;
  const int item = item4 >> 2, g = item4 & 3;
  const long t0 = (long)item * 128;
  char* ws = p.ws;
  const u16* GVT = (const u16*)(ws + OFF_GV) + (long)item * 1024 * 128;
  u16* U = (u16*)(ws + OFF_U);
  const u16* WSB = (const u16*)(ws + OFF_SM + SM_WSB) + (long)g * 16384;
  const long long* stats = (const long long*)(ws + OFF_SM + SM_STATS) + t0 * 2;
  const float* lng = p.in[6] + (long)l * 1024;
  const float* lnb = p.in[7] + (long)l * 1024;
  const float* bs = p.in[9] + (long)l * 512 + g * 128;
  char* ap = smem;
  float* mu = (float*)(smem + 34816);
  float* rs = mu + 128;
  float* c1 = rs + 128;
  float* c2 = c1 + 128;
  if (tid < 128) {
    const float m = (float)stats[tid * 2] * (1.f / 16777216.f / 1024.f);
    const float var = (float)stats[tid * 2 + 1] * (1.f / 16777216.f / 1024.f) - m * m;
    mu[tid] = m; rs[tid] = rsqrtf(fmaxf(var, 0.f) + 1e-6f);
  }
  __syncthreads();
#pragma unroll 2
  for (int i = 0; i < 8; ++i) {
    const int idx = tid + 256 * i;
    const int t = idx >> 4, ch = (idx & 15) * 8;
    const uint4 wv = *(const uint4*)(WSB + t * 128 + ch);
    const unsigned wu[4] = {wv.x, wv.y, wv.z, wv.w};
    float a1 = 0.f, a2 = 0.f;
    uint4 o;
    unsigned* ou = (unsigned*)&o;
#pragma unroll
    for (int e = 0; e < 4; ++e) {
      const float w0 = bflo(wu[e]), w1 = bfhi(wu[e]);
      const unsigned pk = pack2(w0 * rs[ch + 2 * e], w1 * rs[ch + 2 * e + 1]);
      ou[e] = pk;
      a1 += bflo(pk) * mu[ch + 2 * e] + bfhi(pk) * mu[ch + 2 * e + 1];
      a2 += w0 + w1;
    }
    *(uint4*)(ap + t * 272 + ch * 2) = o;
#pragma unroll
    for (int off = 8; off >= 1; off >>= 1) { a1 += __shfl_xor(a1, off); a2 += __shfl_xor(a2, off); }
    if ((idx & 15) == 0) { c1[t] = a1; c2[t] = a2; }
  }
  __syncthreads();
#pragma unroll 1
  for (int dh = 0; dh < 2; ++dh) {
    const int c0 = g * 256 + dh * 128;
    bf16x8 fa[8];
#pragma unroll
    for (int ks = 0; ks < 8; ++ks) fa[ks] = *(const bf16x8*)(GVT + (long)(c0 + w * 32 + r32) * 128 + ks * 16 + h * 8);
    f32x16 acc[4];
#pragma unroll
    for (int mi = 0; mi < 4; ++mi) acc[mi] = zero16();
#pragma unroll
    for (int ks = 0; ks < 8; ++ks) {
#pragma unroll
      for (int mi = 0; mi < 4; ++mi) {
        if (mi >= (ks >> 1)) {
          const bf16x8 fb = *(const bf16x8*)(ap + (mi * 32 + r32) * 272 + ks * 32 + h * 16);
          acc[mi] = MFMA32(fa[ks], fb, acc[mi]);
        }
      }
    }
#pragma unroll
    for (int mi = 0; mi < 4; ++mi) {
      const int t = mi * 32 + r32;
      const float k1 = c1[t], k2 = c2[t], bias = bs[t];
#pragma unroll
      for (int kk = 0; kk < 2; ++kk) {
        unsigned px[2], py[2];
#pragma unroll
        for (int g2 = 0; g2 < 2; ++g2) {
          const int g4 = 2 * kk + g2;
          const int d = c0 + w * 32 + 8 * g4 + 4 * h;
          const float4 gg = *(const float4*)(lng + d), bb = *(const float4*)(lnb + d);
          const uint2 uv = *(const uint2*)(U + (t0 + t) * 1024 + d);
          px[g2] = pack2(bflo(uv.x) * (gg.x * (acc[mi][4 * g4] - k1) + bb.x * k2 + bias), bfhi(uv.x) * (gg.y * (acc[mi][4 * g4 + 1] - k1) + bb.y * k2 + bias));
          py[g2] = pack2(bflo(uv.y) * (gg.z * (acc[mi][4 * g4 + 2] - k1) + bb.z * k2 + bias), bfhi(uv.y) * (gg.w * (acc[mi][4 * g4 + 3] - k1) + bb.w * k2 + bias));
        }
        auto rx = __builtin_amdgcn_permlane32_swap(px[0], px[1], false, false);
        auto ry = __builtin_amdgcn_permlane32_swap(py[0], py[1], false, false);
        uint4 o; o.x = rx[0]; o.y = ry[0]; o.z = rx[1]; o.w = ry[1];
        *(uint4*)(U + (t0 + t) * 1024 + c0 + w * 32 + 8 * (2 * kk + h)) = o;
      }
    }
  }
  __syncthreads();
}

DI void load_tile64(char* dst, const u16* __restrict__ src, long stride) {
  const int tid = htid();
#pragma unroll
  for (int i = 0; i < 2; ++i) { const int idx = tid + 256 * i; const int r = idx >> 3, c = idx & 7; *(uint4*)(dst + r * 144 + c * 16) = *(const uint4*)(src + (long)r * stride + c * 8); }
}
DI f32x16 qk_sub(const char* ldsK, int kr0, const bf16x8 (&qf)[4], int r32, int h) {
  f32x16 s = zero16();
#pragma unroll
  for (int ks = 0; ks < 4; ++ks) { const bf16x8 kf = *(const bf16x8*)(ldsK + (kr0 + r32) * 144 + ks * 32 + h * 16); s = MFMA32(kf, qf[ks], s); }
  return s;
}
DI void pv_sub(f32x16 (&o)[2], const char* ldsV, int key0, const f32x16& pt, int r32, int h) {
#pragma unroll
  for (int s2 = 0; s2 < 2; ++s2) {
    union { uint4 u; bf16x8 v; } pb;
    pb.u.x = pack2(pt[8 * s2 + 0], pt[8 * s2 + 1]); pb.u.y = pack2(pt[8 * s2 + 2], pt[8 * s2 + 3]);
    pb.u.z = pack2(pt[8 * s2 + 4], pt[8 * s2 + 5]); pb.u.w = pack2(pt[8 * s2 + 6], pt[8 * s2 + 7]);
#pragma unroll
    for (int dt = 0; dt < 2; ++dt) {
      const char* vp = ldsV + (dt * 32 + r32) * 136 + (key0 + 16 * s2 + 4 * h) * 2;
      union { uint4 u; bf16x8 v; } vf;
      const uint2 lo = *(const uint2*)vp, hi = *(const uint2*)(vp + 16);
      vf.u.x = lo.x; vf.u.y = lo.y; vf.u.z = hi.x; vf.u.w = hi.y;
      o[dt] = MFMA32(vf.v, pb.v, o[dt]);
    }
  }
}
#define LOG2E_F 1.4426950408889634f
DI void flash_tile(f32x16 (&O)[2], float& m_run, float& l_run, const char* ldsK, const char* ldsV,
                                          const bf16x8 (&qf)[4], int hi, int lo, int r32, int h) {
  f32x16 s[2];
  s[0] = qk_sub(ldsK, 0, qf, r32, h); s[1] = qk_sub(ldsK, 32, qf, r32, h);
  const bool full = (hi >= 59) && (lo < 0);
  bool rowsel = true;
  if (__builtin_amdgcn_ballot_w64(full) != ~0ull) {
    const bool rowmask = (lo < 0) && (hi >= 59 || hi < 0);
    if (__builtin_amdgcn_ballot_w64(rowmask) == ~0ull) {
      rowsel = hi >= 0;
    } else {
#pragma unroll
      for (int sub = 0; sub < 2; ++sub)
#pragma unroll
        for (int i = 0; i < 16; ++i) {
          const int c = sub * 32 + (i & 3) + 8 * (i >> 2);
          s[sub][i] = (c <= hi && c > lo) ? s[sub][i] : -1e30f;
        }
    }
  }
  float mt = fmaxf(s[0][0], s[1][0]);
#pragma unroll
  for (int i = 1; i < 16; ++i) mt = fmaxf(mt, fmaxf(s[0][i], s[1][i]));
  mt = fmaxf(mt, __shfl_xor(mt, 32));
  mt = rowsel ? mt : -1e30f;
  const float m_new = fmaxf(m_run, mt);
  const float mc = rowsel ? fmaxf(m_new, -1e20f) * LOG2E_F : 1e30f;
  float ls = 0.f;
#pragma unroll
  for (int sub = 0; sub < 2; ++sub)
#pragma unroll
    for (int i = 0; i < 16; ++i) { const float pv = __builtin_amdgcn_exp2f(__builtin_fmaf(s[sub][i], LOG2E_F, -mc)); s[sub][i] = pv; ls += pv; }
  if (__builtin_amdgcn_ballot_w64(m_new != m_run) != 0ull) {
    const float alpha = __builtin_amdgcn_exp2f((m_run - fmaxf(m_new, -1e20f)) * LOG2E_F);
    l_run *= alpha;
#pragma unroll
    for (int dt = 0; dt < 2; ++dt)
#pragma unroll
      for (int i = 0; i < 16; ++i) O[dt][i] *= alpha;
  }
  l_run += ls; m_run = m_new;
  pv_sub(O, ldsV, 0, s[0], r32, h);
  pv_sub(O, ldsV, 32, s[1], r32, h);
}

DI void attn_item(const Params& p, int item, char* smem) {
  const int tid = otid(), lane = tid & 63, w = tid >> 6, r32 = lane & 31, h = lane >> 5;
  const int bg = item & 31, kk = (item >> 5) & 7, rr = (item >> 8) & 3;
  const int qt = (item & 0x10000) ? (31 - ((item >> 5) & 31))
                                  : ((rr == 0) ? (31 - kk) : ((rr == 1) ? (16 + kk) : ((rr == 2) ? (15 - kk) : kk)));
  const int b = bg >> 2, g = bg & 3;
  const int t0 = qt * 64, t = t0 + (w >> 2) * 32 + r32, cur = qt;
  const int hd = g * 4 + (w & 3);
  const long tok = (long)b * 2048 + t;
  char* ws = p.ws;
  u16* Q = (u16*)(ws + OFF_Q);
  float* impA = (float*)(smem + 36864);
  float* impB = (float*)(smem + 70656);
  float* impT = (float*)(smem + 104448);
  unsigned* selm = (unsigned*)(smem + 112896);
  const int lr = tid >> 3, lc = tid & 7;
  const int ldoff = lr * 144 + lc * 16;
  const u16* KS = (const u16*)(ws + OFF_KV) + 2 * KV_ELEMS + (long)bg * 131072;
  const u16* VST = (const u16*)(ws + OFF_KV) + 3 * KV_ELEMS + (long)bg * 131072;
  const u16* KW = (const u16*)(ws + OFF_KV) + 4 * KV_ELEMS + (long)bg * 131072;
  const u16* VWT = (const u16*)(ws + OFF_KV) + 5 * KV_ELEMS + (long)bg * 131072;
  const int jlo = (t0 - 511 > 0) ? ((t0 - 511) >> 6) : 0;
  const int ns = cur + 1, ntile = ns + (cur - jlo + 1);
  u32x4 pkA, pvA, pkB, pvB;
#define ATT_ISSUE(i_, K_, V_) do { const int ii_ = (i_); const bool sl_ = ii_ < ns; const int j_ = sl_ ? ii_ : (jlo + ii_ - ns); \
    K_ = *(const u32x4*)((sl_ ? KS : KW) + (long)j_ * 4096 + lr * 64 + lc * 8); \
    V_ = *(const u32x4*)((sl_ ? VST : VWT) + j_ * 64 + (long)lr * 2048 + lc * 8); } while (0)
  bf16x8 qf[4];
#pragma unroll
  for (int ks = 0; ks < 4; ++ks) {
    u32x4 x = *(const u32x4*)(Q + tok * 1024 + hd * 64 + ks * 16 + h * 8);
#pragma unroll
    for (int e = 0; e < 4; ++e) {
      const float lo = bflo(x[e]) * 0.125f, hi = bfhi(x[e]) * 0.125f;
      x[e] = (__float_as_uint(lo) >> 16) | (__float_as_uint(hi) & 0xffff0000u);
    }
    qf[ks] = __builtin_bit_cast(bf16x8, x);
  }
  const float* NG = (const float*)(ws + OFF_NG) + tok * 48 + hd * 3;
  const float g0 = NG[0], g1 = NG[1], g2 = NG[2];
  f32x16 res[2];
  {
    const u16* KC = (const u16*)(ws + OFF_SM + SM_KC) + (long)bg * 8192;
    const u16* VCT = (const u16*)(ws + OFF_SM + SM_VCT) + (long)bg * 8192;
    const int nsub = ((qt * 4 + 2) >> 5) + 1;
    {
      const u32x4 k0 = *(const u32x4*)(KC + lr * 64 + lc * 8), k1 = *(const u32x4*)(KC + 4096 + lr * 64 + lc * 8);
      const u32x4 v0 = *(const u32x4*)(VCT + lr * 128 + lc * 8), v1 = *(const u32x4*)(VCT + lr * 128 + 64 + lc * 8);
      *(u32x4*)(smem + ldoff) = k0; *(u32x4*)(smem + 18432 + ldoff) = k1;
      { const int vo = lr * 136 + lc * 16;
        uint2 a; a.x = v0[0]; a.y = v0[1]; *(uint2*)(smem + 9216 + vo) = a; a.x = v0[2]; a.y = v0[3]; *(uint2*)(smem + 9216 + vo + 8) = a;
        a.x = v1[0]; a.y = v1[1]; *(uint2*)(smem + 27648 + vo) = a; a.x = v1[2]; a.y = v1[3]; *(uint2*)(smem + 27648 + vo + 8) = a; }
    }
    ATT_ISSUE(0, pkA, pvA);
    ATT_ISSUE(1, pkB, pvB);
    __syncthreads();
    const char* K0 = smem; const char* V0 = smem + 9216; const char* K1 = smem + 18432; const char* V1 = smem + 27648;
    f32x16 sc[4];
    sc[0] = qk_sub(K0, 0, qf, r32, h);
    sc[1] = zero16(); sc[2] = zero16(); sc[3] = zero16();
    if (nsub > 1) sc[1] = qk_sub(K0, 32, qf, r32, h);
    if (nsub > 2) sc[2] = qk_sub(K1, 0, qf, r32, h);
    if (nsub > 3) sc[3] = qk_sub(K1, 32, qf, r32, h);
    float mx = -1e30f;
    const int nlim = ((t - 31) >> 4) - 4 * h;
#pragma unroll
    for (int sub = 0; sub < 4; ++sub)
#pragma unroll
      for (int i = 0; i < 16; ++i) {
        const int c = sub * 32 + (i & 3) + 8 * (i >> 2);
        const float v = (c <= nlim) ? sc[sub][i] : -1e30f;
        sc[sub][i] = v; mx = fmaxf(mx, v);
      }
    mx = fmaxf(mx, __shfl_xor(mx, 32));
    const float mxc = fmaxf(mx, -1e20f) * LOG2E_F;
    float lsum = 0.f;
#pragma unroll
    for (int sub = 0; sub < 4; ++sub)
#pragma unroll
      for (int i = 0; i < 16; ++i) { const float pvv = __builtin_amdgcn_exp2f(__builtin_fmaf(sc[sub][i], LOG2E_F, -mxc)); sc[sub][i] = pvv; lsum += pvv; }
    lsum += __shfl_xor(lsum, 32);
    const float inv = (t >= 31) ? (1.f / lsum) : 0.f;
#pragma unroll
    for (int sub = 0; sub < 4; ++sub)
#pragma unroll
      for (int i = 0; i < 16; ++i) sc[sub][i] *= inv;
    const int qloc = (w >> 2) * 32 + r32, hh4 = w & 3;
#pragma unroll
    for (int sub = 0; sub < 4; ++sub)
#pragma unroll
      for (int g4 = 0; g4 < 4; ++g4) {
        const int mi = 8 * sub + 2 * g4 + h;
        const float p3 = 0.5f * sc[sub][4 * g4 + 3];
        impA[(hh4 * 64 + qloc) * 33 + mi] = sc[sub][4 * g4] + sc[sub][4 * g4 + 1] + sc[sub][4 * g4 + 2] + p3;
        impB[(hh4 * 64 + qloc) * 33 + mi + 1] = p3;
      }
    __syncthreads();
    {
      const int q = tid >> 3, jj = (tid & 7) * 4;
#pragma unroll
      for (int e = 0; e < 4; ++e) {
        const int j = jj + e;
        float tot = 0.f;
#pragma unroll
        for (int ww = 0; ww < 4; ++ww) tot += impA[(ww * 64 + q) * 33 + j];
        if (j > 0) {
#pragma unroll
          for (int ww = 0; ww < 4; ++ww) tot += impB[(ww * 64 + q) * 33 + j];
        }
        impT[q * 33 + j] = tot;
      }
      if (tid < 64) selm[tid] = 0u;
    }
    __syncthreads();
    f32x16 oc[2]; oc[0] = zero16(); oc[1] = zero16();
    pv_sub(oc, V0, 0, sc[0], r32, h);
    if (nsub > 1) pv_sub(oc, V0, 32, sc[1], r32, h);
    if (nsub > 2) pv_sub(oc, V1, 0, sc[2], r32, h);
    if (nsub > 3) pv_sub(oc, V1, 32, sc[3], r32, h);
#pragma unroll
    for (int dt = 0; dt < 2; ++dt)
#pragma unroll
      for (int i = 0; i < 16; ++i) res[dt][i] = g0 * oc[dt][i];
    {
      const int q = tid >> 3, jj = (tid & 7) * 4;
      unsigned bits = 0u;
      for (int e = 0; e < 4; ++e) {
        const int j = jj + e;
        bool sel;
        if (j > cur) sel = false;
        else if (j == 0 || j >= cur - 1) sel = true;
        else if (cur - 2 <= 13) sel = true;
        else {
          const float v = impT[q * 33 + j];
          int rank = 0;
          for (int j2 = 1; j2 <= cur - 2; ++j2) { const float v2 = impT[q * 33 + j2]; rank += ((v2 > v) || (v2 == v && j2 < j)) ? 1 : 0; }
          sel = rank < 13;
        }
        if (sel) bits |= (1u << j);
      }
      atomicOr(&selm[q], bits);
    }
    __syncthreads();
  }
  const unsigned mymask = selm[(w >> 2) * 32 + r32];
  {
    f32x16 O[2]; O[0] = zero16(); O[1] = zero16();
    float m_run = -1e30f, l_run = 0.f;
    auto step = [&](int i, u32x4& pk, u32x4& pv) {
      char* bk = smem + (i & 1) * 18432;
      *(u32x4*)(bk + ldoff) = pk;
      { const int vo = lr * 136 + lc * 16; uint2 a; a.x = pv[0]; a.y = pv[1]; *(uint2*)(bk + 9216 + vo) = a; a.x = pv[2]; a.y = pv[3]; *(uint2*)(bk + 9216 + vo + 8) = a; }
      __syncthreads();
      if (i + 2 < ntile) ATT_ISSUE(i + 2, pk, pv);
      if (i == ns) {
        const float l = l_run + __shfl_xor(l_run, 32);
        const float sc_ = g1 / l;
#pragma unroll
        for (int dt = 0; dt < 2; ++dt)
#pragma unroll
          for (int e = 0; e < 16; ++e) { res[dt][e] += sc_ * O[dt][e]; O[dt][e] = 0.f; }
        m_run = -1e30f; l_run = 0.f;
      }
      const bool sl = i < ns;
      const int j = sl ? i : (jlo + i - ns);
      const int kb = j * 64;
      const int hi = (sl && !((mymask >> j) & 1u)) ? -1 : (t - kb - 4 * h);
      const int lo = sl ? -100000 : (t - 512 - kb - 4 * h);
      flash_tile(O, m_run, l_run, bk, bk + 9216, qf, hi, lo, r32, h);
    };
#pragma unroll 1
    for (int i = 0; i < ntile; i += 2) {
      step(i, pkA, pvA);
      if (i + 1 < ntile) step(i + 1, pkB, pvB);
    }
    const float l = l_run + __shfl_xor(l_run, 32);
    const float sc_ = g2 / l;
#pragma unroll
    for (int dt = 0; dt < 2; ++dt)
#pragma unroll
      for (int e = 0; e < 16; ++e) res[dt][e] += sc_ * O[dt][e];
  }
#undef ATT_ISSUE
#pragma unroll
  for (int dt = 0; dt < 2; ++dt)
#pragma unroll
    for (int kk = 0; kk < 2; ++kk) {
      auto rx = __builtin_amdgcn_permlane32_swap(pack2(res[dt][8 * kk + 0], res[dt][8 * kk + 1]), pack2(res[dt][8 * kk + 4], res[dt][8 * kk + 5]), false, false);
      auto ry = __builtin_amdgcn_permlane32_swap(pack2(res[dt][8 * kk + 2], res[dt][8 * kk + 3]), pack2(res[dt][8 * kk + 6], res[dt][8 * kk + 7]), false, false);
      uint4 o; o.x = rx[0]; o.y = ry[0]; o.z = rx[1]; o.w = ry[1];
      *(uint4*)(Q + tok * 1024 + hd * 64 + dt * 32 + 8 * (2 * kk + h)) = o;
    }
  __syncthreads();
}

DI TileSrc srcE(const Params& p, int step) {
  const int item = step / 6, r = step % 6, k = r >> 1, isv = r & 1;
  const int nt = item & 7, mt = item >> 3;
  const size_t yo = (k == 0) ? OFF_U : ((k == 1) ? OFF_Q : OFF_RG);
  TileSrc t;
  t.A = (const u16*)(p.ws + (isv ? yo : OFF_HB)) + (long)mt * 256 * 1024; t.lda = 1024;
  t.Bt = (const u16*)(p.ws + OFF_W1 + (isv ? W1_WBR : W1_WMG)) + ((long)k * 1024 + nt * 128) * 1024; t.ldb = 1024;
  return t;
}
DI void phaseE_tile(const Params& p, int item, char* smem, Stg& st, bool pre, int nitem, bool hasnxt) {
  const int nt = item & 7, mt = item >> 3;
  const int m0 = mt * 256, n0 = nt * 128;
  char* ws = p.ws;
  f32x4 R[4][4];
  zero_acc<2>(R);
#pragma unroll 1
  for (int k = 0; k < 3; ++k) {
    f32x4 acc[4][4];
    zero_acc<2>(acc);
    gemm512<2, 2>(acc, srcE(p, item * 6 + k * 2), 1024, smem, st, pre || (k > 0), srcE(p, item * 6 + k * 2 + 1), true);
    uint4* gs = (uint4*)(ws + OFF_KV + 25165824) + (size_t)blockIdx.x * 4096 + otid();
#pragma unroll
    for (int a = 0; a < 4; ++a) {
#pragma unroll
      for (int b2 = 0; b2 < 2; ++b2) {
        uint4 v;
        v.x = pack2(sigmoidf_(acc[a][2 * b2][0]), sigmoidf_(acc[a][2 * b2][1]));
        v.y = pack2(sigmoidf_(acc[a][2 * b2][2]), sigmoidf_(acc[a][2 * b2][3]));
        v.z = pack2(sigmoidf_(acc[a][2 * b2 + 1][0]), sigmoidf_(acc[a][2 * b2 + 1][1]));
        v.w = pack2(sigmoidf_(acc[a][2 * b2 + 1][2]), sigmoidf_(acc[a][2 * b2 + 1][3]));
        gs[(a * 2 + b2) * 512] = v;
      }
      __builtin_amdgcn_sched_barrier(0);
    }
    zero_acc<2>(acc);
    {
      const bool last = (k == 2);
      gemm512<2, 2>(acc, srcE(p, item * 6 + k * 2 + 1), 1024, smem, st, true, last ? srcE(p, nitem * 6) : srcE(p, item * 6 + k * 2 + 2), last ? hasnxt : true);
    }
#pragma unroll
    for (int a = 0; a < 4; ++a) {
#pragma unroll
      for (int b2 = 0; b2 < 2; ++b2) {
        const uint4 v = gs[(a * 2 + b2) * 512];
        R[a][2 * b2][0] += bflo(v.x) * acc[a][2 * b2][0]; R[a][2 * b2][1] += bfhi(v.x) * acc[a][2 * b2][1];
        R[a][2 * b2][2] += bflo(v.y) * acc[a][2 * b2][2]; R[a][2 * b2][3] += bfhi(v.y) * acc[a][2 * b2][3];
        R[a][2 * b2 + 1][0] += bflo(v.z) * acc[a][2 * b2 + 1][0]; R[a][2 * b2 + 1][1] += bfhi(v.z) * acc[a][2 * b2 + 1][1];
        R[a][2 * b2 + 1][2] += bflo(v.w) * acc[a][2 * b2 + 1][2]; R[a][2 * b2 + 1][3] += bfhi(v.w) * acc[a][2 * b2 + 1][3];
      }
      __builtin_amdgcn_sched_barrier(0);
    }
  }
  u16* M = (u16*)(ws + OFF_MERGED);
  epi512_rows16<2, 2>(R, m0, n0, M, 1024, 0, [](float v) { return v; });
}

DI TileSrc srcP(const u16* A, long lda, const u16* Bt, long ldb, int item) {
  const int nt = item & 3, mt = item >> 2;
  TileSrc t; t.A = A + (long)mt * 256 * lda; t.lda = lda; t.Bt = Bt + (long)nt * 256 * ldb; t.ldb = ldb;
  return t;
}
DI void gemm_f32out_tile(const u16* A, long lda, const u16* Bt, long ldb, int K, u16* C, int item, char* smem, Stg& st, bool pre, int nitem, bool hasnxt) {
  const int nt = item & 3, mt = item >> 2;
  const int m0 = mt * 256, n0 = nt * 256;
  f32x4 acc[4][8];
  zero_acc<4>(acc);
  gemm512<4, 4>(acc, srcP(A, lda, Bt, ldb, item), K, smem, st, pre, srcP(A, lda, Bt, ldb, nitem), hasnxt);
  epi512<4, 4>(acc, m0, n0, [&](int m, int n, float a, float b, float c, float d) { store4bf(C + (long)m * 1024 + n, a, b, c, d); });
}

DI TileSrc srcH(const Params& p, int item) {
  const int nt = item % 22, mt = item / 22;
  TileSrc t; t.A = (const u16*)(p.ws + OFF_HB) + (long)mt * 256 * 1024; t.lda = 1024; t.Bt = (const u16*)(p.ws + OFF_W2 + W2_WFI) + (long)nt * 256 * 1024; t.ldb = 1024;
  return t;
}
DI void phaseH_tile(const Params& p, int item, char* smem, Stg& st, bool pre, int nitem, bool hasnxt) {
  const int nt = item % 22, mt = item / 22;
  const int m0 = mt * 256, n0 = nt * 256;
  char* ws = p.ws;
  f32x4 acc[4][8];
  zero_acc<4>(acc);
  gemm512<4, 4>(acc, srcH(p, item), 1024, smem, st, pre, srcH(p, nitem), hasnxt);
  u16* ACT = (u16*)(ws + OFF_ACT);
  const int tid = otid(), lane = tid & 63, wid = tid >> 6, wm = wid >> 2, wn = wid & 3, r16 = lane & 15, q = lane >> 4;
#pragma unroll
  for (int mf = 0; mf < 8; ++mf) {
    const int m = m0 + wm * 128 + mf * 16 + r16;
    float o[2][4];
#pragma unroll
    for (int nf = 0; nf < 2; ++nf)
#pragma unroll
      for (int e = 0; e < 4; ++e) { const float gt = acc[nf][mf][e], up = acc[nf + 2][mf][e]; o[nf][e] = gt * sigmoidf_(gt) * up; }
    auto rx = __builtin_amdgcn_permlane16_swap(pack2(o[0][0], o[0][1]), pack2(o[1][0], o[1][1]), false, false);
    auto ry = __builtin_amdgcn_permlane16_swap(pack2(o[0][2], o[0][3]), pack2(o[1][2], o[1][3]), false, false);
    const int j = ((n0 + wn * 64) >> 6) * 32 + (q & 1) * 16 + (q >> 1) * 8;
    uint4 ov; ov.x = rx[0]; ov.y = ry[0]; ov.z = rx[1]; ov.w = ry[1];
    *(uint4*)(ACT + (long)m * 2816 + j) = ov;
    __builtin_amdgcn_sched_barrier(0);
  }
}

DI void phaseH_half_tile(const Params& p, int mt, int n0, char* smem) {
  const int m0 = mt * 256;
  char* ws = p.ws;
  f32x4 acc[4][4];
  zero_acc<2>(acc);
  {
    Stg st;
    TileSrc t; t.A = (const u16*)(ws + OFF_HB) + (long)m0 * 1024; t.lda = 1024; t.Bt = (const u16*)(ws + OFF_W2 + W2_WFI) + (long)n0 * 1024; t.ldb = 1024;
    gemm512<2, 2>(acc, t, 1024, smem, st, false, t, false);
  }
  u16* ACT = (u16*)(ws + OFF_ACT);
  const int tid = otid(), lane = tid & 63, wid = tid >> 6, wm = wid >> 1, wn = wid & 1, r16 = lane & 15, q = lane >> 4;
#pragma unroll
  for (int mf = 0; mf < 4; ++mf) {
    const int m = m0 + wm * 64 + mf * 16 + r16;
    float o[2][4];
#pragma unroll
    for (int nf = 0; nf < 2; ++nf)
#pragma unroll
      for (int e = 0; e < 4; ++e) { const float gt = acc[nf][mf][e], up = acc[nf + 2][mf][e]; o[nf][e] = gt * sigmoidf_(gt) * up; }
    auto rx = __builtin_amdgcn_permlane16_swap(pack2(o[0][0], o[0][1]), pack2(o[1][0], o[1][1]), false, false);
    auto ry = __builtin_amdgcn_permlane16_swap(pack2(o[0][2], o[0][3]), pack2(o[1][2], o[1][3]), false, false);
    const int j = ((n0 + wn * 64) >> 6) * 32 + (q & 1) * 16 + (q >> 1) * 8;
    uint4 ov; ov.x = rx[0]; ov.y = ry[0]; ov.z = rx[1]; ov.w = ry[1];
    *(uint4*)(ACT + (long)m * 2816 + j) = ov;
    __builtin_amdgcn_sched_barrier(0);
  }
}

DI void rowsq_exchange(const f32x4 (&acc)[4][8], float* xch, unsigned* cnt, int mt, int nt, char* smem, float* rsv) {
  const int tid = otid(), lane = tid & 63, wid = tid >> 6, wm = wid >> 2, wn = wid & 3, r16 = lane & 15, q = lane >> 4;
  float* part = (float*)smem;
#pragma unroll
  for (int mf = 0; mf < 8; ++mf) {
    float ss = 0.f;
#pragma unroll
    for (int nf = 0; nf < 4; ++nf) ss += acc[nf][mf][0] * acc[nf][mf][0] + acc[nf][mf][1] * acc[nf][mf][1] + acc[nf][mf][2] * acc[nf][mf][2] + acc[nf][mf][3] * acc[nf][mf][3];
    ss += __shfl_xor(ss, 16); ss += __shfl_xor(ss, 32);
    if (q == 0) part[wn * 256 + wm * 128 + mf * 16 + r16] = ss;
  }
  __syncthreads();
  if (tid < 256) {
    const float P = part[tid] + part[256 + tid] + part[512 + tid] + part[768 + tid];
    __hip_atomic_store(xch + ((long)mt * 4 + nt) * 256 + tid, P, __ATOMIC_RELAXED, __HIP_MEMORY_SCOPE_AGENT);
  }
  asm volatile("s_waitcnt vmcnt(0)" ::: "memory");
  __syncthreads();
  if (tid == 0) {
    __hip_atomic_fetch_add(cnt + mt, 1u, __ATOMIC_RELAXED, __HIP_MEMORY_SCOPE_AGENT);
    while (__hip_atomic_load(cnt + mt, __ATOMIC_RELAXED, __HIP_MEMORY_SCOPE_AGENT) < 4u) __builtin_amdgcn_s_sleep(1);
  }
  __syncthreads();
  if (tid < 256) {
    float S = 0.f;
#pragma unroll
    for (int j = 0; j < 4; ++j) S += __hip_atomic_load(xch + ((long)mt * 4 + j) * 256 + tid, __ATOMIC_RELAXED, __HIP_MEMORY_SCOPE_AGENT);
    rsv[tid] = rsqrtf(S * (1.f / 1024.f) + 1e-6f);
  }
  __syncthreads();
}
DI void fused_norm_tile(const Params& p, const u16* A, long lda, const u16* Bt, long ldb, int K, int use, const float* res_in, float* res_out,
                        const float* g_post, const float* g_next, u16* hnext, bool zero_stats, char* smem) {
  const int bid = blockIdx.x;
  const int mt = (bid & 7) * 8 + ((bid >> 3) & 7), nt = bid >> 6;
  const int m0 = mt * 256, n0 = nt * 256;
  char* ws = p.ws;
  f32x4 acc[4][8];
  zero_acc<4>(acc);
  {
    Stg st;
    const TileSrc src = srcP(A, lda, Bt, ldb, mt * 4 + nt);
    gemm512<4, 4>(acc, src, K, smem, st, false, src, false);
  }
  float* xch = (float*)(ws + OFF_NG);
  unsigned* cnt = (unsigned*)(ws + OFF_SM + SM_BAR) + 16 + use * 128;
  float* rsv = (float*)(smem + 4096);
  const int tid = otid(), lane = tid & 63, wid = tid >> 6, wm = wid >> 2, wn = wid & 3, r16 = lane & 15, q = lane >> 4;
  rowsq_exchange(acc, xch, cnt, mt, nt, smem, rsv);
#pragma unroll
  for (int mf = 0; mf < 8; ++mf) {
    const int ml = wm * 128 + mf * 16 + r16;
    const float rs = rsv[ml];
#pragma unroll
    for (int nf = 0; nf < 4; ++nf) {
      const int n = n0 + wn * 64 + nf * 16 + q * 4;
      const float4 xv = *(const float4*)(res_in + (long)(m0 + ml) * 1024 + n);
      const float4 gv = *(const float4*)(g_post + n);
      acc[nf][mf][0] = xv.x + acc[nf][mf][0] * rs * gv.x; acc[nf][mf][1] = xv.y + acc[nf][mf][1] * rs * gv.y;
      acc[nf][mf][2] = xv.z + acc[nf][mf][2] * rs * gv.z; acc[nf][mf][3] = xv.w + acc[nf][mf][3] * rs * gv.w;
      float4 o; o.x = acc[nf][mf][0]; o.y = acc[nf][mf][1]; o.z = acc[nf][mf][2]; o.w = acc[nf][mf][3];
      *(float4*)(res_out + (long)(m0 + ml) * 1024 + n) = o;
    }
    __builtin_amdgcn_sched_barrier(0);
  }
  if (hnext) {
    __syncthreads();
    rowsq_exchange(acc, xch + 65536, cnt + 64, mt, nt, smem, rsv);
#pragma unroll
    for (int mf = 0; mf < 8; ++mf) {
      const int ml = wm * 128 + mf * 16 + r16;
      const float rs = rsv[ml];
#pragma unroll
      for (int pp = 0; pp < 2; ++pp) {
        const int na = n0 + wn * 64 + 2 * pp * 16 + q * 4;
        const float4 ga = *(const float4*)(g_next + na), gb = *(const float4*)(g_next + na + 16);
        auto rx = __builtin_amdgcn_permlane16_swap(pack2(acc[2 * pp][mf][0] * rs * ga.x, acc[2 * pp][mf][1] * rs * ga.y),
                                                   pack2(acc[2 * pp + 1][mf][0] * rs * gb.x, acc[2 * pp + 1][mf][1] * rs * gb.y), false, false);
        auto ry = __builtin_amdgcn_permlane16_swap(pack2(acc[2 * pp][mf][2] * rs * ga.z, acc[2 * pp][mf][3] * rs * ga.w),
                                                   pack2(acc[2 * pp + 1][mf][2] * rs * gb.z, acc[2 * pp + 1][mf][3] * rs * gb.w), false, false);
        const int n = n0 + wn * 64 + (2 * pp + (q & 1)) * 16 + (q >> 1) * 8;
        uint4 o; o.x = rx[0]; o.y = ry[0]; o.z = rx[1]; o.w = ry[1];
        *(uint4*)(hnext + (long)(m0 + ml) * 1024 + n) = o;
      }
      __builtin_amdgcn_sched_barrier(0);
    }
  }
  if (zero_stats && nt == 0 && tid < 256) {
    unsigned long long* stz = (unsigned long long*)(ws + OFF_SM + SM_STATS) + (long)(m0 + tid) * 2;
    unsigned long long zz = 0ull; asm volatile("" : "+v"(zz));
    stz[0] = zz; stz[1] = zz;
  }
  __syncthreads();
}

#ifndef PHMASK
#define PHMASK 0x3ff
#endif
#define PH_ON(i) ((PHMASK >> (i)) & 1)
DI void run_phase(const Params& p, int ph, char* smem, int csub = 7) {
  const int G = gridDim.x, bid = blockIdx.x;
  char* ws = p.ws;
  int half = ((int)__builtin_amdgcn_workitem_id_x()) >> 8;
  asm volatile("" : "+v"(half));
  half = __builtin_amdgcn_readfirstlane(half);
  char* hsm = smem + half * 65536;
  if (ph == 0) {
    if (!PH_ON(9)) return;
    const int n = 2048 + CONV1_ITEMS / 2;
    for (int it = bid; it < n; it += G) {
      if (it < 2048) row_item(it, p.in[0], nullptr, nullptr, nullptr, p.in[1], (u16*)(ws + OFF_HB), (unsigned long long*)(ws + OFF_SM + SM_STATS));
      else conv1_item(p, 0, (it - 2048) * 2 + half, hsm);
    }
    return;
  }
  const int l = (ph - 1) / 9, sp = (ph - 1) % 9;
  switch (sp) {
    case 0: if (!PH_ON(0)) break; {
      Stg st; bool pre = false;
      if (G == 256) {
        int mt, nt, mt2, nt2;
        xcd_tile(0, 27, mt, nt);
        for (int r = 0; r < 6; ++r) { const bool hn = (r < 5); xcd_tile(r + 1, 27, mt2, nt2); phaseB_tile(p, mt * 27 + nt, smem, st, pre, mt2 * 27 + nt2, hn); pre = hn; mt = mt2; nt = nt2; }
        {
          const int x = bid & 7, lb = bid >> 3, tix = lb >> 1;
          phaseB_half_tile(p, x * 8 + (tix & 7), (24 + (tix >> 3)) * 256 + (lb & 1) * 128, smem);
        }
      } else
      for (int it = bid; it < 64 * 27; it += G) { const bool hn = (it + G < 64 * 27); phaseB_tile(p, it, smem, st, pre, it + G, hn); pre = hn; }
      break;
    }
    case 1: if (!PH_ON(1)) break;
      if (G >= 192) {
        if (bid < 128) { if (csub & 1) rglru_item(p, l, bid * 2 + half, hsm); }
        else if (bid < 160) { if (csub & 2) compress_item(p, bid - 128, smem); }
        else {
          for (int e = bid - 160; e < 64 + 256; e += G - 160) {
            if (e < 64) { if (csub & 4) nsa_item(p, e, smem); }
            else { if (csub & 4) gmlp_item(p, l, (e - 64) * 2 + half, hsm); }
          }
        }
#ifndef NO_CD_MERGE
        if (G == 256) {
          unsigned* cq = (unsigned*)(ws + OFF_SM + SM_BAR) + 600 + l * 2;
          const int tidr = (int)__builtin_amdgcn_workitem_id_x();
          if (bid >= 128) {
            asm volatile("s_waitcnt vmcnt(0)" ::: "memory");
            __syncthreads();
            if (tidr == 0) {
              __builtin_amdgcn_fence(__ATOMIC_RELEASE, "agent");
              const unsigned mine = (bid < 160) ? 1u : (unsigned)(((63 - (bid - 160)) / 96) + 1);
              __hip_atomic_fetch_add(cq + 1, (bid < 160 || bid - 160 < 64) ? mine : 0u, __ATOMIC_RELAXED, __HIP_MEMORY_SCOPE_AGENT);
            }
          }
          unsigned* qslot = (unsigned*)(smem + 114688);
          if (tidr == 0) {
            while (__hip_atomic_load(cq + 1, __ATOMIC_RELAXED, __HIP_MEMORY_SCOPE_AGENT) < 96u) __builtin_amdgcn_s_sleep(2);
            __builtin_amdgcn_fence(__ATOMIC_ACQUIRE, "agent");
          }
          for (;;) {
            __syncthreads();
            if (tidr == 0) *qslot = __hip_atomic_fetch_add(cq, 1u, __ATOMIC_RELAXED, __HIP_MEMORY_SCOPE_AGENT);
            __syncthreads();
            const unsigned idx = *qslot;
            if (idx >= 1024u) break;
            attn_item(p, (int)idx | 0x10000, smem);
          }
        }
#endif
      } else {
        for (int e = bid; e < 128 + 32 + 256; e += G) {
          if (e < 128) { if (csub & 1) rglru_item(p, l, e * 2 + half, hsm); }
          else if (e < 160) { if (csub & 2) compress_item(p, e - 128, smem); }
          else { if (csub & 4) gmlp_item(p, l, (e - 160) * 2 + half, hsm); }
        }
      }
      break;
    case 2: if (!PH_ON(2)) break;
#ifndef NO_CD_MERGE
      if (G == 256) break;
#endif
      for (int it = bid; it < 1024; it += G) attn_item(p, it, smem); break;
    case 3: if (!PH_ON(3)) break;
      {
        Stg st; bool pre = false;
        for (int it = bid; it < 512 + CONV2_TILES / 2; it += G) {
          if (it < 512) {
            const bool hn = (it + G < 512);
            int e0 = it, e1 = it + G;
            if (G == 256) { const int x = bid & 7, lb = bid >> 3; const int t0_ = (it >> 8) * 32 + lb, t1_ = t0_ + 32; e0 = (x * 8 + (t0_ & 7)) * 8 + (t0_ >> 3); e1 = (x * 8 + (t1_ & 7)) * 8 + (t1_ >> 3); }
            phaseE_tile(p, e0, smem, st, pre, e1, hn); pre = hn;
          }
          else conv2_item(p, l, (it - 512) * 2 + half, hsm);
        }
      }
      break;
    case 4: if (!PH_ON(4)) break;
      if (G == 256) {
        fused_norm_tile(p, (const u16*)(ws + OFF_MERGED), 1024, (const u16*)(ws + OFF_W2 + W2_WO), 1024, 1024, l * 2 + 0,
                        (l == 0) ? p.in[0] : p.out, p.out, p.in[2] + l * 1024, p.in[3] + l * 1024, (u16*)(ws + OFF_HB), false, smem);
      } else
      {
        Stg st; bool pre = false;
        for (int it = bid; it < 256; it += G) { const bool hn = (it + G < 256);
          const int e0 = (G == 256) ? (((bid & 7) * 8 + ((bid >> 3) & 7)) * 4 + (bid >> 6)) : it;
          gemm_f32out_tile((const u16*)(ws + OFF_MERGED), 1024, (const u16*)(ws + OFF_W2 + W2_WO), 1024, 1024, (u16*)(ws + OFF_TBUF), e0, smem, st, pre, it + G, hn); pre = hn; }
      }
      break;
    case 5: if (!PH_ON(5)) break;
      for (int it = bid; it < 2048; it += G)
        row_item(it, (l == 0) ? p.in[0] : p.out, (const u16*)(ws + OFF_TBUF), p.in[2] + l * 1024, p.out, p.in[3] + l * 1024, (u16*)(ws + OFF_HB), nullptr);
      break;
    case 6: if (!PH_ON(6)) break; {
      Stg st; bool pre = false;
      if (G == 256) {
        int mt, nt, mt2, nt2;
        xcd_tile(0, 22, mt, nt);
        for (int r = 0; r < 5; ++r) { const bool hn = (r < 4); xcd_tile(r + 1, 22, mt2, nt2); phaseH_tile(p, mt * 22 + nt, smem, st, pre, mt2 * 22 + nt2, hn); pre = hn; mt = mt2; nt = nt2; }
        {
          const int x = bid & 7, lb = bid >> 3, tix = lb >> 1;
          phaseH_half_tile(p, x * 8 + (tix & 7), (20 + (tix >> 3)) * 256 + (lb & 1) * 128, smem);
        }
      } else
      for (int it = bid; it < 64 * 22; it += G) { const bool hn = (it + G < 64 * 22); phaseH_tile(p, it, smem, st, pre, it + G, hn); pre = hn; }
      break;
    }
    case 7: if (!PH_ON(7)) break;
      if (G == 256) {
        const bool nxt = (l + 1 < 2);
        fused_norm_tile(p, (const u16*)(ws + OFF_ACT), 2816, (const u16*)(ws + OFF_W2 + W2_WFO), 2816, 2816, l * 2 + 1,
                        p.out, p.out, p.in[4] + l * 1024, nxt ? (p.in[1] + (l + 1) * 1024) : nullptr, nxt ? (u16*)(ws + OFF_HB) : nullptr, nxt, smem);
        if (nxt) for (int it = bid; it < CONV1_ITEMS / 2; it += G) conv1_item(p, l + 1, it * 2 + half, hsm);
      } else
      {
        Stg st; bool pre = false;
        for (int it = bid; it < 256; it += G) { const bool hn = (it + G < 256);
          const int e0 = (G == 256) ? (((bid & 7) * 8 + ((bid >> 3) & 7)) * 4 + (bid >> 6)) : it;
          gemm_f32out_tile((const u16*)(ws + OFF_ACT), 2816, (const u16*)(ws + OFF_W2 + W2_WFO), 2816, 2816, (u16*)(ws + OFF_TBUF), e0, smem, st, pre, it + G, hn); pre = hn; }
      }
      break;
    case 8: if (!PH_ON(8)) break; {
      const bool nxt = (l + 1 < 2);
      const int n = 2048 + (nxt ? CONV1_ITEMS / 2 : 0);
      for (int it = bid; it < n; it += G) {
        if (it < 2048) row_item(it, p.out, (const u16*)(ws + OFF_TBUF), p.in[4] + l * 1024, p.out, nxt ? (p.in[1] + (l + 1) * 1024) : nullptr, nxt ? (u16*)(ws + OFF_HB) : nullptr, (unsigned long long*)(ws + OFF_SM + SM_STATS));
        else conv1_item(p, l + 1, (it - 2048) * 2 + half, hsm);
      }
      break;
    }
  }
}

constexpr int N_PHASES = 19;

__global__ void __launch_bounds__(NTHR, 2) mega_kernel(Params p, int ph0, int ph1) {
  extern __shared__ __attribute__((aligned(16))) char smem[];
  cg::grid_group grid = cg::this_grid();
#ifdef TIMER_MASK
  unsigned long long tacc = 0, tprev = wall_clock64();
#endif
  unsigned* gbar = (unsigned*)(p.ws + OFF_SM + SM_BAR);
  if (blockIdx.x == 0) { __hip_atomic_store(gbar + threadIdx.x, 0u, __ATOMIC_RELAXED, __HIP_MEMORY_SCOPE_AGENT); __hip_atomic_store(gbar + 512 + threadIdx.x, 0u, __ATOMIC_RELAXED, __HIP_MEMORY_SCOPE_AGENT); }
  const bool fused_rows = (gridDim.x == 256);
  unsigned nbar = 0;
  for (int ph = ph0; ph < ph1; ++ph) {
    if (fused_rows && ph >= 1) { const int kd = (ph - 1) % 9; if (kd == 5 || kd == 8) continue;
#ifndef NO_CD_MERGE
      if (kd == 2) continue;
#endif
    }
#ifdef CSUB
    if (ph >= 1 && ((ph - 1) % 9) == 1) {
      for (int c = 1; c <= 4; c <<= 1) {
        run_phase(p, ph, smem, c);
        grid.sync();
        const unsigned long long tn = wall_clock64(); if (c == CSUB) tacc += tn - tprev; tprev = tn;
      }
      continue;
    }
#endif
    run_phase(p, ph, smem);
#ifdef TIMER_MASK
    grid.sync();
    { const unsigned long long tn = wall_clock64(); const int kind = (ph == 0) ? 9 : ((ph - 1) % 9); if ((TIMER_MASK >> kind) & 1) tacc += tn - tprev; tprev = tn; }
#else
    if (ph + 1 < ph1) {
      if (ph == ph0) grid.sync();
      else {
        asm volatile("s_waitcnt vmcnt(0)" ::: "memory");
        __syncthreads();
        ++nbar;
        if (threadIdx.x == 0) {
          __builtin_amdgcn_fence(__ATOMIC_RELEASE, "agent");
          __hip_atomic_fetch_add(gbar, 1u, __ATOMIC_RELAXED, __HIP_MEMORY_SCOPE_AGENT);
          const unsigned target = nbar * gridDim.x;
          while (__hip_atomic_load(gbar, __ATOMIC_RELAXED, __HIP_MEMORY_SCOPE_AGENT) < target) __builtin_amdgcn_s_sleep(2);
          __builtin_amdgcn_fence(__ATOMIC_ACQUIRE, "agent");
        }
        __syncthreads();
      }
    }
#endif
  }
#ifdef TIMER_MASK
  if (blockIdx.x == 0 && threadIdx.x == 0) p.out[0] += (float)tacc * 0.001f;
#endif
}

extern "C" void kernel_launch(void* const* d_in, const int* in_sizes, int n_in, void* d_out, int out_size, void* d_ws, size_t ws_size,
                              hipStream_t stream) {
  static int grid_blocks = 0;
  if (!grid_blocks) {
    int dev = 0, cus = 0, per_cu = 0;
    (void)hipGetDevice(&dev);
    (void)hipDeviceGetAttribute(&cus, hipDeviceAttributeMultiprocessorCount, dev);
    (void)hipFuncSetAttribute((const void*)mega_kernel, hipFuncAttributeMaxDynamicSharedMemorySize, LDS_BYTES);
    (void)hipOccupancyMaxActiveBlocksPerMultiprocessor(&per_cu, mega_kernel, NTHR, LDS_BYTES);
    if (per_cu < 1) per_cu = 1;
    if (per_cu > 1) per_cu = 1;
    grid_blocks = cus * per_cu;
    if (ws_size < WS_NEED) fprintf(stderr, "kernel_launch: workspace too small: %zu < %zu\n", ws_size, (size_t)WS_NEED);
  }
  Params p{};
  for (int i = 0; i < 29; ++i) p.in[i] = (const float*)d_in[i];
  p.out = (float*)d_out;
  p.ws = (char*)d_ws;
#if MK_MULTI
  for (int ph = 0; ph < N_PHASES; ++ph) {
    hipLaunchKernelGGL(mega_kernel, dim3(grid_blocks), dim3(NTHR), LDS_BYTES, stream, p, ph, ph + 1);
  }
#else
  int ph0 = 0, ph1 = N_PHASES;
  void* args[] = {&p, &ph0, &ph1};
  hipError_t e = hipLaunchCooperativeKernel((void*)mega_kernel, dim3(grid_blocks), dim3(NTHR), args, LDS_BYTES, stream);
  if (e != hipSuccess) fprintf(stderr, "cooperative launch failed: %s (grid %d)\n", hipGetErrorString(e), grid_blocks);
#endif
}
```

```cpp
#include <hip/hip_runtime.h>
#include <hip/hip_cooperative_groups.h>
#include <cstdio>
namespace cg = cooperative_groups;

#ifndef MK_MULTI
#define MK_MULTI 0
#endif

typedef unsigned short u16;
using bf16x8 = __attribute__((ext_vector_type(8))) short;
using f32x16 = __attribute__((ext_vector_type(16))) float;
using u32x4 = __attribute__((ext_vector_type(4))) unsigned;
using f32x4 = __attribute__((ext_vector_type(4))) float;
#define MFMA16(a, b, c) __builtin_amdgcn_mfma_f32_16x16x32_bf16((a), (b), (c), 0, 0, 0)
#define DI __device__ __forceinline__
#define MFMA32(a, b, c) __builtin_amdgcn_mfma_f32_32x32x16_bf16((a), (b), (c), 0, 0, 0)

constexpr int T_ = 16384;
constexpr int NTHR = 512;
constexpr int LDS_BYTES = 131072;

constexpr size_t SZ32 = 33554432;
constexpr size_t OFF_HB = 0;
constexpr size_t OFF_U = 1 * SZ32;
constexpr size_t OFF_GV = 2 * SZ32;
constexpr size_t OFF_Q = 3 * SZ32;
constexpr size_t OFF_XR = 4 * SZ32;
constexpr size_t OFF_RG = 5 * SZ32;
constexpr size_t OFF_KV = 6 * SZ32;
constexpr size_t KV_ELEMS = 4194304;
constexpr size_t OFF_NG = OFF_KV + 50331648;
constexpr size_t OFF_SM = OFF_NG + 3145728;
constexpr size_t SM_KC = 0, SM_VCT = 524288, SM_CKV = 1048576, SM_WSB = 1050624, SM_HID = 1310720, SM_STATS = 5505024, SM_BAR = 5767168;
constexpr size_t OFF_W1 = OFF_SM + 6291456;
constexpr size_t W1_WIN = 0, W1_WMG = 14155776, W1_WBR = W1_WMG + 6291456, W1_WK1 = W1_WBR + 6291456, W1_WV1 = W1_WK1 + 1048576, W1_WK2 = W1_WV1 + 1048576, W1_WV2 = W1_WK2 + 32768, W1_WNS = W1_WV2 + 32768;
constexpr size_t WS_NEED = OFF_W1 + W1_WNS + 131072;
constexpr size_t OFF_TBUF = OFF_XR;
constexpr size_t OFF_W2 = OFF_KV;
constexpr size_t W2_WO = 0, W2_WFI = 2097152, W2_WFO = 13631488;
constexpr size_t OFF_ACT = OFF_U;
constexpr size_t OFF_MERGED = OFF_GV;

struct Params { const float* in[29]; float* out; char* ws; };

DI int otid() { int t = (int)__builtin_amdgcn_workitem_id_x(); asm volatile("" : "+v"(t)); return t; }
DI int htid() { int t = (int)__builtin_amdgcn_workitem_id_x() & 255; asm volatile("" : "+v"(t)); return t; }

DI float bf2f(u16 b) { return __uint_as_float(((unsigned)b) << 16); }
typedef __bf16 bf2_t __attribute__((ext_vector_type(2)));
typedef float f2_t __attribute__((ext_vector_type(2)));
DI unsigned pack2(float a, float b) { f2_t v; v.x = a; v.y = b; return __builtin_bit_cast(unsigned, __builtin_convertvector(v, bf2_t)); }
DI u16 f2bf(float x) { return (u16)(pack2(x, 0.f) & 0xffffu); }
DI float bflo(unsigned w) { return __uint_as_float(w << 16); }
DI float bfhi(unsigned w) { return __uint_as_float(w & 0xffff0000u); }
DI float rcpf(float x) { return __builtin_amdgcn_rcpf(x); }
DI float sigmoidf_(float x) { return rcpf(1.f + __expf(-x)); }
DI float geluf_(float x) { float y = 1.5957691216f * (x + 0.044715f * x * x * x); return x * rcpf(1.f + __expf(-y)); }
DI float wave_sum(float v) {
#pragma unroll
  for (int o = 32; o >= 1; o >>= 1) v += __shfl_xor(v, o);
  return v;
}
DI float lane_swap1(float v) { const int u = (int)__float_as_uint(v); return __uint_as_float((unsigned)__builtin_amdgcn_update_dpp(u, u, 0xB1, 0xF, 0xF, false)); }
DI unsigned lane_swap2u(unsigned v) { return (unsigned)__builtin_amdgcn_update_dpp((int)v, (int)v, 0x4E, 0xF, 0xF, false); }
DI uint2 quad_transpose_pack(float a, float b, float c, float d, int k) {
  const int odd = k & 1, hi2 = k >> 1;
  const float r0 = lane_swap1(odd ? a : b), r1 = lane_swap1(odd ? c : d);
  const unsigned W0 = odd ? pack2(r0, b) : pack2(a, r0);
  const unsigned W1 = odd ? pack2(r1, d) : pack2(c, r1);
  const unsigned rcv = lane_swap2u(hi2 ? W0 : W1);
  uint2 o; o.x = hi2 ? rcv : W0; o.y = hi2 ? W1 : rcv;
  return o;
}
DI f32x16 zero16() { f32x16 v;
#pragma unroll
  for (int i = 0; i < 16; ++i) v[i] = 0.f;
  return v; }
DI void store4bf(u16* p, float a, float b, float c, float d) { uint2 v; v.x = pack2(a, b); v.y = pack2(c, d); *(uint2*)p = v; }

struct TileSrc { const u16* A; long lda; const u16* Bt; long ldb; };
struct Stg { u32x4 a0, a1, a2, a3, b0, b1, b2, b3; };
template <int MI, int WN> DI void gemm512(f32x4 (&acc)[4][2 * MI], const TileSrc cur, int K, char* smem, Stg& st, bool pre, const TileSrc nxt, bool hasnxt) {
  const int tid = otid(), lane = tid & 63, wid = tid >> 6;
  const int wm = wid / WN, wn = wid % WN;
  const int r16 = lane & 15, q = lane >> 4;
  const int lr = tid >> 3, lc = tid & 7;
  const int soff = lr * 128 + ((lc ^ ((lr >> 1) & 7)) << 4);
  const u16* ga = cur.A + (long)lr * cur.lda + lc * 8;
  const u16* gb = cur.Bt + (long)lr * cur.ldb + lc * 8;
  long a64 = 64 * cur.lda, b64 = 64 * cur.ldb;
  const int nk = K >> 6;
#define G512_LOAD() do { st.a0 = *(const u32x4*)(ga); st.a1 = *(const u32x4*)(ga + a64); st.a2 = *(const u32x4*)(ga + 2 * a64); st.a3 = *(const u32x4*)(ga + 3 * a64); \
    st.b0 = *(const u32x4*)(gb); if (WN > 1) st.b1 = *(const u32x4*)(gb + b64); if (WN > 2) { st.b2 = *(const u32x4*)(gb + 2 * b64); st.b3 = *(const u32x4*)(gb + 3 * b64); } } while (0)
#define G512_STORE(d) do { *(u32x4*)((d) + soff) = st.a0; *(u32x4*)((d) + soff + 8192) = st.a1; *(u32x4*)((d) + soff + 16384) = st.a2; *(u32x4*)((d) + soff + 24576) = st.a3; \
    *(u32x4*)((d) + 32768 + soff) = st.b0; if (WN > 1) *(u32x4*)((d) + 32768 + soff + 8192) = st.b1; if (WN > 2) { *(u32x4*)((d) + 32768 + soff + 16384) = st.b2; *(u32x4*)((d) + 32768 + soff + 24576) = st.b3; } } while (0)
  if (!pre) G512_LOAD();
  G512_STORE(smem);
  ga += 64; gb += 64;
  G512_LOAD();
  const int sw = r16 >> 1;
  for (int kt = 0; kt < nk; ++kt) {
    __syncthreads();
    if (kt + 1 < nk) {
      char* d = smem + ((kt + 1) & 1) * 65536;
      G512_STORE(d);
      if (kt + 2 < nk) { ga += 64; gb += 64; G512_LOAD(); }
      else if (hasnxt) {
        ga = nxt.A + (long)lr * nxt.lda + lc * 8; gb = nxt.Bt + (long)lr * nxt.ldb + lc * 8; a64 = 64 * nxt.lda; b64 = 64 * nxt.ldb;
        G512_LOAD();
      }
    }
    const char* sa = smem + (kt & 1) * 65536;
    const char* sb = sa + 32768;
#pragma unroll
    for (int ks = 0; ks < 2; ++ks) {
      bf16x8 fa[4];
      const int coff = ((ks * 4 + q) ^ sw) << 4;
#pragma unroll
      for (int nf = 0; nf < 4; ++nf) fa[nf] = *(const bf16x8*)(sb + (wn * 64 + nf * 16 + r16) * 128 + coff);
      constexpr int MG = (MI >= 2) ? 4 : 2;
      for (int mh = 0; mh < (2 * MI) / MG; ++mh) {
        bf16x8 fb[MG];
#pragma unroll
        for (int mf = 0; mf < MG; ++mf) fb[mf] = *(const bf16x8*)(sa + (wm * (MI * 32) + (mh * MG + mf) * 16 + r16) * 128 + coff);
#pragma unroll
        for (int nf = 0; nf < 4; ++nf)
#pragma unroll
          for (int mf = 0; mf < MG; ++mf) acc[nf][mh * MG + mf] = MFMA16(fa[nf], fb[mf], acc[nf][mh * MG + mf]);
      }
    }
  }
  if (nk & 1) __syncthreads();
#undef G512_LOAD
#undef G512_STORE
}
template <int MI, int WN, class F> DI void epi512(const f32x4 (&acc)[4][2 * MI], int m0, int n0, F f) {
  const int tid = otid(), lane = tid & 63, wid = tid >> 6, wm = wid / WN, wn = wid % WN, r16 = lane & 15, q = lane >> 4;
#pragma unroll
  for (int nf = 0; nf < 4; ++nf) {
#pragma unroll
    for (int mf = 0; mf < 2 * MI; ++mf) {
      const int m = m0 + wm * (MI * 32) + mf * 16 + r16;
      const int n = n0 + wn * 64 + nf * 16 + q * 4;
      f(m, n, acc[nf][mf][0], acc[nf][mf][1], acc[nf][mf][2], acc[nf][mf][3]);
      __builtin_amdgcn_sched_barrier(0);
    }
  }
}
template <int MI, int WN, class TF> DI void epi512_rows16(const f32x4 (&acc)[4][2 * MI], int m0, int n0, u16* dst, long ld, int coladj, TF tf) {
  const int tid = otid(), lane = tid & 63, wid = tid >> 6, wm = wid / WN, wn = wid % WN, r16 = lane & 15, q = lane >> 4;
#pragma unroll
  for (int mf = 0; mf < 2 * MI; ++mf) {
    const int m = m0 + wm * (MI * 32) + mf * 16 + r16;
#pragma unroll
    for (int pp = 0; pp < 2; ++pp) {
      const unsigned ax = pack2(tf(acc[2 * pp][mf][0]), tf(acc[2 * pp][mf][1])), ay = pack2(tf(acc[2 * pp][mf][2]), tf(acc[2 * pp][mf][3]));
      const unsigned bx = pack2(tf(acc[2 * pp + 1][mf][0]), tf(acc[2 * pp + 1][mf][1])), by = pack2(tf(acc[2 * pp + 1][mf][2]), tf(acc[2 * pp + 1][mf][3]));
      auto rx = __builtin_amdgcn_permlane16_swap(ax, bx, false, false);
      auto ry = __builtin_amdgcn_permlane16_swap(ay, by, false, false);
      const int n = n0 + wn * 64 + (2 * pp + (q & 1)) * 16 + (q >> 1) * 8;
      uint4 o; o.x = rx[0]; o.y = ry[0]; o.z = rx[1]; o.w = ry[1];
      *(uint4*)(dst + (long)m * ld + n + coladj) = o;
    }
    __builtin_amdgcn_sched_barrier(0);
  }
}
template <int MI, int WN, class AF> DI void epi512_rows16_at(const f32x4 (&acc)[4][2 * MI], int m0, int n0, AF af) {
  const int tid = otid(), lane = tid & 63, wid = tid >> 6, wm = wid / WN, wn = wid % WN, r16 = lane & 15, q = lane >> 4;
#pragma unroll
  for (int mf = 0; mf < 2 * MI; ++mf) {
    const int m = m0 + wm * (MI * 32) + mf * 16 + r16;
#pragma unroll
    for (int pp = 0; pp < 2; ++pp) {
      auto rx = __builtin_amdgcn_permlane16_swap(pack2(acc[2 * pp][mf][0], acc[2 * pp][mf][1]), pack2(acc[2 * pp + 1][mf][0], acc[2 * pp + 1][mf][1]), false, false);
      auto ry = __builtin_amdgcn_permlane16_swap(pack2(acc[2 * pp][mf][2], acc[2 * pp][mf][3]), pack2(acc[2 * pp + 1][mf][2], acc[2 * pp + 1][mf][3]), false, false);
      const int n = n0 + wn * 64 + (2 * pp + (q & 1)) * 16 + (q >> 1) * 8;
      uint4 o; o.x = rx[0]; o.y = ry[0]; o.z = rx[1]; o.w = ry[1];
      *(uint4*)af(m, n) = o;
    }
    __builtin_amdgcn_sched_barrier(0);
  }
}
template <int MI> DI void zero_acc(f32x4 (&acc)[4][2 * MI]) {
#pragma unroll
  for (int a = 0; a < 4; ++a)
#pragma unroll
    for (int b = 0; b < 2 * MI; ++b) { acc[a][b][0] = 0.f; acc[a][b][1] = 0.f; acc[a][b][2] = 0.f; acc[a][b][3] = 0.f; }
}

template <int NI> DI void gemm_h(f32x16 (&acc)[NI][2], const u16* __restrict__ A, long lda, const u16* __restrict__ Bt, long ldb, int K, char* smem) {
  const int tid = htid(), lane = tid & 63, wid = tid >> 6;
  const int wm = wid >> 1, wn = wid & 1;
  const int r32 = lane & 31, h = lane >> 5;
  const int lr = tid >> 3, lc = tid & 7;
  const u16* ga = A + (long)lr * lda + lc * 8;
  const u16* gb = Bt + (long)lr * ldb + lc * 8;
  const int soff = lr * 128 + ((lc ^ ((lr & 7) ^ ((lr >> 3) & 1))) << 4);
  uint4 ra[4], rb[2 * NI];
  const int nk = K >> 6;
#pragma unroll
  for (int i = 0; i < 4; ++i) ra[i] = *(const uint4*)(ga + (long)(32 * i) * lda);
#pragma unroll
  for (int i = 0; i < 2 * NI; ++i) rb[i] = *(const uint4*)(gb + (long)(32 * i) * ldb);
#pragma unroll
  for (int i = 0; i < 4; ++i) *(uint4*)(smem + soff + i * 4096) = ra[i];
#pragma unroll
  for (int i = 0; i < 2 * NI; ++i) *(uint4*)(smem + 16384 + soff + i * 4096) = rb[i];
  __syncthreads();
  const int sw = (r32 & 7) ^ ((r32 >> 3) & 1);
  for (int kt = 0; kt < nk; ++kt) {
    const bool more = (kt + 1 < nk);
    if (more) {
      ga += 64; gb += 64;
#pragma unroll
      for (int i = 0; i < 4; ++i) ra[i] = *(const uint4*)(ga + (long)(32 * i) * lda);
#pragma unroll
      for (int i = 0; i < 2 * NI; ++i) rb[i] = *(const uint4*)(gb + (long)(32 * i) * ldb);
    }
    const char* sa = smem + (kt & 1) * 32768;
    const char* sb = sa + 16384;
#pragma unroll
    for (int ks = 0; ks < 4; ++ks) {
      bf16x8 fa[NI], fb[2];
      const int coff = ((ks * 2 + h) ^ sw) << 4;
#pragma unroll
      for (int ni = 0; ni < NI; ++ni) fa[ni] = *(const bf16x8*)(sb + (wn * (32 * NI) + ni * 32 + r32) * 128 + coff);
#pragma unroll
      for (int mi = 0; mi < 2; ++mi) fb[mi] = *(const bf16x8*)(sa + (wm * 64 + mi * 32 + r32) * 128 + coff);
#pragma unroll
      for (int ni = 0; ni < NI; ++ni)
#pragma unroll
        for (int mi = 0; mi < 2; ++mi) acc[ni][mi] = MFMA32(fa[ni], fb[mi], acc[ni][mi]);
    }
    if (more) {
      char* d = smem + ((kt + 1) & 1) * 32768;
#pragma unroll
      for (int i = 0; i < 4; ++i) *(uint4*)(d + soff + i * 4096) = ra[i];
#pragma unroll
      for (int i = 0; i < 2 * NI; ++i) *(uint4*)(d + 16384 + soff + i * 4096) = rb[i];
    }
    __syncthreads();
  }
}

template <int NI, class F> DI void epi_h(const f32x16 (&acc)[NI][2], int m0, int n0, F f) {
  const int lane = htid() & 63, wid = htid() >> 6, wm = wid >> 1, wn = wid & 1, r32 = lane & 31, h = lane >> 5;
#pragma unroll
  for (int ni = 0; ni < NI; ++ni)
#pragma unroll
    for (int mi = 0; mi < 2; ++mi) {
      const int m = m0 + wm * 64 + mi * 32 + r32;
#pragma unroll
      for (int g4 = 0; g4 < 4; ++g4) {
        const int n = n0 + wn * (32 * NI) + ni * 32 + 8 * g4 + 4 * h;
        f(m, n, acc[ni][mi][4 * g4 + 0], acc[ni][mi][4 * g4 + 1], acc[ni][mi][4 * g4 + 2], acc[ni][mi][4 * g4 + 3]);
      }
    }
}

DI int srccol(int mode, int param, int n) {
  if (mode == 0) return n + param;
  if (mode == 1) { if (n < 4608) return n; if (n < 6656) return n + 48; if (n < 6704) return n - 2048; return -1; }
  if (mode == 3) return (n < 48) ? (4608 + n) : -1;
  const int blk = n >> 6, w = n & 63;
  return (w < 32) ? (blk * 32 + w) : (2816 + blk * 32 + (w - 32));
}
DI void conv_tile(const float* __restrict__ src, int lds_, u16* __restrict__ dst, int K, int mode, int param, int tile, char* smem) {
  const int tid = htid();
  const int ntk = K >> 6;
  const int k0 = (tile % ntk) * 64, n0 = (tile / ntk) * 64;
  float* tl = (float*)smem;
  {
    const int c = tid & 63, i0 = tid >> 6;
    const int sc = srccol(mode, param, n0 + c);
#pragma unroll
    for (int j = 0; j < 16; ++j) { const int k = i0 + 4 * j; tl[k * 65 + c] = (sc >= 0) ? src[(long)(k0 + k) * lds_ + sc] : 0.f; }
  }
  __syncthreads();
#pragma unroll
  for (int jj = 0; jj < 2; ++jj) {
    const int nl = (tid >> 3) + 32 * jj, kc = tid & 7;
    float v[8];
#pragma unroll
    for (int e = 0; e < 8; ++e) v[e] = tl[(kc * 8 + e) * 65 + nl];
    uint4 o; o.x = pack2(v[0], v[1]); o.y = pack2(v[2], v[3]); o.z = pack2(v[4], v[5]); o.w = pack2(v[6], v[7]);
    *(uint4*)(dst + (long)(n0 + nl) * K + k0 + kc * 8) = o;
  }
  __syncthreads();
}

constexpr int CONV1_TILES = 1728 + 768 + 768 + 256 + 8 + 16;
constexpr int CONV1_ITEMS = CONV1_TILES + 8 + 32;
DI void conv1_item(const Params& p, int l, int t, char* smem) {
  char* w1 = p.ws + OFF_W1;
  const int tid = htid();
  if (t < CONV1_TILES) {
    const float* win = p.in[5] + (long)l * 1024 * 9776;
    if (t < 1728) { conv_tile(win, 9776, (u16*)(w1 + W1_WIN), 1024, 1, 0, t, smem); return; }
    t -= 1728;
    if (t < 768) { conv_tile(win, 9776, (u16*)(w1 + W1_WMG), 1024, 0, 6704, t, smem); return; }
    t -= 768;
    if (t < 768) { const int k = t >> 8; conv_tile(p.in[23 + k] + (long)l * 1048576, 1024, (u16*)(w1 + W1_WBR) + (long)k * 1048576, 1024, 0, 0, t & 255, smem); return; }
    t -= 768;
    if (t < 256) { const int kv = t >> 7; conv_tile(p.in[kv ? 14 : 12] + (long)l * 524288, 256, (u16*)(w1 + (kv ? W1_WV1 : W1_WK1)), 2048, 0, 0, t & 127, smem); return; }
    t -= 256;
    if (t < 8) { const int kv = t >> 2; conv_tile(p.in[kv ? 15 : 13] + (long)l * 16384, 64, (u16*)(w1 + (kv ? W1_WV2 : W1_WK2)), 256, 0, 0, t & 3, smem); return; }
    t -= 8;
    { conv_tile(win, 9776, (u16*)(w1 + W1_WNS), 1024, 3, 0, t, smem); return; }
  }
  t -= CONV1_TILES;
  if (t < 8) {
    const int kv = t >> 2, jg = t & 3;
    const float* pe = p.in[10 + kv] + (long)l * 2048;
    const float* w = p.in[kv ? 14 : 12] + (long)l * 524288;
    const int j = jg * 64 + (tid & 63), ksl = tid >> 6;
    float s = 0.f;
    for (int kk = ksl * 512; kk < ksl * 512 + 512; kk += 16) {
      float wv[16];
#pragma unroll
      for (int u = 0; u < 16; ++u) wv[u] = w[(long)(kk + u) * 256 + j];
#pragma unroll
      for (int u = 0; u < 16; ++u) s += pe[kk + u] * wv[u];
    }
    float* red = (float*)smem;
    red[tid] = s;
    __syncthreads();
    if (tid < 64) { float r = red[tid] + red[tid + 64] + red[tid + 128] + red[tid + 192]; ((float*)(p.ws + OFF_SM + SM_CKV))[kv * 256 + jg * 64 + tid] = r; }
    __syncthreads();
    return;
  }
  t -= 8;
  {
    const float* wsrc = p.in[8] + (long)l * 65536;
    u16* dst = (u16*)(p.ws + OFF_SM + SM_WSB);
    const int e0 = t * 2048 + tid * 8;
    const int tt = (e0 >> 7) & 127, s0 = e0 & 127;
    float v[8];
#pragma unroll
    for (int e = 0; e < 8; ++e) v[e] = (s0 + e <= tt) ? wsrc[e0 + e] : 0.f;
    uint4 o; o.x = pack2(v[0], v[1]); o.y = pack2(v[2], v[3]); o.z = pack2(v[4], v[5]); o.w = pack2(v[6], v[7]);
    *(uint4*)(dst + e0) = o;
  }
}
constexpr int CONV2_TILES = 256 + 1408 + 704;
DI void conv2_item(const Params& p, int l, int t, char* smem) {
  char* w2 = p.ws + OFF_W2;
  if (t < 256) { conv_tile(p.in[26] + (long)l * 1048576, 1024, (u16*)(w2 + W2_WO), 1024, 0, 0, t, smem); return; }
  t -= 256;
  if (t < 1408) { conv_tile(p.in[27] + (long)l * 1024 * 5632, 5632, (u16*)(w2 + W2_WFI), 1024, 2, 0, t, smem); return; }
  t -= 1408;
  conv_tile(p.in[28] + (long)l * 2816 * 1024, 1024, (u16*)(w2 + W2_WFO), 2816, 0, 0, t, smem);
}

DI void row_item(int item, const float* __restrict__ res_in, const u16* __restrict__ delta, const float* __restrict__ g_post,
                 float* __restrict__ res_out, const float* __restrict__ g_next, u16* __restrict__ hnext, unsigned long long* __restrict__ stats) {
  const int lane = otid() & 63;
  const long row = (long)item * 8 + (otid() >> 6);
  float x[16];
#pragma unroll
  for (int j = 0; j < 4; ++j) { const float4 v = *(const float4*)(res_in + row * 1024 + j * 256 + lane * 4); x[4 * j] = v.x; x[4 * j + 1] = v.y; x[4 * j + 2] = v.z; x[4 * j + 3] = v.w; }
  if (delta) {
    float d[16]; float ss = 0.f;
#pragma unroll
    for (int j = 0; j < 4; ++j) { const uint2 v = *(const uint2*)(delta + row * 1024 + j * 256 + lane * 4); d[4 * j] = bflo(v.x); d[4 * j + 1] = bfhi(v.x); d[4 * j + 2] = bflo(v.y); d[4 * j + 3] = bfhi(v.y); }
#pragma unroll
    for (int i = 0; i < 16; ++i) ss += d[i] * d[i];
    ss = wave_sum(ss);
    const float rs = rsqrtf(ss * (1.f / 1024.f) + 1e-6f);
#pragma unroll
    for (int j = 0; j < 4; ++j) {
      const float4 g = *(const float4*)(g_post + j * 256 + lane * 4);
      x[4 * j] += d[4 * j] * rs * g.x; x[4 * j + 1] += d[4 * j + 1] * rs * g.y; x[4 * j + 2] += d[4 * j + 2] * rs * g.z; x[4 * j + 3] += d[4 * j + 3] * rs * g.w;
      float4 o; o.x = x[4 * j]; o.y = x[4 * j + 1]; o.z = x[4 * j + 2]; o.w = x[4 * j + 3];
      *(float4*)(res_out + row * 1024 + j * 256 + lane * 4) = o;
    }
  }
  if (hnext) {
    if (stats && lane < 2) { unsigned long long zz = 0ull; asm volatile("" : "+v"(zz)); stats[row * 2 + lane] = zz; }
    float ss = 0.f;
#pragma unroll
    for (int i = 0; i < 16; ++i) ss += x[i] * x[i];
    ss = wave_sum(ss);
    const float rs = rsqrtf(ss * (1.f / 1024.f) + 1e-6f);
#pragma unroll
    for (int j = 0; j < 4; ++j) {
      const float4 g = *(const float4*)(g_next + j * 256 + lane * 4);
      store4bf(hnext + row * 1024 + j * 256 + lane * 4, x[4 * j] * rs * g.x, x[4 * j + 1] * rs * g.y, x[4 * j + 2] * rs * g.z, x[4 * j + 3] * rs * g.w);
    }
  }
}

DI bool xcd_tile(int round, int NT, int& mt, int& nt) {
  const int bid = blockIdx.x, x = bid & 7, lb = bid >> 3;
  const int ti = round * 32 + lb;
  mt = x * 8 + (ti & 7); nt = ti >> 3;
  return nt < NT;
}
DI TileSrc srcB(const Params& p, int item) {
  const int nt = item % 27, mt = item / 27;
  TileSrc t; t.A = (const u16*)(p.ws + OFF_HB) + (long)mt * 256 * 1024; t.lda = 1024; t.Bt = (const u16*)(p.ws + OFF_W1 + W1_WIN) + (long)nt * 256 * 1024; t.ldb = 1024;
  return t;
}
DI void phaseB_tile(const Params& p, int item, char* smem, Stg& st, bool pre, int nitem, bool hasnxt, const TileSrc* nx = nullptr) {
  const int nt = item % 27, mt = item / 27;
  const int m0 = mt * 256, n0 = nt * 256;
  char* ws = p.ws;
  f32x4 acc[4][8];
  zero_acc<4>(acc);
  gemm512<4, 4>(acc, srcB(p, item), 1024, smem, st, pre, nx ? *nx : srcB(p, nitem), hasnxt);
  if (n0 < 1024) {
    u16* U = (u16*)(ws + OFF_U);
    epi512_rows16<4, 4>(acc, m0, n0, U, 1024, 0, [](float v) { return geluf_(v); });
  } else if (n0 < 2048) {
    u16* G = (u16*)(ws + OFF_GV);
    unsigned long long* stats = (unsigned long long*)(ws + OFF_SM + SM_STATS);
    const int tid = otid(), lane = tid & 63, wid = tid >> 6, wm = wid >> 2, wn = wid & 3, r16 = lane & 15, q = lane >> 4;
#pragma unroll
    for (int mf = 0; mf < 8; ++mf) {
      const int m = m0 + wm * 128 + mf * 16 + r16;
      float s1 = 0.f, s2 = 0.f;
#pragma unroll
      for (int nf = 0; nf < 4; ++nf) {
        const int d = n0 - 1024 + wn * 64 + nf * 16 + q * 4;
        float gg[4];
#pragma unroll
        for (int e = 0; e < 4; ++e) { gg[e] = geluf_(acc[nf][mf][e]); s1 += gg[e]; s2 += gg[e] * gg[e]; }
        const int k4 = lane & 3;
        *(uint2*)(G + ((long)(m >> 7) * 1024 + d + k4) * 128 + ((m & 127) - k4)) = quad_transpose_pack(gg[0], gg[1], gg[2], gg[3], k4);
      }
      s1 += __shfl_xor(s1, 16); s2 += __shfl_xor(s2, 16);
      s1 += __shfl_xor(s1, 32); s2 += __shfl_xor(s2, 32);
      if (q == 0) {
        atomicAdd(stats + (long)m * 2, (unsigned long long)(long long)__float2ll_rn(s1 * 16777216.f));
        atomicAdd(stats + (long)m * 2 + 1, (unsigned long long)(long long)__float2ll_rn(s2 * 16777216.f));
      }
      __builtin_amdgcn_sched_barrier(0);
    }
  } else if (n0 < 3072) {
    u16* Q = (u16*)(ws + OFF_Q);
    epi512_rows16<4, 4>(acc, m0, n0, Q, 1024, -2048, [](float v) { return v; });
  } else if (n0 < 4608) {
    const int i6 = (n0 - 3072) >> 8;
    u16* base = (u16*)(ws + OFF_KV) + (long)i6 * KV_ELEMS;
    if (i6 == 3 || i6 == 5) {
      epi512<4, 4>(acc, m0, n0, [&](int m, int n, float a, float b, float c, float d) {
        const int cc = n - 3072, g = (cc >> 6) & 3, dd = cc & 63, bb = m >> 11, s = m & 2047;
        const int k4 = (int)__builtin_amdgcn_workitem_id_x() & 3;
        *(uint2*)(base + ((long)(bb * 4 + g) * 64 + dd + k4) * 2048 + (s - k4)) = quad_transpose_pack(a, b, c, d, k4);
      });
    } else {
      epi512_rows16_at<4, 4>(acc, m0, n0, [&](int m, int n) {
        const int cc = n - 3072, g = (cc >> 6) & 3, dd = cc & 63, bb = m >> 11, s = m & 2047;
        return base + ((long)(bb * 4 + g) * 2048 + s) * 64 + dd;
      });
    }
  } else if (n0 < 5632) {
    u16* X = (u16*)(ws + OFF_XR);
    epi512_rows16<4, 4>(acc, m0, n0, X, 1024, -4608, [](float v) { return v; });
  } else if (n0 < 6656) {
    u16* R = (u16*)(ws + OFF_RG);
    epi512_rows16<4, 4>(acc, m0, n0, R, 1024, -5632, [](float v) { return geluf_(v); });
  } else {
    float* NG = (float*)(ws + OFF_NG);
    epi512<4, 4>(acc, m0, n0, [&](int m, int n, float a, float b, float c, float d) {
      const int cc = n - 6656;
      if (cc < 48) { float4 o; o.x = sigmoidf_(a); o.y = sigmoidf_(b); o.z = sigmoidf_(c); o.w = sigmoidf_(d); *(float4*)(NG + (long)m * 48 + cc) = o; }
    });
  }
}

DI void nsa_item(const Params& p, int strip, char* smem) {
  char* ws = p.ws;
  f32x4 acc[4][2];
  zero_acc<1>(acc);
  {
    Stg st;
    TileSrc t; t.A = (const u16*)(ws + OFF_HB) + (long)strip * 256 * 1024; t.lda = 1024; t.Bt = (const u16*)(ws + OFF_W1 + W1_WNS); t.ldb = 1024;
    gemm512<1, 1>(acc, t, 1024, smem, st, false, t, false);
  }
  float* NG = (float*)(ws + OFF_NG);
  const int tid = otid(), lane = tid & 63, wid = tid >> 6, r16 = lane & 15, q = lane >> 4;
#pragma unroll
  for (int mf = 0; mf < 2; ++mf) {
    const int m = strip * 256 + wid * 32 + mf * 16 + r16;
#pragma unroll
    for (int nf = 0; nf < 3; ++nf) {
      const int c = nf * 16 + q * 4;
      float4 o; o.x = sigmoidf_(acc[nf][mf][0]); o.y = sigmoidf_(acc[nf][mf][1]); o.z = sigmoidf_(acc[nf][mf][2]); o.w = sigmoidf_(acc[nf][mf][3]);
      *(float4*)(NG + (long)m * 48 + c) = o;
    }
  }
  __syncthreads();
}
DI TileSrc srcB_half(const Params& p, int mt, int n0) {
  TileSrc t; t.A = (const u16*)(p.ws + OFF_HB) + (long)mt * 256 * 1024; t.lda = 1024; t.Bt = (const u16*)(p.ws + OFF_W1 + W1_WIN) + (long)n0 * 1024; t.ldb = 1024;
  return t;
}
DI void phaseB_half_tile(const Params& p, int mt, int n0, char* smem, Stg& st, bool pre) {
  const int m0 = mt * 256;
  char* ws = p.ws;
  f32x4 acc[4][4];
  zero_acc<2>(acc);
  {
    const TileSrc t = srcB_half(p, mt, n0);
    gemm512<2, 2>(acc, t, 1024, smem, st, pre, t, false);
  }
  u16* R = (u16*)(ws + OFF_RG);
  epi512_rows16<2, 2>(acc, m0, n0, R, 1024, -5632, [](float v) { return geluf_(v); });
}

DI void rglru_item(const Params& p, int l, int item, char* smem) {
  const int tid = htid(), lane = tid & 63, w = tid >> 6, r32 = lane & 31, h = lane >> 5;
  const int chalf = item & 1, hd = (item >> 1) & 15, b = item >> 5;
  char* xcb = smem;
  char* WT = smem + 18432;
  float* AL = (float*)(smem + 27648);
  float* BL = (float*)(smem + 44544);
  float* segP = (float*)(smem + 61440);
  float* segH = (float*)(smem + 62464);
  float* carry = (float*)(smem + 63488);
  const u16* XR = (const u16*)(p.ws + OFF_XR);
  u16* RG = (u16*)(p.ws + OFF_RG);
  {
    const float* wa = p.in[18] + (long)l * 65536 + (long)hd * 4096;
    const float* wx = p.in[20] + (long)l * 65536 + (long)hd * 4096;
#pragma unroll 4
    for (int e = 0; e < 16; ++e) {
      const int idx = tid + 256 * e;
      const int gate = idx >> 11, i = (idx >> 5) & 63, o = idx & 31;
      const float v = (gate ? wx : wa)[i * 64 + chalf * 32 + o];
      ((u16*)WT)[((o >> 4) * 32 + gate * 16 + (o & 15)) * 72 + i] = f2bf(v);
    }
    if (tid < 64) carry[tid] = 0.f;
  }
  const int cc = tid & 63, tg = tid >> 6;
  float cw[4];
#pragma unroll
  for (int jj = 0; jj < 4; ++jj) cw[jj] = p.in[16][(long)l * 4096 + jj * 1024 + hd * 64 + cc];
  const float cb = p.in[17][(long)l * 1024 + hd * 64 + cc];
  const int wr = w & 1, mth = w >> 1;
  float ba[8], bx[8], sp[8];
#pragma unroll
  for (int e = 0; e < 8; ++e) {
    const int rho = (e & 3) + 8 * (e >> 2) + 4 * h;
    const int c = hd * 64 + chalf * 32 + wr * 16 + rho;
    ba[e] = p.in[19][(long)l * 1024 + c]; bx[e] = p.in[21][(long)l * 1024 + c];
    sp[e] = -8.f * log1pf(expf(-p.in[22][(long)l * 1024 + c]));
  }
  const int scl = tid & 31, seg = tid >> 5;
  float xn[35];
  {
    const u16* xp = XR + ((long)b * 2048 + tg * 32) * 1024 + hd * 64 + cc;
#pragma unroll
    for (int jj = 0; jj < 35; ++jj) { const int s = tg * 32 + jj - 3; xn[jj] = (s >= 0) ? bf2f(xp[(long)(jj - 3) * 1024]) : 0.f; }
  }
  __syncthreads();
#pragma unroll 1
  for (int ch = 0; ch < 16; ++ch) {
    const int s0 = ch * 128;
    u16* rp = RG + ((long)b * 2048 + s0 + seg * 16) * 1024 + hd * 64 + chalf * 32 + scl;
    float rgv[16];
#pragma unroll
    for (int jj = 0; jj < 16; ++jj) rgv[jj] = bf2f(rp[(long)jj * 1024]);
#pragma unroll
    for (int tt = 0; tt < 32; ++tt) {
      const float v = cb + cw[0] * xn[tt] + cw[1] * xn[tt + 1] + cw[2] * xn[tt + 2] + cw[3] * xn[tt + 3];
      ((u16*)xcb)[(tg * 32 + tt) * 72 + cc] = f2bf(v);
    }
    if (ch + 1 < 16) {
      const u16* xp = XR + ((long)b * 2048 + s0 + 128 + tg * 32) * 1024 + hd * 64 + cc;
#pragma unroll
      for (int jj = 0; jj < 35; ++jj) xn[jj] = bf2f(xp[(long)(jj - 3) * 1024]);
    }
    __syncthreads();
#pragma unroll
    for (int m2 = 0; m2 < 2; ++m2) {
      const int mt = mth * 2 + m2;
      f32x16 acc = zero16();
#pragma unroll
      for (int ks = 0; ks < 4; ++ks) {
        const bf16x8 fa = *(const bf16x8*)(WT + (wr * 32 + r32) * 144 + ks * 32 + h * 16);
        const bf16x8 fb = *(const bf16x8*)(xcb + (mt * 32 + r32) * 144 + ks * 32 + h * 16);
        acc = MFMA32(fa, fb, acc);
      }
      const int t = mt * 32 + r32;
#pragma unroll
      for (int e = 0; e < 8; ++e) {
        const int rho = (e & 3) + 8 * (e >> 2) + 4 * h;
        const int cl = wr * 16 + rho;
        const float r = sigmoidf_(acc[e] + ba[e]), ii = sigmoidf_(acc[e + 8] + bx[e]);
        const float la = r * sp[e];
        const float a = __expf(la);
        const float om2 = fmaxf(__builtin_fmaf(-a, a, 1.f), 0.f);
        const float xcv = bf2f(((const u16*)xcb)[t * 72 + chalf * 32 + cl]);
        AL[t * 33 + cl] = a;
        BL[t * 33 + cl] = __builtin_amdgcn_sqrtf(om2) * ii * xcv;
      }
    }
    __syncthreads();
    {
      float a[16], bq[16];
      float P = 1.f, H = 0.f;
#pragma unroll
      for (int jj = 0; jj < 16; ++jj) { a[jj] = AL[(seg * 16 + jj) * 33 + scl]; bq[jj] = BL[(seg * 16 + jj) * 33 + scl]; H = a[jj] * H + bq[jj]; P *= a[jj]; }
      segP[seg * 32 + scl] = P; segH[seg * 32 + scl] = H;
      __syncthreads();
      float hh = carry[(ch & 1) * 32 + scl];
      for (int s2 = 0; s2 < seg; ++s2) hh = segP[s2 * 32 + scl] * hh + segH[s2 * 32 + scl];
#pragma unroll
      for (int jj = 0; jj < 16; ++jj) { hh = a[jj] * hh + bq[jj]; rp[(long)jj * 1024] = f2bf(hh * rgv[jj]); }
      if (seg == 7) carry[((ch + 1) & 1) * 32 + scl] = hh;
    }
  }
  __syncthreads();
}

DI void compress_item(const Params& p, int item, char* smem) {
  const int tid = otid(), lane = tid & 63, w = tid >> 6, r32 = lane & 31, h = lane >> 5;
  const int kv = item & 1, mt = item >> 1;
  char* ws = p.ws;
  const u16* w2T = (const u16*)(ws + OFF_W1 + (kv ? W1_WV2 : W1_WK2));
  const float* cb = (const float*)(ws + OFF_SM + SM_CKV) + kv * 256;
  u16* hid = (u16*)(ws + OFF_SM + SM_HID) + (long)item * 65536;
  {
    TileSrc src; src.A = (const u16*)(ws + OFF_KV) + (long)kv * KV_ELEMS + (long)mt * 256 * 1024; src.lda = 1024;
    src.Bt = (const u16*)(ws + OFF_W1 + (kv ? W1_WV1 : W1_WK1)); src.ldb = 2048;
    f32x4 acc[4][8];
    zero_acc<4>(acc);
    Stg st;
    gemm512<4, 4>(acc, src, 2048, smem, st, false, src, false);
    epi512<4, 4>(acc, 0, 0, [&](int m, int n, float a, float b, float c, float d) {
      const float4 cv = *(const float4*)(cb + n);
      store4bf(hid + m * 256 + n, geluf_(a + cv.x), geluf_(b + cv.y), geluf_(c + cv.z), geluf_(d + cv.w));
    });
  }
  __syncthreads();
  f32x16 o2[2]; o2[0] = zero16(); o2[1] = zero16();
#pragma unroll 4
  for (int ks = 0; ks < 16; ++ks) {
    const bf16x8 fb = *(const bf16x8*)(hid + (w * 32 + r32) * 256 + ks * 16 + h * 8);
#pragma unroll
    for (int dt = 0; dt < 2; ++dt) {
      const bf16x8 fa = *(const bf16x8*)(w2T + (dt * 32 + r32) * 256 + ks * 16 + h * 8);
      o2[dt] = MFMA32(fa, fb, o2[dt]);
    }
  }
  const int R = mt * 256 + w * 32 + r32;
  const int bg = R >> 7, n = R & 127;
  const bool dead = (n == 127);
  if (kv == 0) {
    u16* KC = (u16*)(ws + OFF_SM + SM_KC) + (long)bg * 8192;
#pragma unroll
    for (int dt = 0; dt < 2; ++dt)
#pragma unroll
      for (int g4 = 0; g4 < 4; ++g4) {
        const int d = dt * 32 + 8 * g4 + 4 * h;
        if (dead) store4bf(KC + n * 64 + d, 0.f, 0.f, 0.f, 0.f);
        else store4bf(KC + n * 64 + d, o2[dt][4 * g4], o2[dt][4 * g4 + 1], o2[dt][4 * g4 + 2], o2[dt][4 * g4 + 3]);
      }
  } else {
    u16* VCT = (u16*)(ws + OFF_SM + SM_VCT) + (long)bg * 8192;
#pragma unroll
    for (int dt = 0; dt < 2; ++dt)
#pragma unroll
      for (int i = 0; i < 16; ++i) {
        const int d = dt * 32 + (i & 3) + 8 * (i >> 2) + 4 * h;
        VCT[d * 128 + n] = dead ? (u16)0 : f2bf(o2[dt][i]);
      }
  }
  __syncthreads();
}

DI void gmlp_item(const Params& p, int l, int item4, char* smem) {
  const int tid = htid(), lane = tid & 63, w = tid >> 6, r32 = lane & 31, h = lane >> 5;
  const int item = item4 >> 2, g = item4 & 3;
  const long t0 = (long)item * 128;
  char* ws = p.ws;
  const u16* GVT = (const u16*)(ws + OFF_GV) + (long)item * 1024 * 128;
  u16* U = (u16*)(ws + OFF_U);
  const u16* WSB = (const u16*)(ws + OFF_SM + SM_WSB) + (long)g * 16384;
  const long long* stats = (const long long*)(ws + OFF_SM + SM_STATS) + t0 * 2;
  const float* lng = p.in[6] + (long)l * 1024;
  const float* lnb = p.in[7] + (long)l * 1024;
  const float* bs = p.in[9] + (long)l * 512 + g * 128;
  char* ap = smem;
  float* mu = (float*)(smem + 34816);
  float* rs = mu + 128;
  float* c1 = rs + 128;
  float* c2 = c1 + 128;
  if (tid < 128) {
    const float m = (float)stats[tid * 2] * (1.f / 16777216.f / 1024.f);
    const float var = (float)stats[tid * 2 + 1] * (1.f / 16777216.f / 1024.f) - m * m;
    mu[tid] = m; rs[tid] = rsqrtf(fmaxf(var, 0.f) + 1e-6f);
  }
  __syncthreads();
#pragma unroll 2
  for (int i = 0; i < 8; ++i) {
    const int idx = tid + 256 * i;
    const int t = idx >> 4, ch = (idx & 15) * 8;
    const uint4 wv = *(const uint4*)(WSB + t * 128 + ch);
    const unsigned wu[4] = {wv.x, wv.y, wv.z, wv.w};
    float a1 = 0.f, a2 = 0.f;
    uint4 o;
    unsigned* ou = (unsigned*)&o;
#pragma unroll
    for (int e = 0; e < 4; ++e) {
      const float w0 = bflo(wu[e]), w1 = bfhi(wu[e]);
      const unsigned pk = pack2(w0 * rs[ch + 2 * e], w1 * rs[ch + 2 * e + 1]);
      ou[e] = pk;
      a1 += bflo(pk) * mu[ch + 2 * e] + bfhi(pk) * mu[ch + 2 * e + 1];
      a2 += w0 + w1;
    }
    *(uint4*)(ap + t * 272 + ch * 2) = o;
#pragma unroll
    for (int off = 8; off >= 1; off >>= 1) { a1 += __shfl_xor(a1, off); a2 += __shfl_xor(a2, off); }
    if ((idx & 15) == 0) { c1[t] = a1; c2[t] = a2; }
  }
  __syncthreads();
#pragma unroll 1
  for (int dh = 0; dh < 2; ++dh) {
    const int c0 = g * 256 + dh * 128;
    bf16x8 fa[8];
#pragma unroll
    for (int ks = 0; ks < 8; ++ks) fa[ks] = *(const bf16x8*)(GVT + (long)(c0 + w * 32 + r32) * 128 + ks * 16 + h * 8);
    f32x16 acc[4];
#pragma unroll
    for (int mi = 0; mi < 4; ++mi) acc[mi] = zero16();
#pragma unroll
    for (int ks = 0; ks < 8; ++ks) {
#pragma unroll
      for (int mi = 0; mi < 4; ++mi) {
        if (mi >= (ks >> 1)) {
          const bf16x8 fb = *(const bf16x8*)(ap + (mi * 32 + r32) * 272 + ks * 32 + h * 16);
          acc[mi] = MFMA32(fa[ks], fb, acc[mi]);
        }
      }
    }
#pragma unroll
    for (int mi = 0; mi < 4; ++mi) {
      const int t = mi * 32 + r32;
      const float k1 = c1[t], k2 = c2[t], bias = bs[t];
#pragma unroll
      for (int kk = 0; kk < 2; ++kk) {
        unsigned px[2], py[2];
#pragma unroll
        for (int g2 = 0; g2 < 2; ++g2) {
          const int g4 = 2 * kk + g2;
          const int d = c0 + w * 32 + 8 * g4 + 4 * h;
          const float4 gg = *(const float4*)(lng + d), bb = *(const float4*)(lnb + d);
          const uint2 uv = *(const uint2*)(U + (t0 + t) * 1024 + d);
          px[g2] = pack2(bflo(uv.x) * (gg.x * (acc[mi][4 * g4] - k1) + bb.x * k2 + bias), bfhi(uv.x) * (gg.y * (acc[mi][4 * g4 + 1] - k1) + bb.y * k2 + bias));
          py[g2] = pack2(bflo(uv.y) * (gg.z * (acc[mi][4 * g4 + 2] - k1) + bb.z * k2 + bias), bfhi(uv.y) * (gg.w * (acc[mi][4 * g4 + 3] - k1) + bb.w * k2 + bias));
        }
        auto rx = __builtin_amdgcn_permlane32_swap(px[0], px[1], false, false);
        auto ry = __builtin_amdgcn_permlane32_swap(py[0], py[1], false, false);
        uint4 o; o.x = rx[0]; o.y = ry[0]; o.z = rx[1]; o.w = ry[1];
        *(uint4*)(U + (t0 + t) * 1024 + c0 + w * 32 + 8 * (2 * kk + h)) = o;
      }
    }
  }
  __syncthreads();
}

DI void load_tile64(char* dst, const u16* __restrict__ src, long stride) {
  const int tid = htid();
#pragma unroll
  for (int i = 0; i < 2; ++i) { const int idx = tid + 256 * i; const int r = idx >> 3, c = idx & 7; *(uint4*)(dst + r * 144 + c * 16) = *(const uint4*)(src + (long)r * stride + c * 8); }
}
DI f32x16 qk_sub(const char* ldsK, int kr0, const bf16x8 (&qf)[4], int r32, int h) {
  f32x16 s = zero16();
#pragma unroll
  for (int ks = 0; ks < 4; ++ks) { const bf16x8 kf = *(const bf16x8*)(ldsK + (kr0 + r32) * 144 + ks * 32 + h * 16); s = MFMA32(kf, qf[ks], s); }
  return s;
}
DI void pv_sub(f32x16 (&o)[2], const char* ldsV, int key0, const f32x16& pt, int r32, int h) {
#pragma unroll
  for (int s2 = 0; s2 < 2; ++s2) {
    union { uint4 u; bf16x8 v; } pb;
    pb.u.x = pack2(pt[8 * s2 + 0], pt[8 * s2 + 1]); pb.u.y = pack2(pt[8 * s2 + 2], pt[8 * s2 + 3]);
    pb.u.z = pack2(pt[8 * s2 + 4], pt[8 * s2 + 5]); pb.u.w = pack2(pt[8 * s2 + 6], pt[8 * s2 + 7]);
#pragma unroll
    for (int dt = 0; dt < 2; ++dt) {
      const char* vp = ldsV + (dt * 32 + r32) * 136 + (key0 + 16 * s2 + 4 * h) * 2;
      union { uint4 u; bf16x8 v; } vf;
      const uint2 lo = *(const uint2*)vp, hi = *(const uint2*)(vp + 16);
      vf.u.x = lo.x; vf.u.y = lo.y; vf.u.z = hi.x; vf.u.w = hi.y;
      o[dt] = MFMA32(vf.v, pb.v, o[dt]);
    }
  }
}
#define LOG2E_F 1.4426950408889634f
DI void flash_tile(f32x16 (&O)[2], float& m_run, float& l_run, const char* ldsK, const char* ldsV,
                                          const bf16x8 (&qf)[4], int hi, int lo, int r32, int h) {
  f32x16 s[2];
  s[0] = qk_sub(ldsK, 0, qf, r32, h); s[1] = qk_sub(ldsK, 32, qf, r32, h);
  const bool full = (hi >= 59) && (lo < 0);
  bool rowsel = true;
  if (__builtin_amdgcn_ballot_w64(full) != ~0ull) {
    const bool rowmask = (lo < 0) && (hi >= 59 || hi < 0);
    if (__builtin_amdgcn_ballot_w64(rowmask) == ~0ull) {
      rowsel = hi >= 0;
    } else {
#pragma unroll
      for (int sub = 0; sub < 2; ++sub)
#pragma unroll
        for (int i = 0; i < 16; ++i) {
          const int c = sub * 32 + (i & 3) + 8 * (i >> 2);
          s[sub][i] = (c <= hi && c > lo) ? s[sub][i] : -1e30f;
        }
    }
  }
  float mt = fmaxf(s[0][0], s[1][0]);
#pragma unroll
  for (int i = 1; i < 16; ++i) mt = fmaxf(mt, fmaxf(s[0][i], s[1][i]));
  mt = fmaxf(mt, __shfl_xor(mt, 32));
  mt = rowsel ? mt : -1e30f;
  const float m_new = fmaxf(m_run, mt);
  const float mc = rowsel ? fmaxf(m_new, -1e20f) * LOG2E_F : 1e30f;
  float ls = 0.f;
#pragma unroll
  for (int sub = 0; sub < 2; ++sub)
#pragma unroll
    for (int i = 0; i < 16; ++i) { const float pv = __builtin_amdgcn_exp2f(__builtin_fmaf(s[sub][i], LOG2E_F, -mc)); s[sub][i] = pv; ls += pv; }
  if (__builtin_amdgcn_ballot_w64(m_new != m_run) != 0ull) {
    const float alpha = __builtin_amdgcn_exp2f((m_run - fmaxf(m_new, -1e20f)) * LOG2E_F);
    l_run *= alpha;
#pragma unroll
    for (int dt = 0; dt < 2; ++dt)
#pragma unroll
      for (int i = 0; i < 16; ++i) O[dt][i] *= alpha;
  }
  l_run += ls; m_run = m_new;
  pv_sub(O, ldsV, 0, s[0], r32, h);
  pv_sub(O, ldsV, 32, s[1], r32, h);
}

DI void attn_item(const Params& p, int item, char* smem) {
  const int tid = otid(), lane = tid & 63, w = tid >> 6, r32 = lane & 31, h = lane >> 5;
  const int bg = item & 31, kk = (item >> 5) & 7, rr = (item >> 8) & 3;
  const int qt = (item & 0x10000) ? (31 - ((item >> 5) & 31))
                                  : ((rr == 0) ? (31 - kk) : ((rr == 1) ? (16 + kk) : ((rr == 2) ? (15 - kk) : kk)));
  const int b = bg >> 2, g = bg & 3;
  const int t0 = qt * 64, t = t0 + (w >> 2) * 32 + r32, cur = qt;
  const int hd = g * 4 + (w & 3);
  const long tok = (long)b * 2048 + t;
  char* ws = p.ws;
  u16* Q = (u16*)(ws + OFF_Q);
  float* impA = (float*)(smem + 36864);
  float* impB = (float*)(smem + 70656);
  float* impT = (float*)(smem + 104448);
  unsigned* selm = (unsigned*)(smem + 112896);
  const int lr = tid >> 3, lc = tid & 7;
  const int ldoff = lr * 144 + lc * 16;
  const u16* KS = (const u16*)(ws + OFF_KV) + 2 * KV_ELEMS + (long)bg * 131072;
  const u16* VST = (const u16*)(ws + OFF_KV) + 3 * KV_ELEMS + (long)bg * 131072;
  const u16* KW = (const u16*)(ws + OFF_KV) + 4 * KV_ELEMS + (long)bg * 131072;
  const u16* VWT = (const u16*)(ws + OFF_KV) + 5 * KV_ELEMS + (long)bg * 131072;
  const int jlo = (t0 - 511 > 0) ? ((t0 - 511) >> 6) : 0;
  const int ns = cur + 1, ntile = ns + (cur - jlo + 1);
  u32x4 pkA, pvA, pkB, pvB;
#define ATT_ISSUE(i_, K_, V_) do { const int ii_ = (i_); const bool sl_ = ii_ < ns; const int j_ = sl_ ? ii_ : (jlo + ii_ - ns); \
    K_ = *(const u32x4*)((sl_ ? KS : KW) + (long)j_ * 4096 + lr * 64 + lc * 8); \
    V_ = *(const u32x4*)((sl_ ? VST : VWT) + j_ * 64 + (long)lr * 2048 + lc * 8); } while (0)
  bf16x8 qf[4];
#pragma unroll
  for (int ks = 0; ks < 4; ++ks) {
    u32x4 x = *(const u32x4*)(Q + tok * 1024 + hd * 64 + ks * 16 + h * 8);
#pragma unroll
    for (int e = 0; e < 4; ++e) {
      const float lo = bflo(x[e]) * 0.125f, hi = bfhi(x[e]) * 0.125f;
      x[e] = (__float_as_uint(lo) >> 16) | (__float_as_uint(hi) & 0xffff0000u);
    }
    qf[ks] = __builtin_bit_cast(bf16x8, x);
  }
  const float* NG = (const float*)(ws + OFF_NG) + tok * 48 + hd * 3;
  const float g0 = NG[0], g1 = NG[1], g2 = NG[2];
  f32x16 res[2];
  {
    const u16* KC = (const u16*)(ws + OFF_SM + SM_KC) + (long)bg * 8192;
    const u16* VCT = (const u16*)(ws + OFF_SM + SM_VCT) + (long)bg * 8192;
    const int nsub = ((qt * 4 + 2) >> 5) + 1;
    {
      const u32x4 k0 = *(const u32x4*)(KC + lr * 64 + lc * 8), k1 = *(const u32x4*)(KC + 4096 + lr * 64 + lc * 8);
      const u32x4 v0 = *(const u32x4*)(VCT + lr * 128 + lc * 8), v1 = *(const u32x4*)(VCT + lr * 128 + 64 + lc * 8);
      *(u32x4*)(smem + ldoff) = k0; *(u32x4*)(smem + 18432 + ldoff) = k1;
      { const int vo = lr * 136 + lc * 16;
        uint2 a; a.x = v0[0]; a.y = v0[1]; *(uint2*)(smem + 9216 + vo) = a; a.x = v0[2]; a.y = v0[3]; *(uint2*)(smem + 9216 + vo + 8) = a;
        a.x = v1[0]; a.y = v1[1]; *(uint2*)(smem + 27648 + vo) = a; a.x = v1[2]; a.y = v1[3]; *(uint2*)(smem + 27648 + vo + 8) = a; }
    }
    ATT_ISSUE(0, pkA, pvA);
    ATT_ISSUE(1, pkB, pvB);
    __syncthreads();
    const char* K0 = smem; const char* V0 = smem + 9216; const char* K1 = smem + 18432; const char* V1 = smem + 27648;
    f32x16 sc[4];
    sc[0] = qk_sub(K0, 0, qf, r32, h);
    sc[1] = zero16(); sc[2] = zero16(); sc[3] = zero16();
    if (nsub > 1) sc[1] = qk_sub(K0, 32, qf, r32, h);
    if (nsub > 2) sc[2] = qk_sub(K1, 0, qf, r32, h);
    if (nsub > 3) sc[3] = qk_sub(K1, 32, qf, r32, h);
    float mx = -1e30f;
    const int nlim = ((t - 31) >> 4) - 4 * h;
#pragma unroll
    for (int sub = 0; sub < 4; ++sub)
#pragma unroll
      for (int i = 0; i < 16; ++i) {
        const int c = sub * 32 + (i & 3) + 8 * (i >> 2);
        const float v = (c <= nlim) ? sc[sub][i] : -1e30f;
        sc[sub][i] = v; mx = fmaxf(mx, v);
      }
    mx = fmaxf(mx, __shfl_xor(mx, 32));
    const float mxc = fmaxf(mx, -1e20f) * LOG2E_F;
    float lsum = 0.f;
#pragma unroll
    for (int sub = 0; sub < 4; ++sub)
#pragma unroll
      for (int i = 0; i < 16; ++i) { const float pvv = __builtin_amdgcn_exp2f(__builtin_fmaf(sc[sub][i], LOG2E_F, -mxc)); sc[sub][i] = pvv; lsum += pvv; }
    lsum += __shfl_xor(lsum, 32);
    const float inv = (t >= 31) ? (1.f / lsum) : 0.f;
#pragma unroll
    for (int sub = 0; sub < 4; ++sub)
#pragma unroll
      for (int i = 0; i < 16; ++i) sc[sub][i] *= inv;
    const int qloc = (w >> 2) * 32 + r32, hh4 = w & 3;
#pragma unroll
    for (int sub = 0; sub < 4; ++sub)
#pragma unroll
      for (int g4 = 0; g4 < 4; ++g4) {
        const int mi = 8 * sub + 2 * g4 + h;
        const float p3 = 0.5f * sc[sub][4 * g4 + 3];
        impA[(hh4 * 64 + qloc) * 33 + mi] = sc[sub][4 * g4] + sc[sub][4 * g4 + 1] + sc[sub][4 * g4 + 2] + p3;
        impB[(hh4 * 64 + qloc) * 33 + mi + 1] = p3;
      }
    __syncthreads();
    {
      const int q = tid >> 3, jj = (tid & 7) * 4;
#pragma unroll
      for (int e = 0; e < 4; ++e) {
        const int j = jj + e;
        float tot = 0.f;
#pragma unroll
        for (int ww = 0; ww < 4; ++ww) tot += impA[(ww * 64 + q) * 33 + j];
        if (j > 0) {
#pragma unroll
          for (int ww = 0; ww < 4; ++ww) tot += impB[(ww * 64 + q) * 33 + j];
        }
        impT[q * 33 + j] = tot;
      }
      if (tid < 64) selm[tid] = 0u;
    }
    __syncthreads();
    f32x16 oc[2]; oc[0] = zero16(); oc[1] = zero16();
    pv_sub(oc, V0, 0, sc[0], r32, h);
    if (nsub > 1) pv_sub(oc, V0, 32, sc[1], r32, h);
    if (nsub > 2) pv_sub(oc, V1, 0, sc[2], r32, h);
    if (nsub > 3) pv_sub(oc, V1, 32, sc[3], r32, h);
#pragma unroll
    for (int dt = 0; dt < 2; ++dt)
#pragma unroll
      for (int i = 0; i < 16; ++i) res[dt][i] = g0 * oc[dt][i];
    {
      const int q = tid >> 3, jj = (tid & 7) * 4;
      unsigned bits = 0u;
      for (int e = 0; e < 4; ++e) {
        const int j = jj + e;
        bool sel;
        if (j > cur) sel = false;
        else if (j == 0 || j >= cur - 1) sel = true;
        else if (cur - 2 <= 13) sel = true;
        else {
          const float v = impT[q * 33 + j];
          int rank = 0;
          for (int j2 = 1; j2 <= cur - 2; ++j2) { const float v2 = impT[q * 33 + j2]; rank += ((v2 > v) || (v2 == v && j2 < j)) ? 1 : 0; }
          sel = rank < 13;
        }
        if (sel) bits |= (1u << j);
      }
      atomicOr(&selm[q], bits);
    }
    __syncthreads();
  }
  const unsigned mymask = selm[(w >> 2) * 32 + r32];
  {
    f32x16 O[2]; O[0] = zero16(); O[1] = zero16();
    float m_run = -1e30f, l_run = 0.f;
    auto step = [&](int i, u32x4& pk, u32x4& pv) {
      char* bk = smem + (i & 1) * 18432;
      *(u32x4*)(bk + ldoff) = pk;
      { const int vo = lr * 136 + lc * 16; uint2 a; a.x = pv[0]; a.y = pv[1]; *(uint2*)(bk + 9216 + vo) = a; a.x = pv[2]; a.y = pv[3]; *(uint2*)(bk + 9216 + vo + 8) = a; }
      __syncthreads();
      if (i + 2 < ntile) ATT_ISSUE(i + 2, pk, pv);
      if (i == ns) {
        const float l = l_run + __shfl_xor(l_run, 32);
        const float sc_ = g1 / l;
#pragma unroll
        for (int dt = 0; dt < 2; ++dt)
#pragma unroll
          for (int e = 0; e < 16; ++e) { res[dt][e] += sc_ * O[dt][e]; O[dt][e] = 0.f; }
        m_run = -1e30f; l_run = 0.f;
      }
      const bool sl = i < ns;
      const int j = sl ? i : (jlo + i - ns);
      const int kb = j * 64;
      const int hi = (sl && !((mymask >> j) & 1u)) ? -1 : (t - kb - 4 * h);
      const int lo = sl ? -100000 : (t - 512 - kb - 4 * h);
      flash_tile(O, m_run, l_run, bk, bk + 9216, qf, hi, lo, r32, h);
    };
#pragma unroll 1
    for (int i = 0; i < ntile; i += 2) {
      step(i, pkA, pvA);
      if (i + 1 < ntile) step(i + 1, pkB, pvB);
    }
    const float l = l_run + __shfl_xor(l_run, 32);
    const float sc_ = g2 / l;
#pragma unroll
    for (int dt = 0; dt < 2; ++dt)
#pragma unroll
      for (int e = 0; e < 16; ++e) res[dt][e] += sc_ * O[dt][e];
  }
#undef ATT_ISSUE
#pragma unroll
  for (int dt = 0; dt < 2; ++dt)
#pragma unroll
    for (int kk = 0; kk < 2; ++kk) {
      auto rx = __builtin_amdgcn_permlane32_swap(pack2(res[dt][8 * kk + 0], res[dt][8 * kk + 1]), pack2(res[dt][8 * kk + 4], res[dt][8 * kk + 5]), false, false);
      auto ry = __builtin_amdgcn_permlane32_swap(pack2(res[dt][8 * kk + 2], res[dt][8 * kk + 3]), pack2(res[dt][8 * kk + 6], res[dt][8 * kk + 7]), false, false);
      uint4 o; o.x = rx[0]; o.y = ry[0]; o.z = rx[1]; o.w = ry[1];
      *(uint4*)(Q + tok * 1024 + hd * 64 + dt * 32 + 8 * (2 * kk + h)) = o;
    }
  __syncthreads();
}

DI TileSrc srcE(const Params& p, int step) {
  const int item = step / 6, r = step % 6, k = r >> 1, isv = r & 1;
  const int nt = item & 7, mt = item >> 3;
  const size_t yo = (k == 0) ? OFF_U : ((k == 1) ? OFF_Q : OFF_RG);
  TileSrc t;
  t.A = (const u16*)(p.ws + (isv ? yo : OFF_HB)) + (long)mt * 256 * 1024; t.lda = 1024;
  t.Bt = (const u16*)(p.ws + OFF_W1 + (isv ? W1_WBR : W1_WMG)) + ((long)k * 1024 + nt * 128) * 1024; t.ldb = 1024;
  return t;
}
DI void phaseE_tile(const Params& p, int item, char* smem, Stg& st, bool pre, int nitem, bool hasnxt) {
  const int nt = item & 7, mt = item >> 3;
  const int m0 = mt * 256, n0 = nt * 128;
  char* ws = p.ws;
  f32x4 R[4][4];
  zero_acc<2>(R);
#pragma unroll 1
  for (int k = 0; k < 3; ++k) {
    f32x4 acc[4][4];
    zero_acc<2>(acc);
    gemm512<2, 2>(acc, srcE(p, item * 6 + k * 2), 1024, smem, st, pre || (k > 0), srcE(p, item * 6 + k * 2 + 1), true);
    uint4* gs = (uint4*)(ws + OFF_KV + 25165824) + (size_t)blockIdx.x * 4096 + otid();
#pragma unroll
    for (int a = 0; a < 4; ++a) {
#pragma unroll
      for (int b2 = 0; b2 < 2; ++b2) {
        uint4 v;
        v.x = pack2(sigmoidf_(acc[a][2 * b2][0]), sigmoidf_(acc[a][2 * b2][1]));
        v.y = pack2(sigmoidf_(acc[a][2 * b2][2]), sigmoidf_(acc[a][2 * b2][3]));
        v.z = pack2(sigmoidf_(acc[a][2 * b2 + 1][0]), sigmoidf_(acc[a][2 * b2 + 1][1]));
        v.w = pack2(sigmoidf_(acc[a][2 * b2 + 1][2]), sigmoidf_(acc[a][2 * b2 + 1][3]));
        gs[(a * 2 + b2) * 512] = v;
      }
      __builtin_amdgcn_sched_barrier(0);
    }
    zero_acc<2>(acc);
    {
      const bool last = (k == 2);
      gemm512<2, 2>(acc, srcE(p, item * 6 + k * 2 + 1), 1024, smem, st, true, last ? srcE(p, nitem * 6) : srcE(p, item * 6 + k * 2 + 2), last ? hasnxt : true);
    }
#pragma unroll
    for (int a = 0; a < 4; ++a) {
#pragma unroll
      for (int b2 = 0; b2 < 2; ++b2) {
        const uint4 v = gs[(a * 2 + b2) * 512];
        R[a][2 * b2][0] += bflo(v.x) * acc[a][2 * b2][0]; R[a][2 * b2][1] += bfhi(v.x) * acc[a][2 * b2][1];
        R[a][2 * b2][2] += bflo(v.y) * acc[a][2 * b2][2]; R[a][2 * b2][3] += bfhi(v.y) * acc[a][2 * b2][3];
        R[a][2 * b2 + 1][0] += bflo(v.z) * acc[a][2 * b2 + 1][0]; R[a][2 * b2 + 1][1] += bfhi(v.z) * acc[a][2 * b2 + 1][1];
        R[a][2 * b2 + 1][2] += bflo(v.w) * acc[a][2 * b2 + 1][2]; R[a][2 * b2 + 1][3] += bfhi(v.w) * acc[a][2 * b2 + 1][3];
      }
      __builtin_amdgcn_sched_barrier(0);
    }
  }
  u16* M = (u16*)(ws + OFF_MERGED);
  epi512_rows16<2, 2>(R, m0, n0, M, 1024, 0, [](float v) { return v; });
}

DI TileSrc srcP(const u16* A, long lda, const u16* Bt, long ldb, int item) {
  const int nt = item & 3, mt = item >> 2;
  TileSrc t; t.A = A + (long)mt * 256 * lda; t.lda = lda; t.Bt = Bt + (long)nt * 256 * ldb; t.ldb = ldb;
  return t;
}
DI void gemm_f32out_tile(const u16* A, long lda, const u16* Bt, long ldb, int K, u16* C, int item, char* smem, Stg& st, bool pre, int nitem, bool hasnxt) {
  const int nt = item & 3, mt = item >> 2;
  const int m0 = mt * 256, n0 = nt * 256;
  f32x4 acc[4][8];
  zero_acc<4>(acc);
  gemm512<4, 4>(acc, srcP(A, lda, Bt, ldb, item), K, smem, st, pre, srcP(A, lda, Bt, ldb, nitem), hasnxt);
  epi512<4, 4>(acc, m0, n0, [&](int m, int n, float a, float b, float c, float d) { store4bf(C + (long)m * 1024 + n, a, b, c, d); });
}

DI TileSrc srcH(const Params& p, int item) {
  const int nt = item % 22, mt = item / 22;
  TileSrc t; t.A = (const u16*)(p.ws + OFF_HB) + (long)mt * 256 * 1024; t.lda = 1024; t.Bt = (const u16*)(p.ws + OFF_W2 + W2_WFI) + (long)nt * 256 * 1024; t.ldb = 1024;
  return t;
}
DI void phaseH_tile(const Params& p, int item, char* smem, Stg& st, bool pre, int nitem, bool hasnxt, const TileSrc* nx = nullptr) {
  const int nt = item % 22, mt = item / 22;
  const int m0 = mt * 256, n0 = nt * 256;
  char* ws = p.ws;
  f32x4 acc[4][8];
  zero_acc<4>(acc);
  gemm512<4, 4>(acc, srcH(p, item), 1024, smem, st, pre, nx ? *nx : srcH(p, nitem), hasnxt);
  u16* ACT = (u16*)(ws + OFF_ACT);
  const int tid = otid(), lane = tid & 63, wid = tid >> 6, wm = wid >> 2, wn = wid & 3, r16 = lane & 15, q = lane >> 4;
#pragma unroll
  for (int mf = 0; mf < 8; ++mf) {
    const int m = m0 + wm * 128 + mf * 16 + r16;
    float o[2][4];
#pragma unroll
    for (int nf = 0; nf < 2; ++nf)
#pragma unroll
      for (int e = 0; e < 4; ++e) { const float gt = acc[nf][mf][e], up = acc[nf + 2][mf][e]; o[nf][e] = gt * sigmoidf_(gt) * up; }
    auto rx = __builtin_amdgcn_permlane16_swap(pack2(o[0][0], o[0][1]), pack2(o[1][0], o[1][1]), false, false);
    auto ry = __builtin_amdgcn_permlane16_swap(pack2(o[0][2], o[0][3]), pack2(o[1][2], o[1][3]), false, false);
    const int j = ((n0 + wn * 64) >> 6) * 32 + (q & 1) * 16 + (q >> 1) * 8;
    uint4 ov; ov.x = rx[0]; ov.y = ry[0]; ov.z = rx[1]; ov.w = ry[1];
    *(uint4*)(ACT + (long)m * 2816 + j) = ov;
    __builtin_amdgcn_sched_barrier(0);
  }
}

DI TileSrc srcH_half(const Params& p, int mt, int n0) {
  TileSrc t; t.A = (const u16*)(p.ws + OFF_HB) + (long)mt * 256 * 1024; t.lda = 1024; t.Bt = (const u16*)(p.ws + OFF_W2 + W2_WFI) + (long)n0 * 1024; t.ldb = 1024;
  return t;
}
DI void phaseH_half_tile(const Params& p, int mt, int n0, char* smem, Stg& st, bool pre) {
  const int m0 = mt * 256;
  char* ws = p.ws;
  f32x4 acc[4][4];
  zero_acc<2>(acc);
  {
    const TileSrc t = srcH_half(p, mt, n0);
    gemm512<2, 2>(acc, t, 1024, smem, st, pre, t, false);
  }
  u16* ACT = (u16*)(ws + OFF_ACT);
  const int tid = otid(), lane = tid & 63, wid = tid >> 6, wm = wid >> 1, wn = wid & 1, r16 = lane & 15, q = lane >> 4;
#pragma unroll
  for (int mf = 0; mf < 4; ++mf) {
    const int m = m0 + wm * 64 + mf * 16 + r16;
    float o[2][4];
#pragma unroll
    for (int nf = 0; nf < 2; ++nf)
#pragma unroll
      for (int e = 0; e < 4; ++e) { const float gt = acc[nf][mf][e], up = acc[nf + 2][mf][e]; o[nf][e] = gt * sigmoidf_(gt) * up; }
    auto rx = __builtin_amdgcn_permlane16_swap(pack2(o[0][0], o[0][1]), pack2(o[1][0], o[1][1]), false, false);
    auto ry = __builtin_amdgcn_permlane16_swap(pack2(o[0][2], o[0][3]), pack2(o[1][2], o[1][3]), false, false);
    const int j = ((n0 + wn * 64) >> 6) * 32 + (q & 1) * 16 + (q >> 1) * 8;
    uint4 ov; ov.x = rx[0]; ov.y = ry[0]; ov.z = rx[1]; ov.w = ry[1];
    *(uint4*)(ACT + (long)m * 2816 + j) = ov;
    __builtin_amdgcn_sched_barrier(0);
  }
}

DI void rowsq_exchange(const f32x4 (&acc)[4][8], float* xch, unsigned* cnt, int mt, int nt, char* smem, float* rsv) {
  const int tid = otid(), lane = tid & 63, wid = tid >> 6, wm = wid >> 2, wn = wid & 3, r16 = lane & 15, q = lane >> 4;
  float* part = (float*)smem;
#pragma unroll
  for (int mf = 0; mf < 8; ++mf) {
    float ss = 0.f;
#pragma unroll
    for (int nf = 0; nf < 4; ++nf) ss += acc[nf][mf][0] * acc[nf][mf][0] + acc[nf][mf][1] * acc[nf][mf][1] + acc[nf][mf][2] * acc[nf][mf][2] + acc[nf][mf][3] * acc[nf][mf][3];
    ss += __shfl_xor(ss, 16); ss += __shfl_xor(ss, 32);
    if (q == 0) part[wn * 256 + wm * 128 + mf * 16 + r16] = ss;
  }
  __syncthreads();
  if (tid < 256) {
    const float P = part[tid] + part[256 + tid] + part[512 + tid] + part[768 + tid];
    __hip_atomic_store(xch + ((long)mt * 4 + nt) * 256 + tid, P, __ATOMIC_RELAXED, __HIP_MEMORY_SCOPE_AGENT);
  }
  asm volatile("s_waitcnt vmcnt(0)" ::: "memory");
  __syncthreads();
  if (tid == 0) {
    __hip_atomic_fetch_add(cnt + mt, 1u, __ATOMIC_RELAXED, __HIP_MEMORY_SCOPE_AGENT);
    while (__hip_atomic_load(cnt + mt, __ATOMIC_RELAXED, __HIP_MEMORY_SCOPE_AGENT) < 4u) __builtin_amdgcn_s_sleep(1);
  }
  __syncthreads();
  if (tid < 256) {
    float S = 0.f;
#pragma unroll
    for (int j = 0; j < 4; ++j) S += __hip_atomic_load(xch + ((long)mt * 4 + j) * 256 + tid, __ATOMIC_RELAXED, __HIP_MEMORY_SCOPE_AGENT);
    rsv[tid] = rsqrtf(S * (1.f / 1024.f) + 1e-6f);
  }
  __syncthreads();
}
DI void fused_norm_tile(const Params& p, const u16* A, long lda, const u16* Bt, long ldb, int K, int use, const float* res_in, float* res_out,
                        const float* g_post, const float* g_next, u16* hnext, bool zero_stats, char* smem) {
  const int bid = blockIdx.x;
  const int mt = (bid & 7) * 8 + ((bid >> 3) & 7), nt = bid >> 6;
  const int m0 = mt * 256, n0 = nt * 256;
  char* ws = p.ws;
  f32x4 acc[4][8];
  zero_acc<4>(acc);
  {
    Stg st;
    const TileSrc src = srcP(A, lda, Bt, ldb, mt * 4 + nt);
    gemm512<4, 4>(acc, src, K, smem, st, false, src, false);
  }
  float* xch = (float*)(ws + OFF_NG);
  unsigned* cnt = (unsigned*)(ws + OFF_SM + SM_BAR) + 16 + use * 128;
  float* rsv = (float*)(smem + 4096);
  const int tid = otid(), lane = tid & 63, wid = tid >> 6, wm = wid >> 2, wn = wid & 3, r16 = lane & 15, q = lane >> 4;
  rowsq_exchange(acc, xch, cnt, mt, nt, smem, rsv);
#pragma unroll
  for (int mf = 0; mf < 8; ++mf) {
    const int ml = wm * 128 + mf * 16 + r16;
    const float rs = rsv[ml];
#pragma unroll
    for (int nf = 0; nf < 4; ++nf) {
      const int n = n0 + wn * 64 + nf * 16 + q * 4;
      const float4 xv = *(const float4*)(res_in + (long)(m0 + ml) * 1024 + n);
      const float4 gv = *(const float4*)(g_post + n);
      acc[nf][mf][0] = xv.x + acc[nf][mf][0] * rs * gv.x; acc[nf][mf][1] = xv.y + acc[nf][mf][1] * rs * gv.y;
      acc[nf][mf][2] = xv.z + acc[nf][mf][2] * rs * gv.z; acc[nf][mf][3] = xv.w + acc[nf][mf][3] * rs * gv.w;
      float4 o; o.x = acc[nf][mf][0]; o.y = acc[nf][mf][1]; o.z = acc[nf][mf][2]; o.w = acc[nf][mf][3];
      *(float4*)(res_out + (long)(m0 + ml) * 1024 + n) = o;
    }
    __builtin_amdgcn_sched_barrier(0);
  }
  if (hnext) {
    __syncthreads();
    rowsq_exchange(acc, xch + 65536, cnt + 64, mt, nt, smem, rsv);
#pragma unroll
    for (int mf = 0; mf < 8; ++mf) {
      const int ml = wm * 128 + mf * 16 + r16;
      const float rs = rsv[ml];
#pragma unroll
      for (int pp = 0; pp < 2; ++pp) {
        const int na = n0 + wn * 64 + 2 * pp * 16 + q * 4;
        const float4 ga = *(const float4*)(g_next + na), gb = *(const float4*)(g_next + na + 16);
        auto rx = __builtin_amdgcn_permlane16_swap(pack2(acc[2 * pp][mf][0] * rs * ga.x, acc[2 * pp][mf][1] * rs * ga.y),
                                                   pack2(acc[2 * pp + 1][mf][0] * rs * gb.x, acc[2 * pp + 1][mf][1] * rs * gb.y), false, false);
        auto ry = __builtin_amdgcn_permlane16_swap(pack2(acc[2 * pp][mf][2] * rs * ga.z, acc[2 * pp][mf][3] * rs * ga.w),
                                                   pack2(acc[2 * pp + 1][mf][2] * rs * gb.z, acc[2 * pp + 1][mf][3] * rs * gb.w), false, false);
        const int n = n0 + wn * 64 + (2 * pp + (q & 1)) * 16 + (q >> 1) * 8;
        uint4 o; o.x = rx[0]; o.y = ry[0]; o.z = rx[1]; o.w = ry[1];
        *(uint4*)(hnext + (long)(m0 + ml) * 1024 + n) = o;
      }
      __builtin_amdgcn_sched_barrier(0);
    }
  }
  if (zero_stats && nt == 0 && tid < 256) {
    unsigned long long* stz = (unsigned long long*)(ws + OFF_SM + SM_STATS) + (long)(m0 + tid) * 2;
    unsigned long long zz = 0ull; asm volatile("" : "+v"(zz));
    stz[0] = zz; stz[1] = zz;
  }
  __syncthreads();
}

#ifndef PHMASK
#define PHMASK 0x3ff
#endif
#define PH_ON(i) ((PHMASK >> (i)) & 1)
DI void run_phase(const Params& p, int ph, char* smem, int csub = 7) {
  const int G = gridDim.x, bid = blockIdx.x;
  char* ws = p.ws;
  int half = ((int)__builtin_amdgcn_workitem_id_x()) >> 8;
  asm volatile("" : "+v"(half));
  half = __builtin_amdgcn_readfirstlane(half);
  char* hsm = smem + half * 65536;
  if (ph == 0) {
    if (!PH_ON(9)) return;
    const int n = 2048 + CONV1_ITEMS / 2;
    for (int it = bid; it < n; it += G) {
      if (it < 2048) row_item(it, p.in[0], nullptr, nullptr, nullptr, p.in[1], (u16*)(ws + OFF_HB), (unsigned long long*)(ws + OFF_SM + SM_STATS));
      else conv1_item(p, 0, (it - 2048) * 2 + half, hsm);
    }
    return;
  }
  const int l = (ph - 1) / 9, sp = (ph - 1) % 9;
  switch (sp) {
    case 0: if (!PH_ON(0)) break; {
      Stg st; bool pre = false;
      if (G == 256) {
        int mt, nt, mt2, nt2;
        xcd_tile(0, 27, mt, nt);
        const int hx = bid & 7, hlb = bid >> 3, htix = hlb >> 1;
        const int hmt = hx * 8 + (htix & 7), hn0 = (24 + (htix >> 3)) * 256 + (hlb & 1) * 128;
        const TileSrc th = srcB_half(p, hmt, hn0);
        for (int r = 0; r < 6; ++r) { xcd_tile(r + 1, 27, mt2, nt2); phaseB_tile(p, mt * 27 + nt, smem, st, pre, mt2 * 27 + nt2, true, (r == 5) ? &th : nullptr); pre = true; mt = mt2; nt = nt2; }
        phaseB_half_tile(p, hmt, hn0, smem, st, true);
      } else
      for (int it = bid; it < 64 * 27; it += G) { const bool hn = (it + G < 64 * 27); phaseB_tile(p, it, smem, st, pre, it + G, hn); pre = hn; }
      break;
    }
    case 1: if (!PH_ON(1)) break;
      if (G >= 192) {
        if (bid < 128) { if (csub & 1) rglru_item(p, l, bid * 2 + half, hsm); }
        else if (bid < 160) { if (csub & 2) compress_item(p, bid - 128, smem); }
        else {
          for (int e = bid - 160; e < 64 + 256; e += G - 160) {
            if (e < 64) { if (csub & 4) nsa_item(p, e, smem); }
            else { if (csub & 4) gmlp_item(p, l, (e - 64) * 2 + half, hsm); }
          }
        }
#ifndef NO_CD_MERGE
        if (G == 256) {
          unsigned* cq = (unsigned*)(ws + OFF_SM + SM_BAR) + 600 + l * 2;
          const int tidr = (int)__builtin_amdgcn_workitem_id_x();
          if (bid >= 128) {
            asm volatile("s_waitcnt vmcnt(0)" ::: "memory");
            __syncthreads();
            if (tidr == 0) {
              __builtin_amdgcn_fence(__ATOMIC_RELEASE, "agent");
              const unsigned mine = (bid < 160) ? 1u : (unsigned)(((63 - (bid - 160)) / 96) + 1);
              __hip_atomic_fetch_add(cq + 1, (bid < 160 || bid - 160 < 64) ? mine : 0u, __ATOMIC_RELAXED, __HIP_MEMORY_SCOPE_AGENT);
            }
          }
          unsigned* qslot = (unsigned*)(smem + 114688);
          if (tidr == 0) {
            while (__hip_atomic_load(cq + 1, __ATOMIC_RELAXED, __HIP_MEMORY_SCOPE_AGENT) < 96u) __builtin_amdgcn_s_sleep(2);
            __builtin_amdgcn_fence(__ATOMIC_ACQUIRE, "agent");
          }
          for (;;) {
            __syncthreads();
            if (tidr == 0) *qslot = __hip_atomic_fetch_add(cq, 1u, __ATOMIC_RELAXED, __HIP_MEMORY_SCOPE_AGENT);
            __syncthreads();
            const unsigned idx = *qslot;
            if (idx >= 1024u) break;
            attn_item(p, (int)idx | 0x10000, smem);
          }
        }
#endif
      } else {
        for (int e = bid; e < 128 + 32 + 256; e += G) {
          if (e < 128) { if (csub & 1) rglru_item(p, l, e * 2 + half, hsm); }
          else if (e < 160) { if (csub & 2) compress_item(p, e - 128, smem); }
          else { if (csub & 4) gmlp_item(p, l, (e - 160) * 2 + half, hsm); }
        }
      }
      break;
    case 2: if (!PH_ON(2)) break;
#ifndef NO_CD_MERGE
      if (G == 256) break;
#endif
      for (int it = bid; it < 1024; it += G) attn_item(p, it, smem); break;
    case 3: if (!PH_ON(3)) break;
      {
        Stg st; bool pre = false;
        for (int it = bid; it < 512 + CONV2_TILES / 2; it += G) {
          if (it < 512) {
            const bool hn = (it + G < 512);
            int e0 = it, e1 = it + G;
            if (G == 256) { const int x = bid & 7, lb = bid >> 3; const int t0_ = (it >> 8) * 32 + lb, t1_ = t0_ + 32; e0 = (x * 8 + (t0_ & 7)) * 8 + (t0_ >> 3); e1 = (x * 8 + (t1_ & 7)) * 8 + (t1_ >> 3); }
            phaseE_tile(p, e0, smem, st, pre, e1, hn); pre = hn;
          }
          else conv2_item(p, l, (it - 512) * 2 + half, hsm);
        }
      }
      break;
    case 4: if (!PH_ON(4)) break;
      if (G == 256) {
        fused_norm_tile(p, (const u16*)(ws + OFF_MERGED), 1024, (const u16*)(ws + OFF_W2 + W2_WO), 1024, 1024, l * 2 + 0,
                        (l == 0) ? p.in[0] : p.out, p.out, p.in[2] + l * 1024, p.in[3] + l * 1024, (u16*)(ws + OFF_HB), false, smem);
      } else
      {
        Stg st; bool pre = false;
        for (int it = bid; it < 256; it += G) { const bool hn = (it + G < 256);
          const int e0 = (G == 256) ? (((bid & 7) * 8 + ((bid >> 3) & 7)) * 4 + (bid >> 6)) : it;
          gemm_f32out_tile((const u16*)(ws + OFF_MERGED), 1024, (const u16*)(ws + OFF_W2 + W2_WO), 1024, 1024, (u16*)(ws + OFF_TBUF), e0, smem, st, pre, it + G, hn); pre = hn; }
      }
      break;
    case 5: if (!PH_ON(5)) break;
      for (int it = bid; it < 2048; it += G)
        row_item(it, (l == 0) ? p.in[0] : p.out, (const u16*)(ws + OFF_TBUF), p.in[2] + l * 1024, p.out, p.in[3] + l * 1024, (u16*)(ws + OFF_HB), nullptr);
      break;
    case 6: if (!PH_ON(6)) break; {
      Stg st; bool pre = false;
      if (G == 256) {
        int mt, nt, mt2, nt2;
        xcd_tile(0, 22, mt, nt);
        const int hx = bid & 7, hlb = bid >> 3, htix = hlb >> 1;
        const int hmt = hx * 8 + (htix & 7), hn0 = (20 + (htix >> 3)) * 256 + (hlb & 1) * 128;
        const TileSrc th = srcH_half(p, hmt, hn0);
        for (int r = 0; r < 5; ++r) { xcd_tile(r + 1, 22, mt2, nt2); phaseH_tile(p, mt * 22 + nt, smem, st, pre, mt2 * 22 + nt2, true, (r == 4) ? &th : nullptr); pre = true; mt = mt2; nt = nt2; }
        phaseH_half_tile(p, hmt, hn0, smem, st, true);
      } else
      for (int it = bid; it < 64 * 22; it += G) { const bool hn = (it + G < 64 * 22); phaseH_tile(p, it, smem, st, pre, it + G, hn); pre = hn; }
      break;
    }
    case 7: if (!PH_ON(7)) break;
      if (G == 256) {
        const bool nxt = (l + 1 < 2);
        fused_norm_tile(p, (const u16*)(ws + OFF_ACT), 2816, (const u16*)(ws + OFF_W2 + W2_WFO), 2816, 2816, l * 2 + 1,
                        p.out, p.out, p.in[4] + l * 1024, nxt ? (p.in[1] + (l + 1) * 1024) : nullptr, nxt ? (u16*)(ws + OFF_HB) : nullptr, nxt, smem);
        if (nxt) for (int it = bid; it < CONV1_ITEMS / 2; it += G) conv1_item(p, l + 1, it * 2 + half, hsm);
      } else
      {
        Stg st; bool pre = false;
        for (int it = bid; it < 256; it += G) { const bool hn = (it + G < 256);
          const int e0 = (G == 256) ? (((bid & 7) * 8 + ((bid >> 3) & 7)) * 4 + (bid >> 6)) : it;
          gemm_f32out_tile((const u16*)(ws + OFF_ACT), 2816, (const u16*)(ws + OFF_W2 + W2_WFO), 2816, 2816, (u16*)(ws + OFF_TBUF), e0, smem, st, pre, it + G, hn); pre = hn; }
      }
      break;
    case 8: if (!PH_ON(8)) break; {
      const bool nxt = (l + 1 < 2);
      const int n = 2048 + (nxt ? CONV1_ITEMS / 2 : 0);
      for (int it = bid; it < n; it += G) {
        if (it < 2048) row_item(it, p.out, (const u16*)(ws + OFF_TBUF), p.in[4] + l * 1024, p.out, nxt ? (p.in[1] + (l + 1) * 1024) : nullptr, nxt ? (u16*)(ws + OFF_HB) : nullptr, (unsigned long long*)(ws + OFF_SM + SM_STATS));
        else conv1_item(p, l + 1, (it - 2048) * 2 + half, hsm);
      }
      break;
    }
  }
}

constexpr int N_PHASES = 19;

__global__ void __launch_bounds__(NTHR, 2) mega_kernel(Params p, int ph0, int ph1) {
  extern __shared__ __attribute__((aligned(16))) char smem[];
  cg::grid_group grid = cg::this_grid();
#ifdef TIMER_MASK
  unsigned long long tacc = 0, tprev = wall_clock64();
#endif
  unsigned* gbar = (unsigned*)(p.ws + OFF_SM + SM_BAR);
  if (blockIdx.x == 0) { __hip_atomic_store(gbar + threadIdx.x, 0u, __ATOMIC_RELAXED, __HIP_MEMORY_SCOPE_AGENT); __hip_atomic_store(gbar + 512 + threadIdx.x, 0u, __ATOMIC_RELAXED, __HIP_MEMORY_SCOPE_AGENT); }
  const bool fused_rows = (gridDim.x == 256);
  unsigned nbar = 0;
  for (int ph = ph0; ph < ph1; ++ph) {
    if (fused_rows && ph >= 1) { const int kd = (ph - 1) % 9; if (kd == 5 || kd == 8) continue;
#ifndef NO_CD_MERGE
      if (kd == 2) continue;
#endif
    }
#ifdef CSUB
    if (ph >= 1 && ((ph - 1) % 9) == 1) {
      for (int c = 1; c <= 4; c <<= 1) {
        run_phase(p, ph, smem, c);
        grid.sync();
        const unsigned long long tn = wall_clock64(); if (c == CSUB) tacc += tn - tprev; tprev = tn;
      }
      continue;
    }
#endif
    run_phase(p, ph, smem);
#ifdef TIMER_MASK
    grid.sync();
    { const unsigned long long tn = wall_clock64(); const int kind = (ph == 0) ? 9 : ((ph - 1) % 9); if ((TIMER_MASK >> kind) & 1) tacc += tn - tprev; tprev = tn; }
#else
    if (ph + 1 < ph1) {
      if (ph == ph0) grid.sync();
      else {
        asm volatile("s_waitcnt vmcnt(0)" ::: "memory");
        __syncthreads();
        ++nbar;
        if (threadIdx.x == 0) {
          __builtin_amdgcn_fence(__ATOMIC_RELEASE, "agent");
          __hip_atomic_fetch_add(gbar, 1u, __ATOMIC_RELAXED, __HIP_MEMORY_SCOPE_AGENT);
          const unsigned target = nbar * gridDim.x;
          while (__hip_atomic_load(gbar, __ATOMIC_RELAXED, __HIP_MEMORY_SCOPE_AGENT) < target) __builtin_amdgcn_s_sleep(2);
          __builtin_amdgcn_fence(__ATOMIC_ACQUIRE, "agent");
        }
        __syncthreads();
      }
    }
#endif
  }
#ifdef TIMER_MASK
  if (blockIdx.x == 0 && threadIdx.x == 0) p.out[0] += (float)tacc * 0.001f;
#endif
}

extern "C" void kernel_launch(void* const* d_in, const int* in_sizes, int n_in, void* d_out, int out_size, void* d_ws, size_t ws_size,
                              hipStream_t stream) {
  static int grid_blocks = 0;
  if (!grid_blocks) {
    int dev = 0, cus = 0, per_cu = 0;
    (void)hipGetDevice(&dev);
    (void)hipDeviceGetAttribute(&cus, hipDeviceAttributeMultiprocessorCount, dev);
    (void)hipFuncSetAttribute((const void*)mega_kernel, hipFuncAttributeMaxDynamicSharedMemorySize, LDS_BYTES);
    (void)hipOccupancyMaxActiveBlocksPerMultiprocessor(&per_cu, mega_kernel, NTHR, LDS_BYTES);
    if (per_cu < 1) per_cu = 1;
    if (per_cu > 1) per_cu = 1;
    grid_blocks = cus * per_cu;
    if (ws_size < WS_NEED) fprintf(stderr, "kernel_launch: workspace too small: %zu < %zu\n", ws_size, (size_t)WS_NEED);
  }
  Params p{};
  for (int i = 0; i < 29; ++i) p.in[i] = (const float*)d_in[i];
  p.out = (float*)d_out;
  p.ws = (char*)d_ws;
#if MK_MULTI
  for (int ph = 0; ph < N_PHASES; ++ph) {
    hipLaunchKernelGGL(mega_kernel, dim3(grid_blocks), dim3(NTHR), LDS_BYTES, stream, p, ph, ph + 1);
  }
#else
  int ph0 = 0, ph1 = N_PHASES;
  void* args[] = {&p, &ph0, &ph1};
  hipError_t e = hipLaunchCooperativeKernel((void*)mega_kernel, dim3(grid_blocks), dim3(NTHR), args, LDS_BYTES, stream);
  if (e != hipSuccess) fprintf(stderr, "cooperative launch failed: %s (grid %d)\n", hipGetErrorString(e), grid_blocks);
#endif
}
```
